# Optimizing an MI355X kernel written in HIP

```python
import numpy as np
import jax
import jax.numpy as jnp
from jax import lax

D_MODEL = 1024
BATCH = 16
SEQ = 2048
DEPTH = 2

HEAD_DIM = 64
ROPE_DIM = HEAD_DIM // 4
ROPE_THETA = 500000.0
NORM_EPS = 1e-6
ATTN_SCALE = HEAD_DIM ** -0.5
Q_BLOCK = 32

NSA_HEADS = 8
NSA_KV_GROUPS = 2
NSA_GROUP_SIZE = NSA_HEADS // NSA_KV_GROUPS
CMP_BLOCK = 32
CMP_STRIDE = 16
CMP_HIDDEN = 2 * HEAD_DIM
SLC_BLOCK = 64
N_SLC = 16
N_LOCAL_BLOCKS = 2
SEL_FORCE_SCORE = 1e4
WINDOW = 512

DSA_HEADS = 8
IDX_HEADS = 8
IDX_DIM = 64
IDX_WEIGHT_SCALE = (IDX_HEADS * IDX_DIM) ** -0.5
DSA_TOPK_MAX = 256

D_FF = -(-8 * D_MODEL // (3 * 256)) * 256

NSA_WIDTH = NSA_HEADS * HEAD_DIM
DSA_WIDTH = DSA_HEADS * HEAD_DIM
KV_WIDTH = NSA_KV_GROUPS * HEAD_DIM
IN_SIZES = (
    NSA_WIDTH,
    KV_WIDTH, KV_WIDTH,
    KV_WIDTH, KV_WIDTH,
    KV_WIDTH, KV_WIDTH,
    3 * NSA_HEADS,
    DSA_WIDTH, DSA_WIDTH, DSA_WIDTH,
    IDX_HEADS * IDX_DIM, IDX_DIM, IDX_HEADS,
    D_MODEL, D_MODEL,
)
D_IN = sum(IN_SIZES)

kernel_name = 'nsa_dsa_gated_hybrid_block'


def _rmsnorm(x, g):
    xf = x.astype(jnp.float32)
    y = xf * lax.rsqrt(jnp.mean(xf * xf, axis=-1, keepdims=True) + NORM_EPS)
    return (y * g.astype(jnp.float32)).astype(x.dtype)


def _rope_tables(seq_len):
    pos = jnp.arange(seq_len, dtype=jnp.float32)
    inv_freq = ROPE_THETA ** (-jnp.arange(0, ROPE_DIM, 2, dtype=jnp.float32) / ROPE_DIM)
    ang = pos[:, None] * inv_freq[None, :]
    return jnp.cos(ang), jnp.sin(ang)


def _apply_rope(x, cos, sin):
    half = ROPE_DIM // 2
    bshape = (cos.shape[0],) + (1,) * (x.ndim - 3) + (half,)
    c = cos.reshape(bshape).astype(x.dtype)
    s = sin.reshape(bshape).astype(x.dtype)
    x1 = x[..., :half]
    x2 = x[..., half:ROPE_DIM]
    return jnp.concatenate([x1 * c - x2 * s, x2 * c + x1 * s, x[..., ROPE_DIM:]], axis=-1)


def _masked_softmax(scores, mask):
    s = jnp.where(mask, scores.astype(jnp.float32), -1e30)
    s = s - jnp.max(s, axis=-1, keepdims=True)
    p = jnp.where(mask, jnp.exp(s), 0.0)
    return p / jnp.maximum(jnp.sum(p, axis=-1, keepdims=True), 1e-30)


def _compress(kv, pos_emb, w1, b1, w2, b2):
    bsz, seq_len, groups, hd = kv.shape
    n_cmp = (seq_len - CMP_BLOCK) // CMP_STRIDE + 1
    idx = np.arange(n_cmp)[:, None] * CMP_STRIDE + np.arange(CMP_BLOCK)[None, :]
    blocks = kv[:, idx] + pos_emb[:, None, :]
    blocks = blocks.transpose(0, 1, 3, 2, 4).reshape(bsz, n_cmp, groups, CMP_BLOCK * hd)
    hidden = jax.nn.gelu(blocks @ w1 + b1)
    return hidden @ w2 + b2


def _cmp_to_slc_overlap(n_cmp, n_slc):
    c_start = np.arange(n_cmp)[:, None] * CMP_STRIDE
    s_start = np.arange(n_slc)[None, :] * SLC_BLOCK
    ov = np.minimum(c_start + CMP_BLOCK, s_start + SLC_BLOCK) - np.maximum(c_start, s_start)
    return jnp.asarray(np.clip(ov, 0, None) / CMP_BLOCK, dtype=jnp.float32)


def _nsa_mixer(q, k_cmp, v_cmp, k_slc, v_slc, k_win, v_win, gate_logits, cos, sin,
               cmpk_pos, cmpk_w1, cmpk_b1, cmpk_w2, cmpk_b2,
               cmpv_pos, cmpv_w1, cmpv_b1, cmpv_w2, cmpv_b2):
    bsz, seq_len = q.shape[:2]
    G, R, hd = NSA_KV_GROUPS, NSA_GROUP_SIZE, HEAD_DIM
    kv_shape = (bsz, seq_len, G, hd)
    q = _apply_rope(q.reshape(bsz, seq_len, NSA_HEADS, hd), cos, sin)
    k_cmp = _apply_rope(k_cmp.reshape(kv_shape), cos, sin)
    k_slc = _apply_rope(k_slc.reshape(kv_shape), cos, sin)
    k_win = _apply_rope(k_win.reshape(kv_shape), cos, sin)
    v_slc = v_slc.reshape(kv_shape)
    v_win = v_win.reshape(kv_shape)

    kc = _compress(k_cmp, cmpk_pos, cmpk_w1, cmpk_b1, cmpk_w2, cmpk_b2)
    vc = _compress(v_cmp.reshape(kv_shape), cmpv_pos, cmpv_w1, cmpv_b1, cmpv_w2, cmpv_b2)
    n_cmp = kc.shape[1]
    n_slc = seq_len // SLC_BLOCK
    n_sel = min(N_SLC, n_slc)
    nqb = seq_len // Q_BLOCK
    cmp_end = jnp.asarray(np.arange(n_cmp) * CMP_STRIDE + CMP_BLOCK - 1)
    overlap = _cmp_to_slc_overlap(n_cmp, n_slc)
    blk_ids = jnp.arange(n_slc)

    ks_blk = k_slc.reshape(bsz, n_slc, SLC_BLOCK, G, hd).transpose(0, 3, 1, 2, 4)
    vs_blk = v_slc.reshape(bsz, n_slc, SLC_BLOCK, G, hd).transpose(0, 3, 1, 2, 4)
    kw_pad = jnp.pad(k_win, ((0, 0), (WINDOW, 0), (0, 0), (0, 0)))
    vw_pad = jnp.pad(v_win, ((0, 0), (WINDOW, 0), (0, 0), (0, 0)))
    qb = q.reshape(bsz, nqb, Q_BLOCK, G, R, hd).transpose(1, 0, 3, 4, 2, 5)
    gather_blocks = jax.vmap(jax.vmap(lambda blk, ix: blk[ix]))

    def step(args):
        q_i, i = args
        t = i * Q_BLOCK + jnp.arange(Q_BLOCK)
        s_c = jnp.einsum('bgrtd,bcgd->bgrtc', q_i, kc) * ATTN_SCALE
        p_c = _masked_softmax(s_c, cmp_end[None, :] <= t[:, None])
        o_c = jnp.einsum('bgrtc,bcgd->bgrtd', p_c.astype(vc.dtype), vc)
        imp = jnp.einsum('bgrtc,cj->bgtj', p_c, overlap)
        cur = t // SLC_BLOCK
        dist = cur[:, None] - blk_ids[None, :]
        forced = (blk_ids[None, :] == 0) | ((dist >= 0) & (dist < N_LOCAL_BLOCKS))
        admissible = blk_ids[None, :] * SLC_BLOCK <= t[:, None]
        score = jnp.where(forced, SEL_FORCE_SCORE, imp)
        score = jnp.where(admissible, score, -jnp.inf)
        _, sel = lax.top_k(score, n_sel)
        kg = gather_blocks(ks_blk, sel)
        vg = gather_blocks(vs_blk, sel).reshape(bsz, G, Q_BLOCK, n_sel * SLC_BLOCK, hd)
        tok = sel[..., None] * SLC_BLOCK + jnp.arange(SLC_BLOCK)
        mask_s = (tok <= t[None, None, :, None, None]).reshape(bsz, G, 1, Q_BLOCK, n_sel * SLC_BLOCK)
        s_s = jnp.einsum('bgrtd,bgtnkd->bgrtnk', q_i, kg).reshape(bsz, G, R, Q_BLOCK, n_sel * SLC_BLOCK)
        p_s = _masked_softmax(s_s * ATTN_SCALE, mask_s)
        o_s = jnp.einsum('bgrtm,bgtmd->bgrtd', p_s.astype(vg.dtype), vg)
        kw = lax.dynamic_slice_in_dim(kw_pad, i * Q_BLOCK, WINDOW + Q_BLOCK, axis=1)
        vw = lax.dynamic_slice_in_dim(vw_pad, i * Q_BLOCK, WINDOW + Q_BLOCK, axis=1)
        s_pos = i * Q_BLOCK - WINDOW + jnp.arange(WINDOW + Q_BLOCK)
        diff = t[:, None] - s_pos[None, :]
        mask_w = (diff >= 0) & (diff < WINDOW) & (s_pos[None, :] >= 0)
        s_w = jnp.einsum('bgrtd,bsgd->bgrts', q_i, kw) * ATTN_SCALE
        p_w = _masked_softmax(s_w, mask_w)
        o_w = jnp.einsum('bgrts,bsgd->bgrtd', p_w.astype(vw.dtype), vw)
        return o_c, o_s, o_w

    o_c, o_s, o_w = lax.map(step, (qb, jnp.arange(nqb)))

    def unblock(o):
        return o.transpose(1, 0, 4, 2, 3, 5).reshape(bsz, seq_len, NSA_HEADS, hd)

    g = jax.nn.sigmoid(gate_logits).reshape(bsz, seq_len, 3, NSA_HEADS)[..., None]
    out = g[:, :, 0] * unblock(o_c) + g[:, :, 1] * unblock(o_s) + g[:, :, 2] * unblock(o_w)
    return out.reshape(bsz, seq_len, NSA_WIDTH)


def _dsa_mixer(q, k, v, iq, ik, iw, cos, sin):
    bsz, seq_len = q.shape[:2]
    q = _apply_rope(q.reshape(bsz, seq_len, DSA_HEADS, HEAD_DIM), cos, sin)
    k = _apply_rope(k.reshape(bsz, seq_len, DSA_HEADS, HEAD_DIM), cos, sin)
    v = v.reshape(bsz, seq_len, DSA_HEADS, HEAD_DIM)
    iq = _apply_rope(iq.reshape(bsz, seq_len, IDX_HEADS, IDX_DIM), cos, sin)
    ik = _apply_rope(ik, cos, sin)
    iw = iw * IDX_WEIGHT_SCALE
    k_top = min(DSA_TOPK_MAX, seq_len // 4)
    nqb = seq_len // Q_BLOCK
    qb = q.reshape(bsz, nqb, Q_BLOCK, DSA_HEADS, HEAD_DIM).transpose(1, 0, 2, 3, 4)
    iqb = iq.reshape(bsz, nqb, Q_BLOCK, IDX_HEADS, IDX_DIM).transpose(1, 0, 2, 3, 4)
    iwb = iw.reshape(bsz, nqb, Q_BLOCK, IDX_HEADS).transpose(1, 0, 2, 3)
    key_pos = jnp.arange(seq_len)
    gather_tokens = jax.vmap(lambda a, ix: a[ix])

    def step(args):
        q_i, iq_i, iw_i, i = args
        t = i * Q_BLOCK + jnp.arange(Q_BLOCK)
        rel = jax.nn.relu(jnp.einsum('bthd,bsd->bths', iq_i, ik).astype(jnp.float32))
        score = jnp.einsum('bths,bth->bts', rel, iw_i.astype(jnp.float32))
        score = jnp.where(key_pos[None, :] <= t[:, None], score, -jnp.inf)
        _, sel = lax.top_k(score, k_top)
        kg = gather_tokens(k, sel)
        vg = gather_tokens(v, sel)
        valid = (sel <= t[None, :, None])[:, None]
        s = jnp.einsum('bthd,btkhd->bhtk', q_i, kg) * ATTN_SCALE
        p = _masked_softmax(s, valid)
        return jnp.einsum('bhtk,btkhd->bthd', p.astype(vg.dtype), vg)

    o = lax.map(step, (qb, iqb, iwb, jnp.arange(nqb)))
    return o.transpose(1, 0, 2, 3, 4).reshape(bsz, seq_len, DSA_WIDTH)


def _hybrid_mixer(h, cos, sin, w_in,
                  cmpk_pos, cmpk_w1, cmpk_b1, cmpk_w2, cmpk_b2,
                  cmpv_pos, cmpv_w1, cmpv_b1, cmpv_w2, cmpv_b2,
                  w_branch_nsa, w_branch_dsa, w_out):
    proj = h @ w_in
    points = [int(p) for p in np.cumsum(IN_SIZES)[:-1]]
    (nsa_q, k_cmp, v_cmp, k_slc, v_slc, k_win, v_win, nsa_gate,
     dsa_q, dsa_k, dsa_v, idx_q, idx_k, idx_w, gate_nsa, gate_dsa) = jnp.split(proj, points, axis=-1)
    y_nsa = _nsa_mixer(nsa_q, k_cmp, v_cmp, k_slc, v_slc, k_win, v_win, nsa_gate, cos, sin,
                       cmpk_pos, cmpk_w1, cmpk_b1, cmpk_w2, cmpk_b2,
                       cmpv_pos, cmpv_w1, cmpv_b1, cmpv_w2, cmpv_b2) @ w_branch_nsa
    y_dsa = _dsa_mixer(dsa_q, dsa_k, dsa_v, idx_q, idx_k, idx_w, cos, sin) @ w_branch_dsa
    merged = jax.nn.sigmoid(gate_nsa) * y_nsa + jax.nn.sigmoid(gate_dsa) * y_dsa
    return merged @ w_out


def _swiglu(h, w_gate, w_up, w_down):
    return (jax.nn.silu(h @ w_gate) * (h @ w_up)) @ w_down


def setup_inputs(seed: int = 0) -> dict:
    key = jax.random.key(seed)
    ks = jax.random.split(key, 21)

    def nrm(k, shape, scale):
        return jax.random.normal(k, shape, jnp.float32) * scale

    flat = CMP_BLOCK * HEAD_DIM
    return {
        'x': nrm(ks[0], (BATCH, SEQ, D_MODEL), 1.0),
        'attn_norm': 1.0 + nrm(ks[1], (DEPTH, D_MODEL), 0.01),
        'w_in': nrm(ks[2], (DEPTH, D_MODEL, D_IN), D_MODEL ** -0.5),
        'cmpk_pos': nrm(ks[3], (DEPTH, CMP_BLOCK, HEAD_DIM), 0.1),
        'cmpk_w1': nrm(ks[4], (DEPTH, flat, CMP_HIDDEN), flat ** -0.5),
        'cmpk_b1': nrm(ks[5], (DEPTH, CMP_HIDDEN), 0.01),
        'cmpk_w2': nrm(ks[6], (DEPTH, CMP_HIDDEN, HEAD_DIM), CMP_HIDDEN ** -0.5),
        'cmpk_b2': nrm(ks[7], (DEPTH, HEAD_DIM), 0.01),
        'cmpv_pos': nrm(ks[8], (DEPTH, CMP_BLOCK, HEAD_DIM), 0.1),
        'cmpv_w1': nrm(ks[9], (DEPTH, flat, CMP_HIDDEN), flat ** -0.5),
        'cmpv_b1': nrm(ks[10], (DEPTH, CMP_HIDDEN), 0.01),
        'cmpv_w2': nrm(ks[11], (DEPTH, CMP_HIDDEN, HEAD_DIM), CMP_HIDDEN ** -0.5),
        'cmpv_b2': nrm(ks[12], (DEPTH, HEAD_DIM), 0.01),
        'w_branch_nsa': nrm(ks[13], (DEPTH, NSA_WIDTH, D_MODEL), NSA_WIDTH ** -0.5),
        'w_branch_dsa': nrm(ks[14], (DEPTH, DSA_WIDTH, D_MODEL), DSA_WIDTH ** -0.5),
        'w_out': nrm(ks[15], (DEPTH, D_MODEL, D_MODEL), D_MODEL ** -0.5),
        'ffn_norm': 1.0 + nrm(ks[16], (DEPTH, D_MODEL), 0.01),
        'w_ffn_gate': nrm(ks[17], (DEPTH, D_MODEL, D_FF), D_MODEL ** -0.5),
        'w_ffn_up': nrm(ks[18], (DEPTH, D_MODEL, D_FF), D_MODEL ** -0.5),
        'w_ffn_down': nrm(ks[19], (DEPTH, D_FF, D_MODEL), D_FF ** -0.5),
        'final_norm': 1.0 + nrm(ks[20], (D_MODEL,), 0.01),
    }


def reference(x, attn_norm, w_in,
              cmpk_pos, cmpk_w1, cmpk_b1, cmpk_w2, cmpk_b2,
              cmpv_pos, cmpv_w1, cmpv_b1, cmpv_w2, cmpv_b2,
              w_branch_nsa, w_branch_dsa, w_out,
              ffn_norm, w_ffn_gate, w_ffn_up, w_ffn_down, final_norm):
    cos, sin = _rope_tables(x.shape[1])
    for l in range(DEPTH):
        h = _rmsnorm(x, attn_norm[l])
        x = x + _hybrid_mixer(h, cos, sin, w_in[l],
                              cmpk_pos[l], cmpk_w1[l], cmpk_b1[l], cmpk_w2[l], cmpk_b2[l],
                              cmpv_pos[l], cmpv_w1[l], cmpv_b1[l], cmpv_w2[l], cmpv_b2[l],
                              w_branch_nsa[l], w_branch_dsa[l], w_out[l])
        h = _rmsnorm(x, ffn_norm[l])
        x = x + _swiglu(h, w_ffn_gate[l], w_ffn_up[l], w_ffn_down[l])
    return _rmsnorm(x, final_norm)
```

```cpp
#include <hip/hip_runtime.h>
#include <cstdio>
#include <cstdint>
namespace pg8 {
#define PG8_LAS __attribute__((address_space(3)))
typedef unsigned short bf16_t;
typedef short bf16x8 __attribute__((ext_vector_type(8)));
typedef float f32x4 __attribute__((ext_vector_type(4)));
typedef unsigned u32x4 __attribute__((ext_vector_type(4)));
constexpr int BM = 256, BK = 64, HALF = 128, HTB = HALF * BK * 2  , STAGE_BYTES = 8 * HTB, NXCD = 8, WGM = 8;

__host__ __device__ __forceinline__ int lds_byte(int r, int c) { const int st = (r >> 4) * 2 + (c >> 5), rr = r & 15, cc = c & 31, ob = rr * 64 + cc * 2; return st * 1024 + (ob ^ (((ob >> 9) & 1) << 5)); }
__host__ __device__ __forceinline__ void stage_rc(int b, int& R, int& C) { const int st = b / 1024, sb = b % 1024, swz = sb ^ (((sb >> 9) & 1) << 5); R = (st >> 1) * 16 + swz / 64; C = (st & 1) * 32 + (swz % 64) / 2; }
__host__ __device__ __forceinline__ int perm32(int rho) { const int n = rho >> 4, i = rho & 15; return 8 * (i >> 2) + 4 * n + (i & 3); }

struct Unit { int pm, pn; };
struct Gemm { const bf16_t* A; const bf16_t* Bt; int M, N, K, lda, ldb; };

struct StaticOrder {
    int nM, nN, nwg, G, c;
    __host__ __device__ void init(int M, int N, int G_, int c_) { nM = M / BM; nN = N / BM; nwg = nM * nN; G = G_; c = c_; }
    __host__ __device__ bool next(int i, Unit& u) const {
        const long L = (long)i * G + c; if (L >= nwg) return false;
        int wgid = (int)L; { const int q = nwg / NXCD, r = nwg % NXCD, xcd = wgid % NXCD, off = wgid / NXCD; wgid = (xcd < r ? xcd * (q + 1) : r * (q + 1) + (xcd - r) * q) + off; }
        const int nig = WGM * nN, gid = wgid / nig, fm = gid * WGM, gsz = (nM - fm) < WGM ? (nM - fm) : WGM;
        u.pm = fm + ((wgid % nig) % gsz); u.pn = (wgid % nig) / gsz; return true;
    }
    __device__ __forceinline__ void a_ready(const Unit&) const {}
    __device__ __forceinline__ void done(const Unit&) const {}
};

__device__ __forceinline__ unsigned cvt_pk_bf16(float lo, float hi) { unsigned r; asm volatile("v_cvt_pk_bf16_f32 %0, %1, %2" : "=v"(r) : "v"(lo), "v"(hi)); return r; }
__device__ __forceinline__ float bf_lo(unsigned w) { return __uint_as_float(w << 16); }
__device__ __forceinline__ float bf_hi(unsigned w) { return __uint_as_float(w & 0xffff0000u); }
__device__ __forceinline__ float sigmoidf_(float x) { return 1.0f / (1.0f + __expf(-x)); }
constexpr int PW = 5632;
constexpr float RMS_EPS = 1e-6f;
__device__ __forceinline__ float row_rstd(const float* rowss, int row) {
    const f32x4* p = (const f32x4*)(rowss + (size_t)row * 16);
    const f32x4 a = p[0], b = p[1], c = p[2], d = p[3];
    const float s = ((a[0] + a[1]) + (a[2] + a[3])) + ((b[0] + b[1]) + (b[2] + b[3])) + ((c[0] + c[1]) + (c[2] + c[3])) + ((d[0] + d[1]) + (d[2] + d[3]));
    return 1.0f / sqrtf(s * (1.0f / 1024.0f) + RMS_EPS);
}
struct EpiProj {
    static constexpr bool PERM = true, AFTER_DRAIN = false;
    bf16_t* P; const float* rowss; const float* rcos; const float* rsin;
    __device__ __forceinline__ void operator()(const f32x4 (&acc)[2][2][4][2], const Unit& u, int wr, int wc, int fr, int fq) const {
        const int pn = u.pn;
        const bool rope_tile = (pn <= 1) || (pn >= 5 && pn <= 8) || (pn == 11) || (pn == 12);
#pragma unroll
        for (int ai = 0; ai < 2; ++ai)
#pragma unroll
            for (int m = 0; m < 4; ++m) {
                const int row = u.pm * BM + ai * HALF + wr * 64 + m * 16 + fr;
                const float rs = row_rstd(rowss, row);
                const int pos = row & 2047;
#pragma unroll
                for (int bj = 0; bj < 2; ++bj) {
                    f32x4 v0 = acc[ai][bj][m][0] * rs, v1 = acc[ai][bj][m][1] * rs;
                    const bool rope = ((wc & 1) == 0) && (rope_tile || ((pn >= 2 && pn <= 4) && bj == 0) || (pn == 13 && bj == 0 && wc == 0));
                    if (rope) {
                        const f32x4 c0 = *(const f32x4*)(rcos + pos * 8), c1 = *(const f32x4*)(rcos + pos * 8 + 4);
                        const f32x4 s0 = *(const f32x4*)(rsin + pos * 8), s1 = *(const f32x4*)(rsin + pos * 8 + 4);
                        f32x4 p0, p1;
#pragma unroll
                        for (int e = 0; e < 4; ++e) { p0[e] = __shfl_xor(v0[e], 16); p1[e] = __shfl_xor(v1[e], 16); }
                        if (fq == 0) { v0 = v0 * c0 - p0 * s0; v1 = v1 * c1 - p1 * s1; }
                        else if (fq == 1) { v0 = v0 * c0 + p0 * s0; v1 = v1 * c1 + p1 * s1; }
                    }
                    if (pn >= 14) {
#pragma unroll
                        for (int e = 0; e < 4; ++e) { v0[e] = sigmoidf_(v0[e]); v1[e] = sigmoidf_(v1[e]); }
                    } else if (pn == 13 && bj == 0 && wc == 2) {
                        if (fq == 0) { v0 = v0 * 0.044194173824159216f; v1 = v1 * 0.044194173824159216f; }
                        else {
#pragma unroll
                            for (int e = 0; e < 4; ++e) { v0[e] = sigmoidf_(v0[e]); v1[e] = sigmoidf_(v1[e]); }
                        }
                    }
                    u32x4 w; w.x = cvt_pk_bf16(v0[0], v0[1]); w.y = cvt_pk_bf16(v0[2], v0[3]); w.z = cvt_pk_bf16(v1[0], v1[1]); w.w = cvt_pk_bf16(v1[2], v1[3]);
                    *(u32x4*)(P + (size_t)row * PW + pn * BM + bj * HALF + wc * 32 + 8 * fq) = w;
                }
            }
    }
};
template <int MODE> struct EpiBranch {
    static constexpr bool PERM = true, AFTER_DRAIN = false;
    const bf16_t* G; const bf16_t* T; bf16_t* O;
    __device__ __forceinline__ void operator()(const f32x4 (&acc)[2][2][4][2], const Unit& u, int wr, int wc, int fr, int fq) const {
#pragma unroll
        for (int ai = 0; ai < 2; ++ai)
#pragma unroll
            for (int m = 0; m < 4; ++m) {
                const int row = u.pm * BM + ai * HALF + wr * 64 + m * 16 + fr;
#pragma unroll
                for (int bj = 0; bj < 2; ++bj) {
                    const size_t off = (size_t)row * PW + u.pn * BM + bj * HALF + wc * 32 + 8 * fq;
                    const u32x4 gw = *(const u32x4*)(G + off);
                    f32x4 v0 = acc[ai][bj][m][0], v1 = acc[ai][bj][m][1];
                    v0[0] *= bf_lo(gw.x); v0[1] *= bf_hi(gw.x); v0[2] *= bf_lo(gw.y); v0[3] *= bf_hi(gw.y);
                    v1[0] *= bf_lo(gw.z); v1[1] *= bf_hi(gw.z); v1[2] *= bf_lo(gw.w); v1[3] *= bf_hi(gw.w);
                    if (MODE == 1) { const u32x4 tw = *(const u32x4*)(T + off);
                        v0[0] += bf_lo(tw.x); v0[1] += bf_hi(tw.x); v0[2] += bf_lo(tw.y); v0[3] += bf_hi(tw.y);
                        v1[0] += bf_lo(tw.z); v1[1] += bf_hi(tw.z); v1[2] += bf_lo(tw.w); v1[3] += bf_hi(tw.w); }
                    u32x4 w; w.x = cvt_pk_bf16(v0[0], v0[1]); w.y = cvt_pk_bf16(v0[2], v0[3]); w.z = cvt_pk_bf16(v1[0], v1[1]); w.w = cvt_pk_bf16(v1[2], v1[3]);
                    *(u32x4*)(O + off) = w;
                }
            }
    }
};
struct EpiResid {
    static constexpr bool PERM = false, AFTER_DRAIN = false;
    const float* xi; float* xo; const float* gn; bf16_t* XG; float* ss;
    __device__ __forceinline__ void operator()(const f32x4 (&acc)[2][2][4][2], const Unit& u, int wr, int wc, int fr, int fq) const {
        typedef unsigned u32x2 __attribute__((ext_vector_type(2)));
        const int col0 = u.pn * BM + wc * 32 + 4 * fq;
        f32x4 gv[2][2];
#pragma unroll
        for (int bj = 0; bj < 2; ++bj)
#pragma unroll
            for (int n = 0; n < 2; ++n) gv[bj][n] = gn ? *(const f32x4*)(gn + col0 + bj * HALF + n * 16) : (f32x4){0.f, 0.f, 0.f, 0.f};
#pragma unroll
        for (int ai = 0; ai < 2; ++ai)
#pragma unroll
            for (int m = 0; m < 4; ++m) {
                const int row = u.pm * BM + ai * HALF + wr * 64 + m * 16 + fr;
                const size_t off = (size_t)row * 1024 + col0;
                float q = 0.f;
#pragma unroll
                for (int bj = 0; bj < 2; ++bj)
#pragma unroll
                    for (int n = 0; n < 2; ++n) {
                        const f32x4 o = *(const f32x4*)(xi + off + bj * HALF + n * 16) + acc[ai][bj][m][n];
                        *(f32x4*)(xo + off + bj * HALF + n * 16) = o;
                        q += (o[0] * o[0] + o[1] * o[1]) + (o[2] * o[2] + o[3] * o[3]);
                        if (gn) { const f32x4 g = o * gv[bj][n]; u32x2 w; w.x = cvt_pk_bf16(g[0], g[1]); w.y = cvt_pk_bf16(g[2], g[3]); *(u32x2*)(XG + off + bj * HALF + n * 16) = w; }
                    }
                q += __shfl_xor(q, 16); q += __shfl_xor(q, 32);
                if (fq == 0) ss[(size_t)row * 16 + u.pn * 4 + wc] = q;
            }
    }
};
struct EpiSwiglu {
    static constexpr bool PERM = true, AFTER_DRAIN = false;
    bf16_t* H; const float* rowss;
    __device__ __forceinline__ void operator()(const f32x4 (&acc)[2][2][4][2], const Unit& u, int wr, int wc, int fr, int fq) const {
#pragma unroll
        for (int ai = 0; ai < 2; ++ai)
#pragma unroll
            for (int m = 0; m < 4; ++m) {
                const int row = u.pm * BM + ai * HALF + wr * 64 + m * 16 + fr;
                const float rs = row_rstd(rowss, row);
                float o[8];
#pragma unroll
                for (int n = 0; n < 2; ++n)
#pragma unroll
                    for (int e = 0; e < 4; ++e) { const float g = acc[ai][0][m][n][e] * rs, uu = acc[ai][1][m][n][e] * rs; o[n * 4 + e] = g * sigmoidf_(g) * uu; }
                u32x4 w; w.x = cvt_pk_bf16(o[0], o[1]); w.y = cvt_pk_bf16(o[2], o[3]); w.z = cvt_pk_bf16(o[4], o[5]); w.w = cvt_pk_bf16(o[6], o[7]);
                *(u32x4*)(H + (size_t)row * 2816 + u.pn * HALF + wc * 32 + 8 * fq) = w;
            }
    }
};
template <class Epi, class Sched, bool ALIGN_EPI = false, bool SP2 = false>
__device__ __forceinline__ void gemm_phase(PG8_LAS unsigned char* lds, const Gemm g, const Sched& S, const Epi& E) {
    int tid_ = threadIdx.x; asm volatile("" : "+v"(tid_));
    const int tid = tid_, wid = __builtin_amdgcn_readfirstlane(tid >> 6), lane = tid & 63, wr = wid >> 2, wc = wid & 3, fr = lane & 15, fq = lane >> 4;
    const int K = g.K, nt = K / BK;
    unsigned voffA[2], voffB[2];
#pragma unroll
    for (int i = 0; i < 2; ++i) { int R, C; stage_rc(tid * 16 + i * 8192, R, C); const int Rb = Epi::PERM ? ((R & ~31) + perm32(R & 31)) : R;
        voffA[i] = (unsigned)(R * g.lda + C) * 2u; voffB[i] = (unsigned)(Rb * g.ldb + C) * 2u; }
    const size_t kstep = (size_t)(BK * 2);
    const size_t hstepA = (size_t)HALF * g.lda * 2, hstepB = (size_t)HALF * g.ldb * 2;
    const size_t tstepA = 2 * hstepA, tstepB = 2 * hstepB;
    const unsigned ldsw = (unsigned)wid * 1024u;
    const int aoff = lds_byte(wr * 64 + fr, fq * 8), boff = lds_byte(wc * 32 + fr, fq * 8);
#define PG8_SA(b, h) (((b) * 2 + (h)) * HTB)
#define PG8_SB(b, h) ((4 + (b) * 2 + (h)) * HTB)
#define PG8_STAGE(bufoff, gbase, voff) do { _Pragma("unroll") for (int _i = 0; _i < 2; ++_i) \
        __builtin_amdgcn_global_load_lds((const unsigned*)((const char*)(gbase) + (voff)[_i]), (PG8_LAS unsigned*)(lds + (bufoff) + ldsw + _i * 8192), 16, 0, 0); } while (0)
#define PG8_LDA(dst, b, h) do { _Pragma("unroll") for (int m = 0; m < 4; ++m) _Pragma("unroll") for (int k = 0; k < 2; ++k) dst[m][k] = *(const PG8_LAS bf16x8*)(lds + PG8_SA(b, h) + aoff + m * 2048 + k * 1024); } while (0)
#define PG8_LDB(dst, b, h) do { _Pragma("unroll") for (int n = 0; n < 2; ++n) _Pragma("unroll") for (int k = 0; k < 2; ++k) dst[n][k] = *(const PG8_LAS bf16x8*)(lds + PG8_SB(b, h) + boff + n * 2048 + k * 1024); } while (0)
#define PG8_MMA(ai, bj, At, Bt) do { __builtin_amdgcn_s_setprio(1); _Pragma("unroll") for (int m = 0; m < 4; ++m) _Pragma("unroll") for (int n = 0; n < 2; ++n) _Pragma("unroll") for (int k = 0; k < 2; ++k) \
        acc[ai][bj][m][n] = __builtin_amdgcn_mfma_f32_16x16x32_bf16(Bt[n][k], At[m][k], acc[ai][bj][m][n], 0, 0, 0); __builtin_amdgcn_s_setprio(0); } while (0)
#define PG8_WAIT_V(n) asm volatile("s_waitcnt vmcnt(" #n ")" ::: "memory")
#define PG8_WAIT_L(n) asm volatile("s_waitcnt lgkmcnt(" #n ")" ::: "memory")
#define PG8_BAR __builtin_amdgcn_s_barrier()
#define PG8_SCHED __builtin_amdgcn_sched_barrier(0)
    Unit cur, nxt; int ui = 0;
    if (!S.next(0, cur)) return;
    f32x4 acc[2][2][4][2];
#pragma unroll
    for (int a = 0; a < 2; ++a)
#pragma unroll
        for (int b = 0; b < 2; ++b)
#pragma unroll
            for (int m = 0; m < 4; ++m)
#pragma unroll
                for (int n = 0; n < 2; ++n) acc[a][b][m][n] = (f32x4){0.f, 0.f, 0.f, 0.f};
    bf16x8 At[4][2], B0[2][2], B1[2][2];
    const char* cA = (const char*)g.A + (size_t)cur.pm * tstepA; const char* cB = (const char*)g.Bt + (size_t)cur.pn * tstepB;
    S.a_ready(cur);
    if constexpr (SP2) {
        PG8_STAGE(PG8_SB(0, 0), cB, voffB); PG8_STAGE(PG8_SB(0, 1), cB + hstepB, voffB); PG8_STAGE(PG8_SA(0, 0), cA, voffA); PG8_STAGE(PG8_SA(0, 1), cA + hstepA, voffA);
        if (wr == 1) PG8_BAR;
        PG8_WAIT_V(2); PG8_BAR;
        PG8_STAGE(PG8_SB(1, 0), cB + kstep, voffB); PG8_STAGE(PG8_SA(1, 0), cA + kstep, voffA); PG8_STAGE(PG8_SB(1, 1), cB + hstepB + kstep, voffB);
        PG8_WAIT_V(6); PG8_BAR;
    } else {
        PG8_STAGE(PG8_SB(0, 0), cB, voffB); PG8_STAGE(PG8_SA(0, 0), cA, voffA); PG8_STAGE(PG8_SB(0, 1), cB + hstepB, voffB); PG8_STAGE(PG8_SA(0, 1), cA + hstepA, voffA);
        if (wr == 1) PG8_BAR;
        PG8_WAIT_V(4); PG8_BAR;
        PG8_STAGE(PG8_SB(1, 0), cB + kstep, voffB); PG8_STAGE(PG8_SA(1, 0), cA + kstep, voffA); PG8_STAGE(PG8_SB(1, 1), cB + hstepB + kstep, voffB);
        PG8_WAIT_V(6); PG8_BAR;
    }
    for (;;) {
        const bool has_next = S.next(ui + 1, nxt);
        const char* nA = has_next ? (const char*)g.A + (size_t)nxt.pm * tstepA : cA; const char* nB = has_next ? (const char*)g.Bt + (size_t)nxt.pn * tstepB : cB;
        for (int t = 0; t < nt; t += 2) {
            const bool last = (t == nt - 2);
            const char* a1 = cA + (size_t)(t + 1) * kstep;
            const char* a2 = last ? nA : cA + (size_t)(t + 2) * kstep; const char* b2 = last ? nB : cB + (size_t)(t + 2) * kstep;
            const char* a3 = a2 + kstep; const char* b3 = b2 + kstep;
            if (last && has_next) S.a_ready(nxt);
            if constexpr (SP2) {
            PG8_LDB(B0, 0, 0); PG8_LDB(B1, 0, 1); PG8_SCHED; PG8_LDA(At, 0, 0); PG8_STAGE(PG8_SA(1, 1), a1 + hstepA, voffA);
            PG8_WAIT_V(8); PG8_WAIT_L(0); PG8_BAR; PG8_MMA(0, 0, At, B0); PG8_MMA(0, 1, At, B1); PG8_BAR; PG8_SCHED;
            PG8_LDA(At, 0, 1); PG8_STAGE(PG8_SB(0, 0), b2, voffB); PG8_STAGE(PG8_SB(0, 1), b2 + hstepB, voffB); PG8_STAGE(PG8_SA(0, 0), a2, voffA);
            PG8_WAIT_V(8); PG8_WAIT_L(0); PG8_BAR; PG8_MMA(1, 0, At, B0); PG8_MMA(1, 1, At, B1); PG8_BAR; PG8_SCHED;
            PG8_LDB(B0, 1, 0); PG8_LDB(B1, 1, 1); PG8_SCHED; PG8_LDA(At, 1, 0); PG8_STAGE(PG8_SA(0, 1), a2 + hstepA, voffA);
            PG8_WAIT_V(8); PG8_WAIT_L(0); PG8_BAR; PG8_MMA(0, 0, At, B0); PG8_MMA(0, 1, At, B1); PG8_BAR; PG8_SCHED;
            PG8_LDA(At, 1, 1); PG8_STAGE(PG8_SB(1, 0), b3, voffB); PG8_STAGE(PG8_SB(1, 1), b3 + hstepB, voffB); PG8_STAGE(PG8_SA(1, 0), a3, voffA);
            PG8_WAIT_V(8); PG8_WAIT_L(0); PG8_BAR; PG8_MMA(1, 0, At, B0); PG8_MMA(1, 1, At, B1); PG8_BAR; PG8_SCHED;
            } else {
            PG8_LDB(B0, 0, 0); PG8_SCHED; PG8_LDA(At, 0, 0); PG8_STAGE(PG8_SA(1, 1), a1 + hstepA, voffA);
            PG8_WAIT_L(8); PG8_BAR; PG8_WAIT_L(0); PG8_MMA(0, 0, At, B0); PG8_BAR; PG8_SCHED;
            PG8_LDB(B1, 0, 1); PG8_STAGE(PG8_SB(0, 0), b2, voffB);
            PG8_BAR; PG8_WAIT_L(0); PG8_MMA(0, 1, At, B1); PG8_BAR;
            PG8_LDA(At, 0, 1); PG8_STAGE(PG8_SA(0, 0), a2, voffA);
            PG8_BAR; PG8_WAIT_L(0); PG8_MMA(1, 0, At, B0); PG8_BAR; PG8_SCHED;
            PG8_STAGE(PG8_SB(0, 1), b2 + hstepB, voffB);
            PG8_WAIT_V(6); PG8_BAR; PG8_MMA(1, 1, At, B1); PG8_BAR;
            PG8_LDB(B0, 1, 0); PG8_SCHED; PG8_LDA(At, 1, 0); PG8_STAGE(PG8_SA(0, 1), a2 + hstepA, voffA);
            PG8_WAIT_L(8); PG8_BAR; PG8_WAIT_L(0); PG8_MMA(0, 0, At, B0); PG8_BAR; PG8_SCHED;
            PG8_LDB(B1, 1, 1); PG8_STAGE(PG8_SB(1, 0), b3, voffB);
            PG8_BAR; PG8_WAIT_L(0); PG8_MMA(0, 1, At, B1); PG8_BAR;
            PG8_LDA(At, 1, 1); PG8_STAGE(PG8_SA(1, 0), a3, voffA);
            PG8_BAR; PG8_WAIT_L(0); PG8_MMA(1, 0, At, B0); PG8_BAR; PG8_SCHED;
            PG8_STAGE(PG8_SB(1, 1), b3 + hstepB, voffB);
            PG8_WAIT_V(6); PG8_BAR; PG8_MMA(1, 1, At, B1); PG8_BAR;
            }
        }
        if constexpr (ALIGN_EPI) { if (wr == 0) PG8_BAR; }
        if constexpr (!Epi::AFTER_DRAIN) { E(acc, cur, wr, wc, fr, fq); S.done(cur); }
        if (!has_next) break;
#pragma unroll
        for (int a = 0; a < 2; ++a)
#pragma unroll
            for (int b = 0; b < 2; ++b)
#pragma unroll
                for (int m = 0; m < 4; ++m)
#pragma unroll
                    for (int n = 0; n < 2; ++n) acc[a][b][m][n] = (f32x4){0.f, 0.f, 0.f, 0.f};
        cur = nxt; cA = nA; cB = nB; ++ui;
        if constexpr (ALIGN_EPI) { if (wr == 1) PG8_BAR; }
    }
    PG8_WAIT_V(0);
    if constexpr (!ALIGN_EPI) { if (wr == 0) PG8_BAR; }
    PG8_BAR;
    if constexpr (Epi::AFTER_DRAIN) { E.fused(acc, cur, wr, wc, fr, fq, lds, wid, lane); S.done(cur); }
#undef PG8_SA
#undef PG8_SB
#undef PG8_STAGE
#undef PG8_LDA
#undef PG8_LDB
#undef PG8_MMA
#undef PG8_WAIT_V
#undef PG8_WAIT_L
#undef PG8_BAR
#undef PG8_SCHED
}
}

constexpr int NB = 16, SEQ = 2048, DM = 1024, MTOK = NB * SEQ, DEPTH = 2, DIN = 5472, DFF = 2816;
using pg8::PW;
constexpr int C_NQ = 0, C_KCMP = 512, C_VCMP = 640, C_KSLC = 768, C_VSLC = 896, C_KWIN = 1024, C_VWIN = 1152, C_DQ = 1280, C_DK = 1792, C_DV = 2304,
              C_IQ = 2816, C_IK = 3328, C_IW = 3392, C_NG = 3400, C_GN = 3584, C_GD = 4608;
constexpr int C_TMP = 0, C_MRG = 1024;
__host__ __device__ __forceinline__ int proj_src_col(int n) {
    if (n < 1280) return n;
    if (n < 2816) return n - 1280 + 1304;
    if (n < 3328) return n - 2816 + 2840;
    if (n < 3392) return n - 3328 + 3352;
    if (n < 3400) return n - 3392 + 3416;
    if (n < 3424) return n - 3400 + 1280;
    if (n < 3584) return -1;
    return n - 3584 + 3424;
}
constexpr size_t MiB = 1u << 20;
constexpr size_t WS_CTL = 0, CTL_ZERO_BYTES = 1 * MiB;
constexpr size_t WS_ROPE = 1 * MiB;
constexpr size_t WS_CB1 = WS_ROPE + 131072;
constexpr size_t WS_RSS = 2 * MiB;
constexpr size_t WS_KC = 4 * MiB;
constexpr size_t WS_KCB = 6 * MiB;
constexpr size_t WS_SELM = 7 * MiB;
constexpr size_t WS_DMASK = 8 * MiB;
constexpr size_t WS_WIN = 16 * MiB;
constexpr size_t SZ_WIN = (size_t)PW * DM * 2, SZ_WBR = (size_t)DM * 512 * 2, SZ_WOUT = (size_t)DM * DM * 2, SZ_WGU = (size_t)PW * DM * 2, SZ_WDN = (size_t)DM * DFF * 2;
constexpr size_t WS_WBN = WS_WIN + DEPTH * SZ_WIN, WS_WBD = WS_WBN + DEPTH * SZ_WBR, WS_WOUT = WS_WBD + DEPTH * SZ_WBR, WS_WGU = WS_WOUT + DEPTH * SZ_WOUT, WS_WDN = WS_WGU + DEPTH * SZ_WGU;
constexpr size_t WS_W1B = WS_WDN + DEPTH * SZ_WDN;
constexpr size_t WS_R1 = 88 * MiB;
constexpr size_t WS_P = 152 * MiB;
constexpr size_t WS_END = WS_P + (size_t)MTOK * PW * 2;
static_assert(WS_W1B + 2 * MiB <= WS_R1 && WS_END <= 512 * MiB, "d_ws map");
constexpr int CW_TMO = 0, CW_CODE = 1, CW_BAR = 4096;

constexpr int LDSCTL_OFF = 0, MISC_OFF = 320, POOL_OFF = 1024;
constexpr int LDS_BYTES = 147456, POOL_BYTES = LDS_BYTES - POOL_OFF;
constexpr int NWAVES = 8, NTHR = 512;
#define GAS __attribute__((address_space(1)))
#define LAS __attribute__((address_space(3)))
typedef unsigned short bf16;
typedef unsigned v4u __attribute__((ext_vector_type(4)));
typedef float f32x4 __attribute__((ext_vector_type(4)));
typedef short bf16x8 __attribute__((ext_vector_type(8)));
typedef GAS unsigned gu32;
typedef GAS unsigned long long gu64;
#define RLX_AGENT __ATOMIC_RELAXED, __HIP_MEMORY_SCOPE_AGENT
#define LDS_WAIT() asm volatile("s_waitcnt lgkmcnt(0)" ::: "memory")
#define VM_WAIT() asm volatile("s_waitcnt vmcnt(0)" ::: "memory")
__device__ __forceinline__ unsigned long long rt() { return __builtin_amdgcn_s_memrealtime(); }
__device__ __forceinline__ unsigned f2bf(float f) { unsigned u = __builtin_bit_cast(unsigned, f); return (u + 0x7fffu + ((u >> 16) & 1u)) >> 16; }
__device__ __forceinline__ unsigned pk2(float lo, float hi) { return f2bf(lo) | (f2bf(hi) << 16); }

#define XB_TMO      128
#define XB_XCNT(j)  (256  + 64 * (j))
#define XB_XSUB(j)  (1280 + 64 * (j))
#define XB_XGEN(j)  (2304 + 64 * (j))
#define XB_TOP      3328
#define XB_TOPGEN   3392
#define XCD_BAR_WORDS 3456
#define XB_SPIN_CAP (1u << 18)

__device__ __forceinline__ unsigned xb_ld(unsigned* p)              { return __hip_atomic_load(p, __ATOMIC_RELAXED, __HIP_MEMORY_SCOPE_AGENT); }
__device__ __forceinline__ unsigned xb_add(unsigned* p, unsigned v) { return __hip_atomic_fetch_add(p, v, __ATOMIC_RELAXED, __HIP_MEMORY_SCOPE_AGENT); }
__device__ __forceinline__ unsigned xb_xcc_id() { return (unsigned)__builtin_amdgcn_s_getreg((3 << 11) | 20) & 0xFu; }
#define XB_SPIN(cond, bar) do { unsigned _sp = 0; while (cond) { __builtin_amdgcn_s_sleep(1); \
    if ((++_sp & 255u) == 0u) { if (xb_ld(&(bar)[XB_TMO])) break; if (_sp > XB_SPIN_CAP) { atomicAdd(&(bar)[XB_TMO], 1u); break; } } } } while (0)

struct XcdBarrier {
    unsigned* bar; unsigned x;
    volatile LAS unsigned* st;
};

__device__ __forceinline__ XcdBarrier xcd_barrier_post(unsigned* bar, volatile LAS unsigned* st) {
    XcdBarrier b; b.bar = bar; b.x = xb_xcc_id(); b.st = st;
    if (threadIdx.x == 0) (void)xb_add(&bar[XB_XCNT(b.x)], 1u);
    return b;
}
__device__ __forceinline__ void xcd_barrier_complete(unsigned* bar, unsigned x, unsigned& nloc, unsigned& nx) {
    const unsigned G = gridDim.x * gridDim.y * gridDim.z;
    unsigned sum, cnt, mine, sp = 0u;
    for (;;) {
        sum = 0u; cnt = 0u; mine = 0u;
#pragma unroll
        for (unsigned j = 0; j < 16; ++j) { const unsigned c = xb_ld(&bar[XB_XCNT(j)]); sum += c; cnt += (c > 0u) ? 1u : 0u; mine = (j == x) ? c : mine; }
        if (sum == G) break;
        __builtin_amdgcn_s_sleep(1);
        if ((++sp & 255u) == 0u) { if (xb_ld(&bar[XB_TMO])) break; if (sp > XB_SPIN_CAP) { atomicAdd(&bar[XB_TMO], 1u); break; } }
    }
    nloc = mine > 0u ? mine : 1u; nx = cnt > 0u ? cnt : 1u;
}

__device__ __forceinline__ void xcd_barrier(const XcdBarrier& b) {
    asm volatile("s_waitcnt vmcnt(0)" ::: "memory");
    __syncthreads();
    if (threadIdx.x == 0) {
        unsigned* bar = b.bar;
        __builtin_amdgcn_s_waitcnt(0);
        unsigned nloc = b.st[0], nx = b.st[1];
        if (nloc == 0u) { xcd_barrier_complete(bar, b.x, nloc, nx); b.st[0] = nloc; b.st[1] = nx; }
        const unsigned old = xb_add(&bar[XB_XSUB(b.x)], 1u);
        const unsigned gen = old / nloc;
        if (old + 1u == (gen + 1u) * nloc) {
            __builtin_amdgcn_fence(__ATOMIC_RELEASE, "agent");
            asm volatile("s_waitcnt vmcnt(0)" ::: "memory");
            const unsigned og = xb_add(&bar[XB_TOP], 1u);
            const unsigned tg = og / nx;
            if (og + 1u == (tg + 1u) * nx) xb_add(&bar[XB_TOPGEN], 1u);
            else XB_SPIN(xb_ld(&bar[XB_TOPGEN]) == tg, bar);
            __builtin_amdgcn_fence(__ATOMIC_ACQUIRE, "agent");
            xb_add(&bar[XB_XGEN(b.x)], 1u);
            asm volatile("s_waitcnt vmcnt(0)" ::: "memory");
        } else {
            XB_SPIN(xb_ld(&bar[XB_XGEN(b.x)]) == gen, bar);
            __builtin_amdgcn_fence(__ATOMIC_ACQUIRE, "agent");
            asm volatile("s_waitcnt vmcnt(0)" ::: "memory");
        }
    }
    __syncthreads();
}
struct Args { const float* in[21]; float* out; unsigned char* ws; int ph_lo, ph_hi, li, pad; };
struct Ctx { LAS unsigned char* lds; int tid, lane, wave, G; };
typedef const __attribute__((address_space(4))) Args* KArgs;
__device__ __forceinline__ KArgs kargs() { KArgs p = (KArgs)__builtin_amdgcn_kernarg_segment_ptr(); asm volatile("" : "+s"(p)); return p; }
#define AIN(i) (kargs()->in[i])
#define AOUT (kargs()->out)
#define AWS (kargs()->ws)
__device__ __forceinline__ float bf2f(bf16 b) { return __uint_as_float((unsigned)b << 16); }
__device__ __forceinline__ float wave_sum(float v) {
#pragma unroll
    for (int o = 1; o < 64; o <<= 1) v += __shfl_xor(v, o);
    return v;
}
__device__ __forceinline__ float wave_max(float v) {
#pragma unroll
    for (int o = 1; o < 64; o <<= 1) v = fmaxf(v, __shfl_xor(v, o));
    return v;
}
__host__ __device__ __forceinline__ int mask_bitpos(int u) { return (u & 3) + 4 * (u >> 3) + 16 * ((u >> 2) & 1); }

__device__ __forceinline__ void p0_transpose_item(const float* srcp, int Ns, bf16* WT, int K, int k0, int n0, LAS float* scr, int lane) {
#pragma unroll 8
    for (int i = 0; i < 32; ++i) { const int kk = 2 * i + (lane >> 5); scr[kk * 33 + (lane & 31)] = srcp ? srcp[(size_t)(k0 + kk) * Ns] : 0.f; }
    LDS_WAIT(); asm volatile("" ::: "memory");
    const int c = lane & 7;
#pragma unroll
    for (int j = 0; j < 4; ++j) { const int n = (lane >> 3) + 8 * j; const LAS float* s = scr + (8 * c) * 33 + n;
        v4u o; o.x = pk2(s[0 * 33], s[1 * 33]); o.y = pk2(s[2 * 33], s[3 * 33]); o.z = pk2(s[4 * 33], s[5 * 33]); o.w = pk2(s[6 * 33], s[7 * 33]);
        *(GAS v4u*)(WT + (size_t)(n0 + n) * K + k0 + 8 * c) = o; }
    LDS_WAIT(); asm volatile("" ::: "memory");
}
__device__ __forceinline__ void sincos_small(double r, double& s, double& c) {
    const double r2 = r * r; double ts = 1.0, tc = 1.0, ss = 1.0, cc = 1.0;
#pragma unroll
    for (int k = 1; k <= 14; ++k) { tc = -tc * r2 * (1.0 / (double)((2 * k - 1) * (2 * k))); ts = -ts * r2 * (1.0 / (double)((2 * k) * (2 * k + 1))); cc += tc; ss += ts; }
    s = r * ss; c = cc;
}
__device__ __forceinline__ void p0_prologue(Ctx& C0) {
    Ctx C = C0; asm volatile("" : "+v"(C.tid), "+v"(C.lane), "+s"(C.wave));
    LAS float* scr = (LAS float*)(C.lds + POOL_OFF + C.wave * 16384);
    const int gw = blockIdx.x * NWAVES + C.wave, NGW = C.G * NWAVES, lane = C.lane;
    constexpr int I_WIN = 16 * (PW / 32), I_WBR = 8 * 32, I_WOUT = 16 * 32, I_WGU = 16 * (PW / 32), I_WDN = 44 * 32, I_L = I_WIN + 2 * I_WBR + I_WOUT + I_WGU + I_WDN;
    for (int it = gw; it < DEPTH * I_L; it += NGW) {
        const int l = it / I_L; int r = it % I_L;
        if (r < I_WIN) { const int nblk = PW / 32, kb = r / nblk, nb = r % nblk, n = nb * 32 + (lane & 31), sc = proj_src_col(n);
            p0_transpose_item(sc >= 0 ? AIN(2) + (size_t)l * DM * DIN + sc : nullptr, DIN, (bf16*)(AWS + WS_WIN + l * SZ_WIN), DM, kb * 64, nb * 32, scr, lane); continue; } r -= I_WIN;
        if (r < I_WBR) { const int kb = r / 32, nb = r % 32, n = nb * 32 + (lane & 31);
            p0_transpose_item(AIN(13) + (size_t)l * 512 * DM + n, DM, (bf16*)(AWS + WS_WBN + l * SZ_WBR), 512, kb * 64, nb * 32, scr, lane); continue; } r -= I_WBR;
        if (r < I_WBR) { const int kb = r / 32, nb = r % 32, n = nb * 32 + (lane & 31);
            p0_transpose_item(AIN(14) + (size_t)l * 512 * DM + n, DM, (bf16*)(AWS + WS_WBD + l * SZ_WBR), 512, kb * 64, nb * 32, scr, lane); continue; } r -= I_WBR;
        if (r < I_WOUT) { const int kb = r / 32, nb = r % 32, n = nb * 32 + (lane & 31);
            p0_transpose_item(AIN(15) + (size_t)l * DM * DM + n, DM, (bf16*)(AWS + WS_WOUT + l * SZ_WOUT), DM, kb * 64, nb * 32, scr, lane); continue; } r -= I_WOUT;
        if (r < I_WGU) { const int nblk = PW / 32, kb = r / nblk, nb = r % nblk, n = nb * 32 + (lane & 31), j = n & 255, hcol = (n >> 8) * 128 + (j & 127);
            const float* src = (j < 128 ? AIN(17) : AIN(18)) + (size_t)l * DM * DFF + hcol;
            p0_transpose_item(src, DFF, (bf16*)(AWS + WS_WGU + l * SZ_WGU), DM, kb * 64, nb * 32, scr, lane); continue; } r -= I_WGU;
        { const int kb = r / 32, nb = r % 32, n = nb * 32 + (lane & 31);
            p0_transpose_item(AIN(19) + (size_t)l * DFF * DM + n, DM, (bf16*)(AWS + WS_WDN + l * SZ_WDN), DFF, kb * 64, nb * 32, scr, lane); }
    }
    for (int it = gw; it < DEPTH * 2 * 32 * 4; it += NGW) {
        const int l = it / 256, r = it % 256, kv = r / 128, kb = (r % 128) / 4, nb = r % 4, n = nb * 32 + (lane & 31);
        p0_transpose_item(AIN(kv ? 9 : 4) + (size_t)l * 2048 * 128 + n, 128, (bf16*)(AWS + WS_W1B) + (size_t)(l * 2 + kv) * 128 * 2048, 2048, kb * 64, nb * 32, scr, lane);
    }
    {
        const float* gn = AIN(1); bf16* XG = (bf16*)(AWS + WS_R1); float* rss = (float*)(AWS + WS_RSS);
        f32x4 g[4];
#pragma unroll
        for (int j = 0; j < 4; ++j) g[j] = ((const f32x4*)gn)[lane + 64 * j];
        for (int m = gw; m < MTOK; m += NGW) {
            const GAS f32x4* xr = (const GAS f32x4*)(AIN(0) + (size_t)m * DM) + lane;
            GAS unsigned long long* o8 = (GAS unsigned long long*)(XG + (size_t)m * DM) + lane;
            float s = 0.f;
#pragma unroll
            for (int j = 0; j < 4; ++j) { const f32x4 v = xr[64 * j]; s += (v.x * v.x + v.y * v.y) + (v.z * v.z + v.w * v.w); const f32x4 y = v * g[j];
                o8[64 * j] = (unsigned long long)pk2(y.x, y.y) | ((unsigned long long)pk2(y.z, y.w) << 32); }
            s = wave_sum(s);
            if (lane < 16) rss[(size_t)m * 16 + lane] = (lane == 0) ? s : 0.f;
        }
    }
    {
        float* rc = (float*)(AWS + WS_ROPE); float* rsn = rc + 2048 * 8;
        const float invf[8] = {1.0f, 0.1939227432012558f, 0.03760603070259094f, 0.007292664609849453f, 0.0014142135623842478f, 0.00027424818836152554f, 5.3182957344688475e-05f, 1.0313385246263351e-05f};
        for (int i = blockIdx.x * NTHR + C.tid; i < 2048 * 8; i += C.G * NTHR) {
            const int pos = i >> 3, j = i & 7; float f = invf[0];
#pragma unroll
            for (int q = 1; q < 8; ++q) f = (j == q) ? invf[q] : f;
            const float ang = (float)pos * f; const double a = (double)ang;
            const double k = __builtin_rint(a * 0.15915494309189535); const double r = (a - k * 6.283185307179586) - k * 2.4492935982947064e-16;
            double s, c; sincos_small(r, s, c);
            rc[i] = (float)c; rsn[i] = (float)s;
        }
    }
    if (blockIdx.x < DEPTH * 2) {
        const int l = blockIdx.x >> 1, kv = blockIdx.x & 1; const float* pos = AIN(kv ? 8 : 3) + (size_t)l * 2048; const float* w1 = AIN(kv ? 9 : 4) + (size_t)l * 2048 * 128; const float* b1 = AIN(kv ? 10 : 5) + l * 128;
        LAS float* red = (LAS float*)(C.lds + POOL_OFF);
        __syncthreads();
        const int n = C.tid & 127, q = C.tid >> 7; float a = 0.f;
        for (int k = q * 512; k < q * 512 + 512; ++k) a += pos[k] * w1[(size_t)k * 128 + n];
        red[C.tid] = a; __syncthreads();
        if (C.tid < 128) ((float*)(AWS + WS_CB1))[(l * 2 + kv) * 128 + n] = b1[n] + ((red[n] + red[128 + n]) + (red[256 + n] + red[384 + n]));
        __syncthreads();
    }
}
__device__ __forceinline__ float gelu_tanh(float x) { const float u = 0.7978845608028654f * (x + 0.044715f * x * x * x); const float t = 1.0f - 2.0f / (__expf(2.0f * u) + 1.0f); return 0.5f * x * (1.0f + t); }
__device__ __forceinline__ void compress_naive(Ctx& C0, int l) {
    Ctx C = C0; asm volatile("" : "+v"(C.tid), "+v"(C.lane), "+s"(C.wave)); __syncthreads();
    LAS float* kvs = (LAS float*)(C.lds + POOL_OFF);
    LAS float* hid = kvs + 144 * 64;
    const bf16* P = (const bf16*)(AWS + WS_P);
    for (int u = blockIdx.x; u < 2 * NB * 2 * 16; u += C.G) {
        const int kv = u >> 9, b = (u >> 5) & 15, g = (u >> 4) & 1, cc = u & 15;
        const float* w1 = AIN(kv ? 9 : 4) + (size_t)l * 2048 * 128; const float* w2 = AIN(kv ? 11 : 6) + (size_t)l * 128 * 64; const float* b2 = AIN(kv ? 12 : 7) + l * 64;
        const float* cb1 = (const float*)(AWS + WS_CB1) + (l * 2 + kv) * 128;
        const int tok0 = 128 * cc, ntok = (tok0 + 144 <= SEQ) ? 144 : (SEQ - tok0);
        __syncthreads();
        for (int i = C.tid; i < 144 * 64; i += NTHR) { const int tk = i >> 6, d = i & 63;
            kvs[i] = (tk < ntok) ? bf2f(P[(size_t)(b * SEQ + tok0 + tk) * PW + (kv ? C_VCMP : C_KCMP) + g * 64 + d]) : 0.f; }
        __syncthreads();
        const int n = C.tid & 127, cq = C.tid >> 7; float a0 = 0.f, a1 = 0.f;
        const LAS float* k0 = kvs + (32 * cq) * 64; const LAS float* k1 = k0 + 16 * 64;
        for (int k = 0; k < 2048; ++k) { const float w = w1[(size_t)k * 128 + n]; a0 += k0[k] * w; a1 += k1[k] * w; }
        hid[(2 * cq) * 128 + n] = gelu_tanh(a0 + cb1[n]); hid[(2 * cq + 1) * 128 + n] = gelu_tanh(a1 + cb1[n]);
        __syncthreads();
        { const int cl = C.tid >> 6, d = C.tid & 63, c = 8 * cc + cl; float a = b2[d];
            for (int j = 0; j < 128; ++j) a += hid[cl * 128 + j] * w2[j * 64 + d];
            if (c >= 127) a = 0.f;
            const size_t o = ((size_t)((kv * NB + b) * 2 + g) * 128 + c) * 64 + d;
            ((float*)(AWS + WS_KC))[o] = a; ((bf16*)(AWS + WS_KCB))[o] = (bf16)f2bf(a); }
    }
    __syncthreads();
}
__device__ __forceinline__ unsigned fkey(float f) { f += 0.0f; const unsigned u = __float_as_uint(f); return (u & 0x80000000u) ? ~u : (u | 0x80000000u); }
__device__ __forceinline__ void idx_naive(Ctx& C0) {
    Ctx C = C0; asm volatile("" : "+v"(C.tid), "+v"(C.lane), "+s"(C.wave)); __syncthreads();
    LAS float* wl = (LAS float*)(C.lds + POOL_OFF + C.wave * 10496);
    LAS float* iq = wl; LAS unsigned* keys = (LAS unsigned*)(wl + 512); LAS float* iwl = wl + 512 + 2048;
    const bf16* P = (const bf16*)(AWS + WS_P); unsigned* DMK = (unsigned*)(AWS + WS_DMASK);
    const int lane = C.lane;
    for (int u = blockIdx.x; u < NB * 256; u += C.G) {
        const int b = u >> 8, t = ((u & 255) << 3) + C.wave;
        const bf16* Prow = P + (size_t)(b * SEQ + t) * PW;
#pragma unroll
        for (int h = 0; h < 8; ++h) iq[h * 64 + lane] = bf2f(Prow[C_IQ + h * 64 + lane]);
        if (lane < 8) iwl[lane] = bf2f(Prow[C_IW + lane]);
        LDS_WAIT();
        const int nch = (t >> 6) + 1;
        for (int i = 0; i < nch; ++i) {
            const int s = lane + 64 * i; unsigned key = 0u;
            if (s <= t) {
                const v4u* kr = (const v4u*)(P + (size_t)(b * SEQ + s) * PW + C_IK);
                float kf[64];
#pragma unroll
                for (int j = 0; j < 8; ++j) { const v4u w = kr[j]; kf[8 * j] = pg8::bf_lo(w.x); kf[8 * j + 1] = pg8::bf_hi(w.x); kf[8 * j + 2] = pg8::bf_lo(w.y); kf[8 * j + 3] = pg8::bf_hi(w.y);
                    kf[8 * j + 4] = pg8::bf_lo(w.z); kf[8 * j + 5] = pg8::bf_hi(w.z); kf[8 * j + 6] = pg8::bf_lo(w.w); kf[8 * j + 7] = pg8::bf_hi(w.w); }
                float sc = 0.f;
#pragma unroll
                for (int h = 0; h < 8; ++h) { float x = 0.f;
#pragma unroll
                    for (int d = 0; d < 64; ++d) x += iq[h * 64 + d] * kf[d];
                    sc += iwl[h] * fmaxf(x, 0.f); }
                key = fkey(sc);
            }
            keys[s] = key;
        }
        LDS_WAIT();
        unsigned T = 0u; int need = 0; bool all = (t + 1 <= 256);
        if (!all) {
            for (int bit = 31; bit >= 0; --bit) { const unsigned cand = T | (1u << bit); int cnt = 0;
                for (int i = 0; i < nch; ++i) cnt += __popcll(__ballot(keys[lane + 64 * i] >= cand));
                if (cnt >= 256) T = cand; }
            int cgt = 0;
            for (int i = 0; i < nch; ++i) cgt += __popcll(__ballot(keys[lane + 64 * i] > T));
            need = 256 - cgt;
        }
        for (int i = 0; i < 32; ++i) {
            unsigned long long selb = 0ull;
            if (i < nch) {
                const unsigned key = keys[lane + 64 * i];
                if (all) selb = __ballot(key != 0u);
                else { const unsigned long long gt = __ballot(key > T), eq = __ballot(key == T); const int ne = __popcll(eq);
                    unsigned long long take = eq;
                    if (ne > need) { const int rk = __popcll(eq & ((1ull << lane) - 1ull)); take = __ballot(((eq >> lane) & 1ull) && rk < need); }
                    need -= (ne < need ? ne : need); selb = gt | take; }
            }
            if (lane < 2) { const unsigned w = (unsigned)(selb >> (32 * lane)); unsigned wp = 0u;
#pragma unroll
                for (int n = 0; n < 8; ++n) wp |= ((w >> (4 * n)) & 0xFu) << (4 * ((n & 1) * 4 + (n >> 1)));
                DMK[((size_t)(b * 64 + 2 * i + lane)) * SEQ + t] = wp; }
        }
    }
}
template <int NH> __device__ __forceinline__ void dots64(const bf16* krow, const LAS float* qs, float (&out)[NH]) {
    const v4u* kr = (const v4u*)krow; float kf[64];
#pragma unroll
    for (int j = 0; j < 8; ++j) { const v4u w = kr[j]; kf[8 * j] = pg8::bf_lo(w.x); kf[8 * j + 1] = pg8::bf_hi(w.x); kf[8 * j + 2] = pg8::bf_lo(w.y); kf[8 * j + 3] = pg8::bf_hi(w.y);
        kf[8 * j + 4] = pg8::bf_lo(w.z); kf[8 * j + 5] = pg8::bf_hi(w.z); kf[8 * j + 6] = pg8::bf_lo(w.w); kf[8 * j + 7] = pg8::bf_hi(w.w); }
#pragma unroll
    for (int h = 0; h < NH; ++h) { float x = 0.f;
#pragma unroll
        for (int d = 0; d < 64; ++d) x += qs[h * 64 + d] * kf[d];
        out[h] = x; }
}
__device__ __forceinline__ void softmax_lds(LAS float* sc, int n, int lane) {
    float m = -INFINITY;
    for (int k = lane; k < n; k += 64) m = fmaxf(m, sc[k]);
    m = wave_max(m);
    if (m == -INFINITY) { for (int k = lane; k < n; k += 64) sc[k] = 0.f; LDS_WAIT(); return; }
    float s = 0.f;
    for (int k = lane; k < n; k += 64) { const float p = __expf(sc[k] - m); sc[k] = p; s += p; }
    s = wave_sum(s); const float inv = 1.0f / fmaxf(s, 1e-30f);
    for (int k = lane; k < n; k += 64) sc[k] *= inv;
    LDS_WAIT();
}
__device__ __forceinline__ void nsa_naive(Ctx& C0) {
    Ctx C = C0; asm volatile("" : "+v"(C.tid), "+v"(C.lane), "+s"(C.wave)); __syncthreads();
    constexpr int WSTR = 17664;
    LAS float* wl = (LAS float*)(C.lds + POOL_OFF + C.wave * WSTR);
    LAS float* q4 = wl; LAS float* sc = wl + 256; LAS int* segs = (LAS int*)(wl + 256 + 4096);
    const bf16* P = (const bf16*)(AWS + WS_P); bf16* O = (bf16*)(AWS + WS_R1);
    const float* KC = (const float*)(AWS + WS_KC); const float* VC = KC + (size_t)NB * 2 * 128 * 64;
    const int lane = C.lane;
    for (int u = blockIdx.x; u < NB * 256; u += C.G) {
        const int b = u >> 8, t = ((u & 255) << 3) + C.wave;
        const bf16* Pb = P + (size_t)b * SEQ * PW; const bf16* Prow = Pb + (size_t)t * PW;
        for (int g = 0; g < 2; ++g) {
#pragma unroll
            for (int r = 0; r < 4; ++r) q4[r * 64 + lane] = bf2f(Prow[C_NQ + (4 * g + r) * 64 + lane]);
            LDS_WAIT();
            float oacc[4] = {0.f, 0.f, 0.f, 0.f};
            const float* kc = KC + (size_t)(b * 2 + g) * 128 * 64; const float* vc = VC + (size_t)(b * 2 + g) * 128 * 64;
            const int ncadm = (t >= 31) ? (((t - 31) >> 4) + 1 < 127 ? ((t - 31) >> 4) + 1 : 127) : 0;
#pragma unroll
            for (int hf = 0; hf < 2; ++hf) { const int c = lane + 64 * hf; float s4[4] = {-INFINITY, -INFINITY, -INFINITY, -INFINITY};
                if (c < ncadm) { const f32x4* kr = (const f32x4*)(kc + c * 64); float a[4] = {0.f, 0.f, 0.f, 0.f};
                    for (int j = 0; j < 16; ++j) { const f32x4 kk = kr[j];
#pragma unroll
                        for (int r = 0; r < 4; ++r) a[r] += q4[r * 64 + 4 * j] * kk.x + q4[r * 64 + 4 * j + 1] * kk.y + q4[r * 64 + 4 * j + 2] * kk.z + q4[r * 64 + 4 * j + 3] * kk.w; }
#pragma unroll
                    for (int r = 0; r < 4; ++r) s4[r] = a[r] * 0.125f; }
#pragma unroll
                for (int r = 0; r < 4; ++r) sc[r * 1024 + c] = s4[r]; }
            LDS_WAIT();
#pragma unroll
            for (int r = 0; r < 4; ++r) softmax_lds(sc + r * 1024, 128, lane);
            float oc[4] = {0.f, 0.f, 0.f, 0.f};
            for (int c = 0; c < ncadm; ++c) { const float v = vc[c * 64 + lane];
#pragma unroll
                for (int r = 0; r < 4; ++r) oc[r] += sc[r * 1024 + c] * v; }
            float imp = 0.f;
            if (lane < 32) {
#pragma unroll
                for (int r = 0; r < 4; ++r) { const LAS float* p = sc + r * 1024; const int c0 = 4 * lane;
                    imp += p[c0] + p[c0 + 1] + p[c0 + 2] + 0.5f * p[c0 + 3] + (lane > 0 ? 0.5f * p[c0 - 1] : 0.f); }
            }
            const int cur = t >> 6; unsigned selmask;
            { const int j = lane & 31; const bool adm = (64 * j <= t); const bool forced = (j == 0) || (cur - j >= 0 && cur - j < 2);
                const float myscore = !adm ? -INFINITY : (forced ? 1e4f : imp); int rank = 0;
                for (int i = 0; i < 32; ++i) { const float si = __shfl(myscore, i); rank += (si > myscore || (si == myscore && i < j)) ? 1 : 0; }
                selmask = (unsigned)(__ballot(lane < 32 && rank < 16 && adm) & 0xffffffffull); }
            float gc[4], gs[4], gw[4];
#pragma unroll
            for (int r = 0; r < 4; ++r) { gc[r] = bf2f(Prow[C_NG + 0 * 8 + 4 * g + r]); gs[r] = bf2f(Prow[C_NG + 1 * 8 + 4 * g + r]); gw[r] = bf2f(Prow[C_NG + 2 * 8 + 4 * g + r]); }
#pragma unroll
            for (int r = 0; r < 4; ++r) oacc[r] += gc[r] * oc[r];
            for (int br = 0; br < 2; ++br) {
                int nseg;
                if (br == 0) { nseg = __popc(selmask); if (lane < 32 && ((selmask >> lane) & 1u)) segs[__popc(selmask & ((1u << lane) - 1u))] = 64 * lane; }
                else { nseg = 8; if (lane < 8) segs[lane] = t - 511 + 64 * lane; }
                LDS_WAIT();
                const bf16* Kb = Pb + (br == 0 ? C_KSLC : C_KWIN) + g * 64; const bf16* Vb = Pb + (br == 0 ? C_VSLC : C_VWIN) + g * 64;
                for (int sg = 0; sg < nseg; ++sg) { const int key = segs[sg] + lane; float s4[4] = {-INFINITY, -INFINITY, -INFINITY, -INFINITY};
                    if (key >= 0 && key <= t) { float d4[4]; dots64<4>(Kb + (size_t)key * PW, q4, d4);
#pragma unroll
                        for (int r = 0; r < 4; ++r) s4[r] = d4[r] * 0.125f; }
#pragma unroll
                    for (int r = 0; r < 4; ++r) sc[r * 1024 + sg * 64 + lane] = s4[r]; }
                LDS_WAIT();
#pragma unroll
                for (int r = 0; r < 4; ++r) softmax_lds(sc + r * 1024, nseg * 64, lane);
                float ob[4] = {0.f, 0.f, 0.f, 0.f};
                for (int sg = 0; sg < nseg; ++sg) { const int k0 = segs[sg];
                    for (int kk = 0; kk < 64; ++kk) { const int key = k0 + kk; if (key < 0 || key > t) continue;
                        const float v = bf2f(Vb[(size_t)key * PW + lane]);
#pragma unroll
                        for (int r = 0; r < 4; ++r) ob[r] += sc[r * 1024 + sg * 64 + kk] * v; } }
#pragma unroll
                for (int r = 0; r < 4; ++r) oacc[r] += (br == 0 ? gs[r] : gw[r]) * ob[r];
            }
#pragma unroll
            for (int r = 0; r < 4; ++r) O[(size_t)(b * SEQ + t) * 1024 + (4 * g + r) * 64 + lane] = (bf16)f2bf(oacc[r]);
        }
    }
}
__device__ __forceinline__ void dsa_naive(Ctx& C0) {
    Ctx C = C0; asm volatile("" : "+v"(C.tid), "+v"(C.lane), "+s"(C.wave)); __syncthreads();
    constexpr int WSTR = 2560;
    LAS float* wl = (LAS float*)(C.lds + POOL_OFF + C.wave * WSTR);
    LAS float* qs = wl; LAS float* pl = wl + 64; LAS int* list = (LAS int*)(wl + 64 + 256);
    const bf16* P = (const bf16*)(AWS + WS_P); bf16* O = (bf16*)(AWS + WS_R1); const unsigned* DMK = (const unsigned*)(AWS + WS_DMASK);
    const int lane = C.lane;
    for (int u = blockIdx.x; u < NB * 256; u += C.G) {
        const int b = u >> 8, t = ((u & 255) << 3) + C.wave;
        const bf16* Pb = P + (size_t)b * SEQ * PW; const bf16* Prow = Pb + (size_t)t * PW;
        int nsel = 0;
        for (int i = 0; i <= (t >> 6); ++i) { const int kt = 2 * i + (lane >> 5), s = 64 * i + lane;
            const unsigned w = DMK[(size_t)(b * 64 + kt) * SEQ + t];
            const bool sel = ((w >> mask_bitpos(lane & 31)) & 1u) && (s <= t);
            const unsigned long long bm = __ballot(sel);
            if (sel) { const int pos = nsel + __popcll(bm & ((1ull << lane) - 1ull)); if (pos < 256) list[pos] = s; }
            nsel += __popcll(bm); }
        if (nsel > 256) nsel = 256;
        LDS_WAIT();
        for (int h = 0; h < 8; ++h) {
            qs[lane] = bf2f(Prow[C_DQ + h * 64 + lane]); LDS_WAIT();
#pragma unroll
            for (int j = 0; j < 4; ++j) { const int k = lane + 64 * j; float s = -INFINITY;
                if (k < nsel) { float d1[1]; dots64<1>(Pb + (size_t)list[k] * PW + C_DK + h * 64, qs, d1); s = d1[0] * 0.125f; }
                pl[k] = s; }
            LDS_WAIT();
            softmax_lds(pl, 256, lane);
            float o = 0.f;
            for (int k = 0; k < nsel; ++k) o += pl[k] * bf2f(Pb[(size_t)list[k] * PW + C_DV + h * 64 + lane]);
            O[(size_t)(b * SEQ + t) * 1024 + 512 + h * 64 + lane] = (bf16)f2bf(o);
        }
    }
}
__device__ __forceinline__ void final_norm(Ctx& C0) {
    Ctx C = C0; asm volatile("" : "+v"(C.tid), "+v"(C.lane), "+s"(C.wave)); __syncthreads();
    const float* gn = AIN(20); const int lane = C.lane; const float* rss = (const float*)(AWS + WS_RSS);
    f32x4 g[4];
#pragma unroll
    for (int j = 0; j < 4; ++j) g[j] = ((const f32x4*)gn)[lane + 64 * j];
    for (int m = blockIdx.x * NWAVES + C.wave; m < MTOK; m += C.G * NWAVES) {
        GAS f32x4* xr = (GAS f32x4*)(AOUT + (size_t)m * DM) + lane;
        const float rs = pg8::row_rstd(rss, m);
#pragma unroll
        for (int j = 0; j < 4; ++j) xr[64 * j] = xr[64 * j] * rs * g[j];
    }
}
#ifndef MK_N_LAUNCHES
#define MK_N_LAUNCHES 18
#endif
constexpr int NPH = 18;
constexpr int N_LAUNCHES = MK_N_LAUNCHES;
__global__ void __launch_bounds__(NTHR, 2) hybrid_fwd(Args args) {
    extern __shared__ __attribute__((aligned(16))) unsigned char lds_raw[];
    Ctx C;
    C.lds = (LAS unsigned char*)lds_raw; C.tid = threadIdx.x; C.lane = C.tid & 63; C.wave = __builtin_amdgcn_readfirstlane(C.tid >> 6); C.G = gridDim.x;
    gu32* ctl = (gu32*)(AWS + WS_CTL);
    for (int u = C.tid; u < POOL_OFF / 4; u += NTHR) ((LAS unsigned*)(C.lds + LDSCTL_OFF))[u] = 0u;
    __syncthreads();
    volatile LAS unsigned* MISC = (volatile LAS unsigned*)(C.lds + MISC_OFF);
    XcdBarrier bar; bar.bar = (unsigned*)(ctl + CW_BAR); bar.x = 0; bar.st = nullptr;
    if (N_LAUNCHES == 1) bar = xcd_barrier_post((unsigned*)(ctl + CW_BAR), MISC + 8);
#define GRID_BAR() do { if (N_LAUNCHES == 1) xcd_barrier(bar); } while (0)
    const int lo = kargs()->ph_lo, hi = kargs()->ph_hi;
#ifndef PH_EN
#define PH_EN 0xFFFFFFFFu
#endif
#define IN(k) (((PH_EN >> ((k) > 8 ? ((k) - 8 > 8 ? 17 : (k) - 8) : (k))) & 1u) && lo <= (k) && (k) < hi)
#define BOTH(k) (IN(k) && IN((k) + 1))
    LAS unsigned char* ring = C.lds + POOL_OFF;
    bf16* XG = (bf16*)(AWS + WS_R1); bf16* OB = XG; bf16* P = (bf16*)(AWS + WS_P); bf16* H = P;
    float* rss = (float*)(AWS + WS_RSS);
    const float* rcos = (const float*)(AWS + WS_ROPE); const float* rsin = rcos + 2048 * 8;

    if (IN(0)) { p0_prologue(C); if (BOTH(0)) GRID_BAR(); }
    for (int l = 0; l < DEPTH; ++l) {
        const int pb = 1 + 8 * l;
        if (IN(pb)) {
            pg8::Gemm g{XG, (const bf16*)(AWS + WS_WIN + l * SZ_WIN), MTOK, PW, DM, DM, DM}; pg8::StaticOrder S; S.init(MTOK, PW, C.G, (int)blockIdx.x);
            pg8::EpiProj E{P, rss, rcos, rsin};
            pg8::gemm_phase<pg8::EpiProj, pg8::StaticOrder, true, true>(ring, g, S, E);
            if (BOTH(pb)) GRID_BAR();
        }
        if (IN(pb + 1)) { compress_naive(C, l); idx_naive(C); if (BOTH(pb + 1)) GRID_BAR(); }
        if (IN(pb + 2)) { nsa_naive(C); dsa_naive(C); if (BOTH(pb + 2)) GRID_BAR(); }
        if (IN(pb + 3)) {
            pg8::Gemm g{OB, (const bf16*)(AWS + WS_WBN + l * SZ_WBR), MTOK, DM, 512, DM, 512}; pg8::StaticOrder S; S.init(MTOK, DM, C.G, (int)blockIdx.x);
            pg8::EpiBranch<0> E{P + C_GN, nullptr, P + C_TMP};
            pg8::gemm_phase<pg8::EpiBranch<0>, pg8::StaticOrder, true, true>(ring, g, S, E);
            if (BOTH(pb + 3)) GRID_BAR();
        }
        if (IN(pb + 4)) {
            pg8::Gemm g{OB + 512, (const bf16*)(AWS + WS_WBD + l * SZ_WBR), MTOK, DM, 512, DM, 512}; pg8::StaticOrder S; S.init(MTOK, DM, C.G, (int)blockIdx.x);
            pg8::EpiBranch<1> E{P + C_GD, P + C_TMP, P + C_MRG};
            pg8::gemm_phase<pg8::EpiBranch<1>, pg8::StaticOrder, true, true>(ring, g, S, E);
            if (BOTH(pb + 4)) GRID_BAR();
        }
        if (IN(pb + 5)) {
            pg8::Gemm g{P + C_MRG, (const bf16*)(AWS + WS_WOUT + l * SZ_WOUT), MTOK, DM, DM, PW, DM}; pg8::StaticOrder S; S.init(MTOK, DM, C.G, (int)blockIdx.x);
            pg8::EpiResid E{l == 0 ? AIN(0) : AOUT, AOUT, AIN(16) + l * DM, XG, rss};
            pg8::gemm_phase<pg8::EpiResid, pg8::StaticOrder, true, true>(ring, g, S, E);
            if (BOTH(pb + 5)) GRID_BAR();
        }
        if (IN(pb + 6)) {
            pg8::Gemm g{XG, (const bf16*)(AWS + WS_WGU + l * SZ_WGU), MTOK, PW, DM, DM, DM}; pg8::StaticOrder S; S.init(MTOK, PW, C.G, (int)blockIdx.x);
            pg8::EpiSwiglu E{H, rss};
            pg8::gemm_phase<pg8::EpiSwiglu, pg8::StaticOrder, true, true>(ring, g, S, E);
            if (BOTH(pb + 6)) GRID_BAR();
        }
        if (IN(pb + 7)) {
            pg8::Gemm g{H, (const bf16*)(AWS + WS_WDN + l * SZ_WDN), MTOK, DM, DFF, DFF, DFF}; pg8::StaticOrder S; S.init(MTOK, DM, C.G, (int)blockIdx.x);
            pg8::EpiResid E{AOUT, AOUT, (l + 1 < DEPTH) ? AIN(1) + (l + 1) * DM : nullptr, XG, rss};
            pg8::gemm_phase<pg8::EpiResid, pg8::StaticOrder, true, true>(ring, g, S, E);
            if (BOTH(pb + 7)) GRID_BAR();
        }
    }
    if (IN(17)) final_norm(C);
#undef IN
#undef BOTH
}

extern "C" void kernel_launch(void* const* d_in, const int* in_sizes, int n_in, void* d_out, int out_size, void* d_ws, size_t ws_size, hipStream_t stream) {
    static int grid = 0;
    if (grid == 0) {
        if (n_in != 21 || out_size != MTOK * DM || ws_size < WS_END) { fprintf(stderr, "kernel_launch: unexpected shapes (n_in %d out %d ws %zu)\n", n_in, out_size, ws_size); grid = -1; return; }
        int dev = 0, cus = 0, per_cu = 0;
        if (hipGetDevice(&dev) != hipSuccess || hipDeviceGetAttribute(&cus, hipDeviceAttributeMultiprocessorCount, dev) != hipSuccess) { grid = -1; return; }
        if (hipFuncSetAttribute((const void*)hybrid_fwd, hipFuncAttributeMaxDynamicSharedMemorySize, LDS_BYTES) != hipSuccess) { fprintf(stderr, "kernel_launch: hipFuncSetAttribute failed\n"); grid = -1; return; }
        if (hipOccupancyMaxActiveBlocksPerMultiprocessor(&per_cu, (const void*)hybrid_fwd, NTHR, LDS_BYTES) != hipSuccess || per_cu < 1) fprintf(stderr, "kernel_launch: occupancy query reports %d\n", per_cu);
        (void)hipGetLastError();
        grid = cus;
    }
    if (grid < 0) return;
    (void)hipMemsetAsync((char*)d_ws + WS_CTL, 0, CTL_ZERO_BYTES, stream);
    Args a{};
    for (int i = 0; i < 21; ++i) a.in[i] = (const float*)d_in[i];
    a.out = (float*)d_out; a.ws = (unsigned char*)d_ws;
    for (int li = 0; li < N_LAUNCHES; ++li) {
        a.ph_lo = (N_LAUNCHES == 1) ? 0 : li; a.ph_hi = (N_LAUNCHES == 1) ? NPH : li + 1; a.li = li;
        hipLaunchKernelGGL(hybrid_fwd, dim3(grid), dim3(NTHR), LDS_BYTES, stream, a);
    }
}
```

```cpp
#include <hip/hip_runtime.h>
#include <cstdio>
#include <cstdint>
namespace pg8 {
#define PG8_LAS __attribute__((address_space(3)))
typedef unsigned short bf16_t;
typedef short bf16x8 __attribute__((ext_vector_type(8)));
typedef float f32x4 __attribute__((ext_vector_type(4)));
typedef unsigned u32x4 __attribute__((ext_vector_type(4)));
constexpr int BM = 256, BK = 64, HALF = 128, HTB = HALF * BK * 2  , STAGE_BYTES = 8 * HTB, NXCD = 8, WGM = 8;

__host__ __device__ __forceinline__ int lds_byte(int r, int c) { const int st = (r >> 4) * 2 + (c >> 5), rr = r & 15, cc = c & 31, ob = rr * 64 + cc * 2; return st * 1024 + (ob ^ (((ob >> 9) & 1) << 5)); }
__host__ __device__ __forceinline__ void stage_rc(int b, int& R, int& C) { const int st = b / 1024, sb = b % 1024, swz = sb ^ (((sb >> 9) & 1) << 5); R = (st >> 1) * 16 + swz / 64; C = (st & 1) * 32 + (swz % 64) / 2; }
__host__ __device__ __forceinline__ int perm32(int rho) { const int n = rho >> 4, i = rho & 15; return 8 * (i >> 2) + 4 * n + (i & 3); }

struct Unit { int pm, pn, z; };
struct Gemm { const bf16_t* A; const bf16_t* Bt; int M, N, K, lda, ldb; const bf16_t* A2; const bf16_t* Bt2; };

struct StaticOrder {
    int nM, nN, nwg, G, c;
    __host__ __device__ void init(int M, int N, int G_, int c_) { nM = M / BM; nN = N / BM; nwg = nM * nN; G = G_; c = c_; }
    __host__ __device__ bool next(int i, Unit& u) const {
        const long L = (long)i * G + c; if (L >= nwg) return false;
        int wgid = (int)L; { const int q = nwg / NXCD, r = nwg % NXCD, xcd = wgid % NXCD, off = wgid / NXCD; wgid = (xcd < r ? xcd * (q + 1) : r * (q + 1) + (xcd - r) * q) + off; }
        const int nig = WGM * nN, gid = wgid / nig, fm = gid * WGM, gsz = (nM - fm) < WGM ? (nM - fm) : WGM;
        u.pm = fm + ((wgid % nig) % gsz); u.pn = (wgid % nig) / gsz; u.z = 0; return true;
    }
    __device__ __forceinline__ void a_ready(const Unit&) const {}
    __device__ __forceinline__ void done(const Unit&) const {}
};
struct DualOrder {
    StaticOrder S;
    __host__ __device__ void init(int M, int N, int G_, int c_) { S.init(M, N, G_, c_); }
    __host__ __device__ bool next(int i, Unit& u) const { if (!S.next(i >> 1, u)) return false; u.z = i & 1; return true; }
    __device__ __forceinline__ void a_ready(const Unit&) const {}
    __device__ __forceinline__ void done(const Unit&) const {}
};

__device__ __forceinline__ unsigned cvt_pk_bf16(float lo, float hi) { unsigned r; asm volatile("v_cvt_pk_bf16_f32 %0, %1, %2" : "=v"(r) : "v"(lo), "v"(hi)); return r; }
__device__ __forceinline__ float bf_lo(unsigned w) { return __uint_as_float(w << 16); }
__device__ __forceinline__ float bf_hi(unsigned w) { return __uint_as_float(w & 0xffff0000u); }
__device__ __forceinline__ float sigmoidf_(float x) { return __builtin_amdgcn_rcpf(1.0f + __builtin_amdgcn_exp2f(x * -1.4426950408889634f)); }
constexpr int PW = 5632;
constexpr float RMS_EPS = 1e-6f;
__device__ __forceinline__ float row_rstd(const float* rowss, int row) {
    const f32x4* p = (const f32x4*)(rowss + (size_t)row * 16);
    const f32x4 a = p[0], b = p[1], c = p[2], d = p[3];
    const float s = ((a[0] + a[1]) + (a[2] + a[3])) + ((b[0] + b[1]) + (b[2] + b[3])) + ((c[0] + c[1]) + (c[2] + c[3])) + ((d[0] + d[1]) + (d[2] + d[3]));
    float eps; asm volatile("s_mov_b32 %0, 0x358637bd" : "=s"(eps));
    return __builtin_amdgcn_rsqf(s * (1.0f / 1024.0f) + eps);
}
struct EpiProj {
    static constexpr bool PERM = true, AFTER_DRAIN = false;
    bf16_t* P; const float* rowss; const float* rcos; const float* rsin;
    __device__ __forceinline__ void operator()(const f32x4 (&acc)[2][2][4][2], const Unit& u, int wr, int wc, int fr, int fq) const {
        const int pn = u.pn;
        const bool rope_head = (pn <= 1) || (pn >= 5 && pn <= 8) || (pn == 11) || (pn == 12) || ((pn >= 2 && pn <= 4) && wc < 2) || (pn == 13 && wc == 0);
#pragma unroll
        for (int ai = 0; ai < 2; ++ai)
#pragma unroll
            for (int m = 0; m < 4; ++m) {
                const int row = u.pm * BM + ai * HALF + wr * 64 + m * 16 + fr;
                const float rs = row_rstd(rowss, row) * ((pn <= 1 || pn == 5 || pn == 6) ? 0.18033688011112042f : 1.0f);
                const int pos = row & 2047;
#pragma unroll
                for (int bj = 0; bj < 2; ++bj) {
                    f32x4 v0 = acc[ai][bj][m][0] * rs, v1 = acc[ai][bj][m][1] * rs;
                    if (rope_head && bj == 0) {
                        const f32x4 c0 = *(const f32x4*)(rcos + pos * 8), c1 = *(const f32x4*)(rcos + pos * 8 + 4);
                        const f32x4 s0 = *(const f32x4*)(rsin + pos * 8), s1 = *(const f32x4*)(rsin + pos * 8 + 4);
                        f32x4 p0, p1;
#pragma unroll
                        for (int e = 0; e < 4; ++e) { p0[e] = __shfl_xor(v0[e], 16); p1[e] = __shfl_xor(v1[e], 16); }
                        if (fq == 0) { v0 = v0 * c0 - p0 * s0; v1 = v1 * c1 - p1 * s1; }
                        else if (fq == 1) { v0 = v0 * c0 + p0 * s0; v1 = v1 * c1 + p1 * s1; }
                    }
                    if (pn >= 14) {
#pragma unroll
                        for (int e = 0; e < 4; ++e) { v0[e] = sigmoidf_(v0[e]); v1[e] = sigmoidf_(v1[e]); }
                    } else if (pn == 13 && wc == 1 && bj == 0) {
                        if (fq == 0) { v0 = v0 * 0.044194173824159216f; v1 = v1 * 0.044194173824159216f; }
                        else {
#pragma unroll
                            for (int e = 0; e < 4; ++e) { v0[e] = sigmoidf_(v0[e]); v1[e] = sigmoidf_(v1[e]); }
                        }
                    }
                    u32x4 w; w.x = cvt_pk_bf16(v0[0], v0[1]); w.y = cvt_pk_bf16(v0[2], v0[3]); w.z = cvt_pk_bf16(v1[0], v1[1]); w.w = cvt_pk_bf16(v1[2], v1[3]);
                    *(u32x4*)(P + (size_t)row * PW + pn * BM + wc * 64 + bj * 32 + 8 * fq) = w;
                }
            }
    }
};
struct EpiNull { static constexpr bool PERM = true, AFTER_DRAIN = false;
    __device__ __forceinline__ void operator()(const f32x4 (&acc)[2][2][4][2], const Unit&, int, int, int, int) const {
#pragma unroll
        for (int a = 0; a < 2; ++a)
#pragma unroll
            for (int b = 0; b < 2; ++b)
#pragma unroll
                for (int m = 0; m < 4; ++m) asm volatile("" :: "v"(acc[a][b][m][0]), "v"(acc[a][b][m][1])); } };
struct EpiBranch2 {
    static constexpr bool PERM = true, AFTER_DRAIN = false;
    bf16_t* Pb; int cg0, cg1, ct, co;
    __device__ __forceinline__ void operator()(const f32x4 (&acc)[2][2][4][2], const Unit& u, int wr, int wc, int fr, int fq) const {
        const int cg = u.z ? cg1 : cg0, cst = u.z ? co : ct;
#pragma unroll
        for (int ai = 0; ai < 2; ++ai)
#pragma unroll
            for (int m = 0; m < 4; ++m) {
                const int row = u.pm * BM + ai * HALF + wr * 64 + m * 16 + fr;
#pragma unroll
                for (int bj = 0; bj < 2; ++bj) {
                    const size_t off = (size_t)row * PW + u.pn * BM + wc * 64 + bj * 32 + 8 * fq;
                    const u32x4 gw = __builtin_nontemporal_load((const u32x4*)(Pb + off + cg));
                    f32x4 v0 = acc[ai][bj][m][0], v1 = acc[ai][bj][m][1];
                    v0[0] *= bf_lo(gw.x); v0[1] *= bf_hi(gw.x); v0[2] *= bf_lo(gw.y); v0[3] *= bf_hi(gw.y);
                    v1[0] *= bf_lo(gw.z); v1[1] *= bf_hi(gw.z); v1[2] *= bf_lo(gw.w); v1[3] *= bf_hi(gw.w);
                    if (u.z) { const u32x4 tw = *(const u32x4*)(Pb + off + ct);
                        v0[0] += bf_lo(tw.x); v0[1] += bf_hi(tw.x); v0[2] += bf_lo(tw.y); v0[3] += bf_hi(tw.y);
                        v1[0] += bf_lo(tw.z); v1[1] += bf_hi(tw.z); v1[2] += bf_lo(tw.w); v1[3] += bf_hi(tw.w); }
                    u32x4 w; w.x = cvt_pk_bf16(v0[0], v0[1]); w.y = cvt_pk_bf16(v0[2], v0[3]); w.z = cvt_pk_bf16(v1[0], v1[1]); w.w = cvt_pk_bf16(v1[2], v1[3]);
                    *(u32x4*)(Pb + off + cst) = w;
                }
            }
    }
};
struct EpiResid {
    static constexpr bool PERM = true, AFTER_DRAIN = false;
    bf16_t* X; float* ss;
    __device__ __forceinline__ void operator()(const f32x4 (&acc)[2][2][4][2], const Unit& u, int wr, int wc, int fr, int fq) const {
#pragma unroll
        for (int ai = 0; ai < 2; ++ai)
#pragma unroll
            for (int m = 0; m < 4; ++m) {
                const int row = u.pm * BM + ai * HALF + wr * 64 + m * 16 + fr;
                float q = 0.f;
#pragma unroll
                for (int bj = 0; bj < 2; ++bj) {
                    bf16_t* px = X + (size_t)row * 1024 + u.pn * BM + wc * 64 + bj * 32 + 8 * fq;
                    const u32x4 xw = *(const u32x4*)px;
                    f32x4 v0 = acc[ai][bj][m][0], v1 = acc[ai][bj][m][1];
                    v0[0] += bf_lo(xw.x); v0[1] += bf_hi(xw.x); v0[2] += bf_lo(xw.y); v0[3] += bf_hi(xw.y);
                    v1[0] += bf_lo(xw.z); v1[1] += bf_hi(xw.z); v1[2] += bf_lo(xw.w); v1[3] += bf_hi(xw.w);
                    q += ((v0[0] * v0[0] + v0[1] * v0[1]) + (v0[2] * v0[2] + v0[3] * v0[3])) + ((v1[0] * v1[0] + v1[1] * v1[1]) + (v1[2] * v1[2] + v1[3] * v1[3]));
                    u32x4 w; w.x = cvt_pk_bf16(v0[0], v0[1]); w.y = cvt_pk_bf16(v0[2], v0[3]); w.z = cvt_pk_bf16(v1[0], v1[1]); w.w = cvt_pk_bf16(v1[2], v1[3]);
                    *(u32x4*)px = w;
                }
                q += __shfl_xor(q, 16); q += __shfl_xor(q, 32);
                if (fq == 0) ss[(size_t)row * 16 + u.pn * 4 + wc] = q;
            }
    }
};
struct EpiSwiglu {
    static constexpr bool PERM = true, AFTER_DRAIN = false;
    bf16_t* H; const float* rowss;
    __device__ __forceinline__ void operator()(const f32x4 (&acc)[2][2][4][2], const Unit& u, int wr, int wc, int fr, int fq) const {
#pragma unroll
        for (int ai = 0; ai < 2; ++ai)
#pragma unroll
            for (int m = 0; m < 4; ++m) {
                const int row = u.pm * BM + ai * HALF + wr * 64 + m * 16 + fr;
                const float rs = row_rstd(rowss, row);
                float o[8];
#pragma unroll
                for (int n = 0; n < 2; ++n)
#pragma unroll
                    for (int e = 0; e < 4; ++e) { const float g = acc[ai][0][m][n][e] * rs, uu = acc[ai][1][m][n][e] * rs; o[n * 4 + e] = g * sigmoidf_(g) * uu; }
                u32x4 w; w.x = cvt_pk_bf16(o[0], o[1]); w.y = cvt_pk_bf16(o[2], o[3]); w.z = cvt_pk_bf16(o[4], o[5]); w.w = cvt_pk_bf16(o[6], o[7]);
                *(u32x4*)(H + (size_t)row * 2816 + u.pn * HALF + wc * 32 + 8 * fq) = w;
            }
    }
};
template <class Epi, class Sched, bool ALIGN_EPI = false, bool SP2 = false>
__device__ __forceinline__ void gemm_phase(PG8_LAS unsigned char* lds, const Gemm g, const Sched& S, const Epi& E, int wave_in) {
    int tid_; asm volatile("v_mbcnt_lo_u32_b32 %0, -1, 0\n\tv_mbcnt_hi_u32_b32 %0, -1, %0" : "=v"(tid_)); tid_ += wave_in * 64;
    const int tid = tid_, wid = __builtin_amdgcn_readfirstlane(tid >> 6), lane = tid & 63, wr = wid >> 2, wc = wid & 3, fr = lane & 15, fq = lane >> 4;
    const int K = g.K, nt = K / BK;
    unsigned voffA[2], voffB[2];
#pragma unroll
    for (int i = 0; i < 2; ++i) { int R, C; stage_rc(tid * 16 + i * 8192, R, C); const int Rb = Epi::PERM ? ((R & ~31) + perm32(R & 31)) : R;
        voffA[i] = (unsigned)(R * g.lda + C) * 2u; voffB[i] = (unsigned)(Rb * g.ldb + C) * 2u; }
    const size_t kstep = (size_t)(BK * 2);
    const size_t hstepA = (size_t)HALF * g.lda * 2, hstepB = (size_t)HALF * g.ldb * 2;
    const size_t tstepA = 2 * hstepA, tstepB = 2 * hstepB;
    const unsigned ldsw = (unsigned)wid * 1024u;
    const int aoff = lds_byte(wr * 64 + fr, fq * 8), boff = lds_byte(wc * 32 + fr, fq * 8);
#define PG8_SA(b, h) (((b) * 2 + (h)) * HTB)
#define PG8_SB(b, h) ((4 + (b) * 2 + (h)) * HTB)
#define PG8_STAGE(bufoff, gbase, voff) do { _Pragma("unroll") for (int _i = 0; _i < 2; ++_i) \
        __builtin_amdgcn_global_load_lds((const unsigned*)((const char*)(gbase) + (voff)[_i]), (PG8_LAS unsigned*)(lds + (bufoff) + ldsw + _i * 8192), 16, 0, 0); } while (0)
#define PG8_LDA(dst, b, h) do { _Pragma("unroll") for (int m = 0; m < 4; ++m) _Pragma("unroll") for (int k = 0; k < 2; ++k) dst[m][k] = *(const PG8_LAS bf16x8*)(lds + PG8_SA(b, h) + aoff + m * 2048 + k * 1024); } while (0)
#define PG8_LDB(dst, b, h) do { _Pragma("unroll") for (int n = 0; n < 2; ++n) _Pragma("unroll") for (int k = 0; k < 2; ++k) dst[n][k] = *(const PG8_LAS bf16x8*)(lds + PG8_SB(b, h) + boff + n * 2048 + k * 1024); } while (0)
#define PG8_MMA(ai, bj, At, Bt) do { __builtin_amdgcn_s_setprio(1); _Pragma("unroll") for (int m = 0; m < 4; ++m) _Pragma("unroll") for (int n = 0; n < 2; ++n) _Pragma("unroll") for (int k = 0; k < 2; ++k) \
        acc[ai][bj][m][n] = __builtin_amdgcn_mfma_f32_16x16x32_bf16(Bt[n][k], At[m][k], acc[ai][bj][m][n], 0, 0, 0); __builtin_amdgcn_s_setprio(0); } while (0)
#define PG8_WAIT_V(n) asm volatile("s_waitcnt vmcnt(" #n ")" ::: "memory")
#define PG8_WAIT_L(n) asm volatile("s_waitcnt lgkmcnt(" #n ")" ::: "memory")
#define PG8_BAR __builtin_amdgcn_s_barrier()
#define PG8_SCHED __builtin_amdgcn_sched_barrier(0)
    Unit cur, nxt; int ui = 0;
    if (!S.next(0, cur)) return;
    f32x4 acc[2][2][4][2];
#pragma unroll
    for (int a = 0; a < 2; ++a)
#pragma unroll
        for (int b = 0; b < 2; ++b)
#pragma unroll
            for (int m = 0; m < 4; ++m)
#pragma unroll
                for (int n = 0; n < 2; ++n) acc[a][b][m][n] = (f32x4){0.f, 0.f, 0.f, 0.f};
    bf16x8 At[4][2], B0[2][2], B1[2][2];
    const long dA2 = (const char*)g.A2 - (const char*)g.A, dB2 = (const char*)g.Bt2 - (const char*)g.Bt;
    const char* cA = (const char*)g.A + (cur.z ? dA2 : 0) + (size_t)cur.pm * tstepA; const char* cB = (const char*)g.Bt + (cur.z ? dB2 : 0) + (size_t)cur.pn * tstepB;
    S.a_ready(cur);
    if constexpr (SP2) {
        PG8_STAGE(PG8_SB(0, 0), cB, voffB); PG8_STAGE(PG8_SB(0, 1), cB + hstepB, voffB); PG8_STAGE(PG8_SA(0, 0), cA, voffA); PG8_STAGE(PG8_SA(0, 1), cA + hstepA, voffA);
        if (wr == 1) PG8_BAR;
        PG8_WAIT_V(2); PG8_BAR;
        PG8_STAGE(PG8_SB(1, 0), cB + kstep, voffB); PG8_STAGE(PG8_SA(1, 0), cA + kstep, voffA); PG8_STAGE(PG8_SB(1, 1), cB + hstepB + kstep, voffB);
        PG8_WAIT_V(6); PG8_BAR;
    } else {
        PG8_STAGE(PG8_SB(0, 0), cB, voffB); PG8_STAGE(PG8_SA(0, 0), cA, voffA); PG8_STAGE(PG8_SB(0, 1), cB + hstepB, voffB); PG8_STAGE(PG8_SA(0, 1), cA + hstepA, voffA);
        if (wr == 1) PG8_BAR;
        PG8_WAIT_V(4); PG8_BAR;
        PG8_STAGE(PG8_SB(1, 0), cB + kstep, voffB); PG8_STAGE(PG8_SA(1, 0), cA + kstep, voffA); PG8_STAGE(PG8_SB(1, 1), cB + hstepB + kstep, voffB);
        PG8_WAIT_V(6); PG8_BAR;
    }
    for (;;) {
        const bool has_next = S.next(ui + 1, nxt);
        const char* nA = has_next ? (const char*)g.A + (nxt.z ? dA2 : 0) + (size_t)nxt.pm * tstepA : cA; const char* nB = has_next ? (const char*)g.Bt + (nxt.z ? dB2 : 0) + (size_t)nxt.pn * tstepB : cB;
        for (int t = 0; t < nt; t += 2) {
            const bool last = (t == nt - 2);
            const char* a1 = cA + (size_t)(t + 1) * kstep;
            const char* a2 = last ? nA : cA + (size_t)(t + 2) * kstep; const char* b2 = last ? nB : cB + (size_t)(t + 2) * kstep;
            const char* a3 = a2 + kstep; const char* b3 = b2 + kstep;
            if (last && has_next) S.a_ready(nxt);
            if constexpr (SP2) {
            PG8_LDB(B0, 0, 0); PG8_LDB(B1, 0, 1); PG8_SCHED; PG8_LDA(At, 0, 0); PG8_STAGE(PG8_SA(1, 1), a1 + hstepA, voffA);
            PG8_WAIT_V(8); PG8_WAIT_L(0); PG8_BAR; PG8_MMA(0, 0, At, B0); PG8_MMA(0, 1, At, B1); PG8_BAR; PG8_SCHED;
            PG8_LDA(At, 0, 1); PG8_STAGE(PG8_SB(0, 0), b2, voffB); PG8_STAGE(PG8_SB(0, 1), b2 + hstepB, voffB); PG8_STAGE(PG8_SA(0, 0), a2, voffA);
            PG8_WAIT_V(8); PG8_WAIT_L(0); PG8_BAR; PG8_MMA(1, 0, At, B0); PG8_MMA(1, 1, At, B1); PG8_BAR; PG8_SCHED;
            PG8_LDB(B0, 1, 0); PG8_LDB(B1, 1, 1); PG8_SCHED; PG8_LDA(At, 1, 0); PG8_STAGE(PG8_SA(0, 1), a2 + hstepA, voffA);
            PG8_WAIT_V(8); PG8_WAIT_L(0); PG8_BAR; PG8_MMA(0, 0, At, B0); PG8_MMA(0, 1, At, B1); PG8_BAR; PG8_SCHED;
            PG8_LDA(At, 1, 1); PG8_STAGE(PG8_SB(1, 0), b3, voffB); PG8_STAGE(PG8_SB(1, 1), b3 + hstepB, voffB); PG8_STAGE(PG8_SA(1, 0), a3, voffA);
            PG8_WAIT_V(8); PG8_WAIT_L(0); PG8_BAR; PG8_MMA(1, 0, At, B0); PG8_MMA(1, 1, At, B1); PG8_BAR; PG8_SCHED;
            } else {
            PG8_LDB(B0, 0, 0); PG8_SCHED; PG8_LDA(At, 0, 0); PG8_STAGE(PG8_SA(1, 1), a1 + hstepA, voffA);
            PG8_WAIT_L(8); PG8_BAR; PG8_WAIT_L(0); PG8_MMA(0, 0, At, B0); PG8_BAR; PG8_SCHED;
            PG8_LDB(B1, 0, 1); PG8_STAGE(PG8_SB(0, 0), b2, voffB);
            PG8_BAR; PG8_WAIT_L(0); PG8_MMA(0, 1, At, B1); PG8_BAR;
            PG8_LDA(At, 0, 1); PG8_STAGE(PG8_SA(0, 0), a2, voffA);
            PG8_BAR; PG8_WAIT_L(0); PG8_MMA(1, 0, At, B0); PG8_BAR; PG8_SCHED;
            PG8_STAGE(PG8_SB(0, 1), b2 + hstepB, voffB);
            PG8_WAIT_V(6); PG8_BAR; PG8_MMA(1, 1, At, B1); PG8_BAR;
            PG8_LDB(B0, 1, 0); PG8_SCHED; PG8_LDA(At, 1, 0); PG8_STAGE(PG8_SA(0, 1), a2 + hstepA, voffA);
            PG8_WAIT_L(8); PG8_BAR; PG8_WAIT_L(0); PG8_MMA(0, 0, At, B0); PG8_BAR; PG8_SCHED;
            PG8_LDB(B1, 1, 1); PG8_STAGE(PG8_SB(1, 0), b3, voffB);
            PG8_BAR; PG8_WAIT_L(0); PG8_MMA(0, 1, At, B1); PG8_BAR;
            PG8_LDA(At, 1, 1); PG8_STAGE(PG8_SA(1, 0), a3, voffA);
            PG8_BAR; PG8_WAIT_L(0); PG8_MMA(1, 0, At, B0); PG8_BAR; PG8_SCHED;
            PG8_STAGE(PG8_SB(1, 1), b3 + hstepB, voffB);
            PG8_WAIT_V(6); PG8_BAR; PG8_MMA(1, 1, At, B1); PG8_BAR;
            }
        }
        if constexpr (ALIGN_EPI) { if (wr == 0) PG8_BAR; }
        if constexpr (!Epi::AFTER_DRAIN) { E(acc, cur, wr, wc, fr, fq); S.done(cur); }
        if (!has_next) break;
#pragma unroll
        for (int a = 0; a < 2; ++a)
#pragma unroll
            for (int b = 0; b < 2; ++b)
#pragma unroll
                for (int m = 0; m < 4; ++m)
#pragma unroll
                    for (int n = 0; n < 2; ++n) acc[a][b][m][n] = (f32x4){0.f, 0.f, 0.f, 0.f};
        cur = nxt; cA = nA; cB = nB; ++ui;
        if constexpr (ALIGN_EPI) { if (wr == 1) PG8_BAR; }
    }
    PG8_WAIT_V(0);
    if constexpr (!ALIGN_EPI) { if (wr == 0) PG8_BAR; }
    PG8_BAR;
    if constexpr (Epi::AFTER_DRAIN) { E.fused(acc, cur, wr, wc, fr, fq, lds, wid, lane); S.done(cur); }
#undef PG8_SA
#undef PG8_SB
#undef PG8_STAGE
#undef PG8_LDA
#undef PG8_LDB
#undef PG8_MMA
#undef PG8_WAIT_V
#undef PG8_WAIT_L
#undef PG8_BAR
#undef PG8_SCHED
}
}

constexpr int NB = 16, SEQ = 2048, DM = 1024, MTOK = NB * SEQ, DEPTH = 2, DIN = 5472, DFF = 2816;
using pg8::PW;
constexpr int C_NQ = 0, C_KCMP = 512, C_VCMP = 640, C_KSLC = 768, C_VSLC = 896, C_KWIN = 1024, C_VWIN = 1152, C_DQ = 1280, C_DK = 1792, C_DV = 2304,
              C_IQ = 2816, C_IK = 3328, C_IW = 3392, C_NG = 3400, C_GN = 3584, C_GD = 4608;
constexpr int C_TMP = 0, C_MRG = 1024;
__host__ __device__ __forceinline__ int proj_src_col(int n) {
    if (n < 1280) return n;
    if (n < 2816) return n - 1280 + 1304;
    if (n < 3328) return n - 2816 + 2840;
    if (n < 3392) return n - 3328 + 3352;
    if (n < 3400) return n - 3392 + 3416;
    if (n < 3424) return n - 3400 + 1280;
    if (n < 3584) return -1;
    return n - 3584 + 3424;
}
constexpr size_t MiB = 1u << 20;
constexpr size_t WS_CTL = 0, CTL_ZERO_BYTES = 65536;
constexpr size_t WS_ROPE = 1 * MiB;
constexpr size_t WS_CB1 = WS_ROPE + 131072;
constexpr size_t WS_RSS = 2 * MiB;
constexpr size_t WS_KC = 4 * MiB;
constexpr size_t WS_KCB = 6 * MiB;
constexpr size_t WS_SELM = 7 * MiB;
constexpr size_t WS_DMASK = 8 * MiB;
constexpr size_t WS_WIN = 16 * MiB;
constexpr size_t SZ_WIN = (size_t)PW * DM * 2, SZ_WBR = (size_t)DM * 512 * 2, SZ_WOUT = (size_t)DM * DM * 2, SZ_WGU = (size_t)PW * DM * 2, SZ_WDN = (size_t)DM * DFF * 2;
constexpr size_t WS_WBN = WS_WIN + DEPTH * SZ_WIN, WS_WBD = WS_WBN + DEPTH * SZ_WBR, WS_WOUT = WS_WBD + DEPTH * SZ_WBR, WS_WGU = WS_WOUT + DEPTH * SZ_WOUT, WS_WDN = WS_WGU + DEPTH * SZ_WGU;
constexpr size_t WS_W1B = WS_WDN + DEPTH * SZ_WDN;
constexpr size_t WS_R1 = 88 * MiB;
constexpr size_t WS_P = 152 * MiB;
constexpr size_t WS_END = WS_P + (size_t)MTOK * PW * 2;
static_assert(WS_W1B + 2 * MiB <= WS_R1 && WS_END <= 512 * MiB, "d_ws map");
constexpr int CW_TMO = 0, CW_CODE = 1, CW_BAR = 4096;

constexpr int LDSCTL_OFF = 0, MISC_OFF = 320, POOL_OFF = 1024;
constexpr int LDS_BYTES = 147456, POOL_BYTES = LDS_BYTES - POOL_OFF;
constexpr int NWAVES = 8, NTHR = 512;
#define GAS __attribute__((address_space(1)))
#define LAS __attribute__((address_space(3)))
typedef unsigned short bf16;
typedef unsigned v4u __attribute__((ext_vector_type(4)));
typedef float f32x4 __attribute__((ext_vector_type(4)));
typedef short bf16x8 __attribute__((ext_vector_type(8)));
typedef GAS unsigned gu32;
typedef GAS unsigned long long gu64;
#define RLX_AGENT __ATOMIC_RELAXED, __HIP_MEMORY_SCOPE_AGENT
#define LDS_WAIT() asm volatile("s_waitcnt lgkmcnt(0)" ::: "memory")
#define VM_WAIT() asm volatile("s_waitcnt vmcnt(0)" ::: "memory")
__device__ __forceinline__ unsigned long long rt() { return __builtin_amdgcn_s_memrealtime(); }
__device__ __forceinline__ unsigned f2bf(float f) { unsigned u = __builtin_bit_cast(unsigned, f); return (u + 0x7fffu + ((u >> 16) & 1u)) >> 16; }
__device__ __forceinline__ unsigned pk2(float lo, float hi) { return f2bf(lo) | (f2bf(hi) << 16); }

#define XB_TMO      128
#define XB_XCNT(j)  (256  + 64 * (j))
#define XB_XSUB(j)  (1280 + 64 * (j))
#define XB_XGEN(j)  (2304 + 64 * (j))
#define XB_TOP      3328
#define XB_TOPGEN   3392
#define XCD_BAR_WORDS 3456
#define XB_SPIN_CAP (1u << 18)

__device__ __forceinline__ unsigned xb_ld(unsigned* p)              { return __hip_atomic_load(p, __ATOMIC_RELAXED, __HIP_MEMORY_SCOPE_AGENT); }
__device__ __forceinline__ unsigned xb_add(unsigned* p, unsigned v) { return __hip_atomic_fetch_add(p, v, __ATOMIC_RELAXED, __HIP_MEMORY_SCOPE_AGENT); }
__device__ __forceinline__ unsigned xb_xcc_id() { return (unsigned)__builtin_amdgcn_s_getreg((3 << 11) | 20) & 0xFu; }
#define XB_SPIN(cond, bar) do { unsigned _sp = 0; while (cond) { __builtin_amdgcn_s_sleep(1); \
    if ((++_sp & 255u) == 0u) { if (xb_ld(&(bar)[XB_TMO])) break; if (_sp > XB_SPIN_CAP) { atomicAdd(&(bar)[XB_TMO], 1u); break; } } } } while (0)

struct XcdBarrier {
    unsigned* bar; unsigned x;
    volatile LAS unsigned* st;
};

__device__ __forceinline__ XcdBarrier xcd_barrier_post(unsigned* bar, volatile LAS unsigned* st) {
    XcdBarrier b; b.bar = bar; b.x = xb_xcc_id(); b.st = st;
    if (threadIdx.x == 0) (void)xb_add(&bar[XB_XCNT(b.x)], 1u);
    return b;
}
__device__ __forceinline__ void xcd_barrier_complete(unsigned* bar, unsigned x, unsigned& nloc, unsigned& nx) {
    const unsigned G = gridDim.x * gridDim.y * gridDim.z;
    unsigned sum, cnt, mine, sp = 0u;
    for (;;) {
        sum = 0u; cnt = 0u; mine = 0u;
#pragma unroll
        for (unsigned j = 0; j < 16; ++j) { const unsigned c = xb_ld(&bar[XB_XCNT(j)]); sum += c; cnt += (c > 0u) ? 1u : 0u; mine = (j == x) ? c : mine; }
        if (sum == G) break;
        __builtin_amdgcn_s_sleep(1);
        if ((++sp & 255u) == 0u) { if (xb_ld(&bar[XB_TMO])) break; if (sp > XB_SPIN_CAP) { atomicAdd(&bar[XB_TMO], 1u); break; } }
    }
    nloc = mine > 0u ? mine : 1u; nx = cnt > 0u ? cnt : 1u;
}

__device__ __forceinline__ void xcd_barrier(const XcdBarrier& b) {
    asm volatile("s_waitcnt vmcnt(0)" ::: "memory");
    __syncthreads();
    if (threadIdx.x == 0) {
        unsigned* bar = b.bar;
        __builtin_amdgcn_s_waitcnt(0);
        unsigned nloc = b.st[0], nx = b.st[1];
        if (nloc == 0u) { xcd_barrier_complete(bar, b.x, nloc, nx); b.st[0] = nloc; b.st[1] = nx; }
        const unsigned old = xb_add(&bar[XB_XSUB(b.x)], 1u);
        const unsigned gen = old / nloc;
        if (old + 1u == (gen + 1u) * nloc) {
            __builtin_amdgcn_fence(__ATOMIC_RELEASE, "agent");
            asm volatile("s_waitcnt vmcnt(0)" ::: "memory");
            const unsigned og = xb_add(&bar[XB_TOP], 1u);
            const unsigned tg = og / nx;
            if (og + 1u == (tg + 1u) * nx) xb_add(&bar[XB_TOPGEN], 1u);
            else XB_SPIN(xb_ld(&bar[XB_TOPGEN]) == tg, bar);
            __builtin_amdgcn_fence(__ATOMIC_ACQUIRE, "agent");
            xb_add(&bar[XB_XGEN(b.x)], 1u);
            asm volatile("s_waitcnt vmcnt(0)" ::: "memory");
        } else {
            XB_SPIN(xb_ld(&bar[XB_XGEN(b.x)]) == gen, bar);
            __builtin_amdgcn_fence(__ATOMIC_ACQUIRE, "agent");
            asm volatile("s_waitcnt vmcnt(0)" ::: "memory");
        }
    }
    __syncthreads();
}
struct Args { const float* in[21]; float* out; unsigned char* ws; int ph_lo, ph_hi, li, pad; };
struct Ctx { LAS unsigned char* lds; int tid, lane, wave, G; };
typedef const __attribute__((address_space(4))) Args* KArgs;
__device__ __forceinline__ KArgs kargs() { KArgs p = (KArgs)__builtin_amdgcn_kernarg_segment_ptr(); asm volatile("" : "+s"(p)); return p; }
__device__ __forceinline__ int fresh_tid(const Ctx& C0) { int ln; asm volatile("v_mbcnt_lo_u32_b32 %0, -1, 0\n\tv_mbcnt_hi_u32_b32 %0, -1, %0" : "=v"(ln)); return C0.wave * 64 + ln; }
#define AIN(i) (kargs()->in[i])
#define AOUT (kargs()->out)
#define AWS (kargs()->ws)
__device__ __forceinline__ float bf2f(bf16 b) { return __uint_as_float((unsigned)b << 16); }
__device__ __forceinline__ float wave_sum(float v) {
#pragma unroll
    for (int o = 1; o < 64; o <<= 1) v += __shfl_xor(v, o);
    return v;
}
__device__ __forceinline__ float wave_max(float v) {
#pragma unroll
    for (int o = 1; o < 64; o <<= 1) v = fmaxf(v, __shfl_xor(v, o));
    return v;
}
__host__ __device__ __forceinline__ int mask_bitpos(int u) { return (u & 3) + 4 * (u >> 3) + 16 * ((u >> 2) & 1); }

__device__ __forceinline__ void p0_transpose_item(const float* srcp, int Ns, bf16* WT, int K, int k0, int n0, LAS float* scr, int lane, const float* gk = nullptr) {
    float tv[32];
#pragma unroll
    for (int i = 0; i < 32; ++i) { const int kk = 2 * i + (lane >> 5); tv[i] = srcp ? __builtin_nontemporal_load(srcp + (size_t)(k0 + kk) * Ns) : 0.f; }
#pragma unroll
    for (int i = 0; i < 32; ++i) { const int kk = 2 * i + (lane >> 5); scr[kk * 33 + (lane & 31)] = gk ? tv[i] * gk[k0 + kk] : tv[i]; }
    LDS_WAIT(); asm volatile("" ::: "memory");
    const int c = lane & 7;
#pragma unroll
    for (int j = 0; j < 4; ++j) { const int n = (lane >> 3) + 8 * j; const LAS float* s = scr + (8 * c) * 33 + n;
        v4u o; o.x = pk2(s[0 * 33], s[1 * 33]); o.y = pk2(s[2 * 33], s[3 * 33]); o.z = pk2(s[4 * 33], s[5 * 33]); o.w = pk2(s[6 * 33], s[7 * 33]);
        *(GAS v4u*)(WT + (size_t)(n0 + n) * K + k0 + 8 * c) = o; }
    LDS_WAIT(); asm volatile("" ::: "memory");
}
__device__ __forceinline__ void sincos_small(double r, double& s, double& c) {
    const double r2 = r * r; double ts = 1.0, tc = 1.0, ss = 1.0, cc = 1.0;
#pragma unroll
    for (int k = 1; k <= 14; ++k) { tc = -tc * r2 * (1.0 / (double)((2 * k - 1) * (2 * k))); ts = -ts * r2 * (1.0 / (double)((2 * k) * (2 * k + 1))); cc += tc; ss += ts; }
    s = r * ss; c = cc;
}
__device__ __forceinline__ void p0_prologue(Ctx& C0) {
    Ctx C = C0; C.tid = fresh_tid(C0); C.lane = C.tid & 63;
    LAS float* scr = (LAS float*)(C.lds + POOL_OFF + C.wave * 16384);
    const int gw = blockIdx.x * NWAVES + C.wave, NGW = C.G * NWAVES, lane = C.lane;
    constexpr int I_WIN = 16 * (PW / 32), I_WBR = 8 * 32, I_WOUT = 16 * 32, I_WGU = 16 * (PW / 32), I_WDN = 44 * 32, I_L = I_WIN + 2 * I_WBR + I_WOUT + I_WGU + I_WDN;
    for (int it = gw; it < DEPTH * I_L; it += NGW) {
        const int l = it / I_L; int r = it % I_L;
        if (r < I_WIN) { const int nblk = PW / 32, kb = r / nblk, nb = r % nblk, n = nb * 32 + (lane & 31), rho = n & 255,
                sc = proj_src_col((n & ~255) + 64 * ((rho >> 5) & 3) + 32 * (rho >> 7) + (rho & 31));
            p0_transpose_item(sc >= 0 ? AIN(2) + (size_t)l * DM * DIN + sc : nullptr, DIN, (bf16*)(AWS + WS_WIN + l * SZ_WIN), DM, kb * 64, nb * 32, scr, lane, AIN(1) + l * DM); continue; } r -= I_WIN;
        if (r < I_WBR) { const int kb = r / 32, nb = r % 32, n0_ = nb * 32 + (lane & 31), rho = n0_ & 255, n = (n0_ & ~255) + 64 * ((rho >> 5) & 3) + 32 * (rho >> 7) + (rho & 31);
            p0_transpose_item(AIN(13) + (size_t)l * 512 * DM + n, DM, (bf16*)(AWS + WS_WBN + l * SZ_WBR), 512, kb * 64, nb * 32, scr, lane); continue; } r -= I_WBR;
        if (r < I_WBR) { const int kb = r / 32, nb = r % 32, n0_ = nb * 32 + (lane & 31), rho = n0_ & 255, n = (n0_ & ~255) + 64 * ((rho >> 5) & 3) + 32 * (rho >> 7) + (rho & 31);
            p0_transpose_item(AIN(14) + (size_t)l * 512 * DM + n, DM, (bf16*)(AWS + WS_WBD + l * SZ_WBR), 512, kb * 64, nb * 32, scr, lane); continue; } r -= I_WBR;
        if (r < I_WOUT) { const int kb = r / 32, nb = r % 32, n0_ = nb * 32 + (lane & 31), rho = n0_ & 255, n = (n0_ & ~255) + 64 * ((rho >> 5) & 3) + 32 * (rho >> 7) + (rho & 31);
            p0_transpose_item(AIN(15) + (size_t)l * DM * DM + n, DM, (bf16*)(AWS + WS_WOUT + l * SZ_WOUT), DM, kb * 64, nb * 32, scr, lane); continue; } r -= I_WOUT;
        if (r < I_WGU) { const int nblk = PW / 32, kb = r / nblk, nb = r % nblk, n = nb * 32 + (lane & 31), j = n & 255, hcol = (n >> 8) * 128 + (j & 127);
            const float* src = (j < 128 ? AIN(17) : AIN(18)) + (size_t)l * DM * DFF + hcol;
            p0_transpose_item(src, DFF, (bf16*)(AWS + WS_WGU + l * SZ_WGU), DM, kb * 64, nb * 32, scr, lane, AIN(16) + l * DM); continue; } r -= I_WGU;
        { const int kb = r / 32, nb = r % 32, n0_ = nb * 32 + (lane & 31), rho = n0_ & 255, n = (n0_ & ~255) + 64 * ((rho >> 5) & 3) + 32 * (rho >> 7) + (rho & 31);
            p0_transpose_item(AIN(19) + (size_t)l * DFF * DM + n, DM, (bf16*)(AWS + WS_WDN + l * SZ_WDN), DFF, kb * 64, nb * 32, scr, lane); }
    }
    for (int it = gw; it < DEPTH * 2 * 32 * 4; it += NGW) {
        const int l = it / 256, r = it % 256, kv = r / 128, kb = (r % 128) / 4, nb = r % 4, n = nb * 32 + (lane & 31);
        p0_transpose_item(AIN(kv ? 9 : 4) + (size_t)l * 2048 * 128 + n, 128, (bf16*)(AWS + WS_W1B) + (size_t)(l * 2 + kv) * 128 * 2048, 2048, kb * 64, nb * 32, scr, lane);
    }
    {
        bf16* XG = (bf16*)(AWS + WS_R1); float* rss = (float*)(AWS + WS_RSS);
        const float* xin = AIN(0);
        for (int m0 = gw * 2; m0 < MTOK; m0 += NGW * 2) {
            f32x4 v[2][4];
#pragma unroll
            for (int rr = 0; rr < 2; ++rr)
#pragma unroll
                for (int j = 0; j < 4; ++j) v[rr][j] = __builtin_nontemporal_load((const GAS f32x4*)(xin + (size_t)(m0 + rr) * DM) + lane + 64 * j);
#pragma unroll
            for (int rr = 0; rr < 2; ++rr) { const int m = m0 + rr;
                GAS unsigned long long* o8 = (GAS unsigned long long*)(XG + (size_t)m * DM) + lane;
                float s = 0.f;
#pragma unroll
                for (int j = 0; j < 4; ++j) { const f32x4 vv = v[rr][j]; s += (vv.x * vv.x + vv.y * vv.y) + (vv.z * vv.z + vv.w * vv.w); const f32x4 y = vv;
                    o8[64 * j] = (unsigned long long)pk2(y.x, y.y) | ((unsigned long long)pk2(y.z, y.w) << 32); }
                s = wave_sum(s);
                if (lane < 16) rss[(size_t)m * 16 + lane] = (lane == 0) ? s : 0.f; }
        }
    }
    {
        float* rc = (float*)(AWS + WS_ROPE); float* rsn = rc + 2048 * 8;
        const float invf[8] = {1.0f, 0.1939227432012558f, 0.03760603070259094f, 0.007292664609849453f, 0.0014142135623842478f, 0.00027424818836152554f, 5.3182957344688475e-05f, 1.0313385246263351e-05f};
        for (int i = blockIdx.x * NTHR + C.tid; i < 2048 * 8; i += C.G * NTHR) {
            const int pos = i >> 3, j = i & 7; float f = invf[0];
#pragma unroll
            for (int q = 1; q < 8; ++q) f = (j == q) ? invf[q] : f;
            const float ang = (float)pos * f; const double a = (double)ang;
            const double k = __builtin_rint(a * 0.15915494309189535); const double r = (a - k * 6.283185307179586) - k * 2.4492935982947064e-16;
            double s, c; sincos_small(r, s, c);
            rc[i] = (float)c; rsn[i] = (float)s;
        }
    }
    for (int it = blockIdx.x; it < DEPTH * 2 * 64; it += C.G) {
        const int lkv = it >> 6, ks = it & 63, l = lkv >> 1, kv = lkv & 1; const float* pos = AIN(kv ? 8 : 3) + (size_t)l * 2048; const float* w1 = AIN(kv ? 9 : 4) + (size_t)l * 2048 * 128;
        LAS float* red = (LAS float*)(C.lds + POOL_OFF);
        __syncthreads();
        const int n = C.tid & 127, q = C.tid >> 7; float a = 0.f;
#pragma unroll
        for (int k = 32 * ks + 8 * q; k < 32 * ks + 8 * q + 8; ++k) a += pos[k] * w1[(size_t)k * 128 + n];
        red[C.tid] = a; __syncthreads();
        if (C.tid < 128) ((float*)(AWS + WS_CB1))[(lkv * 64 + ks) * 128 + n] = (red[n] + red[128 + n]) + (red[256 + n] + red[384 + n]);
        __syncthreads();
    }
}
__device__ __forceinline__ float gelu_tanh(float x) { const float u = 0.7978845608028654f * (x + 0.044715f * x * x * x); const float t = 1.0f - 2.0f / (__expf(2.0f * u) + 1.0f); return 0.5f * x * (1.0f + t); }
__device__ __forceinline__ void final_norm(Ctx& C0) {
    Ctx C = C0; C.tid = fresh_tid(C0); C.lane = C.tid & 63; __syncthreads();
    const float* gn = AIN(20); const int lane = C.lane, wave = C.tid >> 6; const float* rss = (const float*)(AWS + WS_RSS); const bf16* X = (const bf16*)(AWS + WS_R1);
    f32x4 g[4];
#pragma unroll
    for (int j = 0; j < 4; ++j) g[j] = ((const f32x4*)gn)[lane + 64 * j];
    for (int m = blockIdx.x * NWAVES + wave; m < MTOK; m += C.G * NWAVES) {
        GAS f32x4* orow = (GAS f32x4*)(AOUT + (size_t)m * DM) + lane;
        const unsigned long long* xr = (const unsigned long long*)(X + (size_t)m * DM) + lane;
        const float rs = pg8::row_rstd(rss, m);
#pragma unroll
        for (int j = 0; j < 4; ++j) { const unsigned long long w = __builtin_nontemporal_load(xr + 64 * j); const unsigned wl = (unsigned)w, wh = (unsigned)(w >> 32);
            const f32x4 x = {pg8::bf_lo(wl), pg8::bf_hi(wl), pg8::bf_lo(wh), pg8::bf_hi(wh)};
            __builtin_nontemporal_store(x * rs * g[j], orow + 64 * j); }
    }
}
namespace fa {
typedef float f32x16 __attribute__((ext_vector_type(16)));
typedef short s16x4 __attribute__((ext_vector_type(4)));
typedef short v4i16_t __attribute__((ext_vector_type(4)));
typedef short bf16x8 __attribute__((ext_vector_type(8)));
typedef unsigned u32x4 __attribute__((ext_vector_type(4)));
typedef float f32x2_t __attribute__((ext_vector_type(2))); typedef __bf16 bf16x2_t __attribute__((ext_vector_type(2)));
constexpr int SLOTB = 8192, NSLOT = 3;
constexpr int L_K = 0, L_V = NSLOT * SLOTB, L_WS = 2 * NSLOT * SLOTB, L_OST = L_WS + 8 * 256, L_END = L_OST + 8 * 4096;
constexpr float THR = 8.0f;
struct W { int lane, r32, hi, wid; LAS unsigned char* shm; };
__device__ __forceinline__ int crow(int r, int hi) { return (r & 3) + 8 * (r >> 2) + 4 * hi; }
__device__ __forceinline__ unsigned cvtpk(float lo, float hi) { f32x2_t v = {lo, hi}; bf16x2_t b = __builtin_convertvector(v, bf16x2_t); return __builtin_bit_cast(unsigned, b); }
__device__ __forceinline__ float max3f(float a, float b, float c) { return __builtin_fmaxf(__builtin_fmaxf(a, b), c); }
#define FA_WAIT_BAR(N) asm volatile("s_waitcnt vmcnt(" #N ") lgkmcnt(0)\n\ts_barrier" ::: "memory")
__device__ __forceinline__ void glds16(const void* gsrc, unsigned lds_dst) { unsigned keep;
    asm volatile("s_mov_b32 %0, m0\n\ts_mov_b32 m0, %2\n\ts_nop 0\n\tglobal_load_lds_dwordx4 %1, off\n\ts_mov_b32 m0, %0" : "=&s"(keep) : "v"(gsrc), "s"(lds_dst) : "memory"); }
__device__ __forceinline__ void dma_tile(const W& w, const bf16* Kb, const bf16* Vb, int pitch, int tile, int slot) {
    const bf16* ks = Kb + (size_t)(64 * tile + w.lane) * pitch + w.wid * 8;
    const bf16* vs = Vb + (size_t)(64 * tile + 16 * (w.wid & 3) + (w.lane >> 2)) * pitch + (w.wid >> 2) * 32 + (w.lane & 3) * 8;
    const unsigned l0 = (unsigned)(uintptr_t)(w.shm) + slot * SLOTB + w.wid * 1024;
    glds16(ks, (unsigned)__builtin_amdgcn_readfirstlane(l0 + L_K)); glds16(vs, (unsigned)__builtin_amdgcn_readfirstlane(l0 + L_V));
}
__device__ __forceinline__ void qkt(f32x16& p0, f32x16& p1, const LAS unsigned char* Kslot, const bf16x8 (&qr)[4], int r32, int hi) {
    const f32x16 zero = f32x16{};
    const LAS unsigned char* kb = Kslot + hi * 1024 + r32 * 16;
#pragma unroll
    for (int dh = 0; dh < 2; ++dh) {
        bf16x8 b0[2], b1[2];
#pragma unroll
        for (int d = 0; d < 2; ++d) { b0[d] = *(const LAS bf16x8*)(kb + (2 * dh + d) * 2048); b1[d] = *(const LAS bf16x8*)(kb + (2 * dh + d) * 2048 + 512); }
        __builtin_amdgcn_sched_barrier(0);
#pragma unroll
        for (int d = 0; d < 2; ++d) { const int d0 = 2 * dh + d;
            if (d0 == 0) { p0 = __builtin_amdgcn_mfma_f32_32x32x16_bf16(b0[d], qr[0], zero, 0, 0, 0); p1 = __builtin_amdgcn_mfma_f32_32x32x16_bf16(b1[d], qr[0], zero, 0, 0, 0); }
            else { p0 = __builtin_amdgcn_mfma_f32_32x32x16_bf16(b0[d], qr[d0], p0, 0, 0, 0); p1 = __builtin_amdgcn_mfma_f32_32x32x16_bf16(b1[d], qr[d0], p1, 0, 0, 0); } }
    }
}
__device__ __forceinline__ s16x4 vtr(const LAS unsigned char* p) { return __builtin_bit_cast(s16x4, __builtin_amdgcn_ds_read_tr16_b64_v4i16((LAS v4i16_t*)p)); }
__device__ __forceinline__ void pv(f32x16 (&o)[2], const LAS unsigned char* vp, const u32x4 (&pw)[4]) {
#pragma unroll
    for (int d0 = 0; d0 < 2; ++d0) {
        s16x4 lo[4], hi[4];
#pragma unroll
        for (int ks = 0; ks < 4; ++ks) { lo[ks] = vtr(vp + d0 * 4096 + ks * 1024); hi[ks] = vtr(vp + d0 * 4096 + ks * 1024 + 512); }
        __builtin_amdgcn_sched_barrier(0);
#pragma unroll
        for (int ks = 0; ks < 4; ++ks) { const bf16x8 vf = {lo[ks][0], lo[ks][1], lo[ks][2], lo[ks][3], hi[ks][0], hi[ks][1], hi[ks][2], hi[ks][3]};
            o[d0] = __builtin_amdgcn_mfma_f32_32x32x16_bf16(__builtin_bit_cast(bf16x8, pw[ks]), vf, o[d0], 0, 0, 0); }
    }
}
__device__ __forceinline__ float half_swap(float v) { const auto rr = __builtin_amdgcn_permlane32_swap(__float_as_uint(v), __float_as_uint(v), false, false); return __uint_as_float(rr[0] == __float_as_uint(v) ? rr[1] : rr[0]); }
__device__ __forceinline__ float rowmax(const f32x16& p0, const f32x16& p1) {
    float a = max3f(p0[0], p0[1], p1[0]), b = max3f(p0[2], p0[3], p1[1]); a = max3f(a, p1[2], p1[3]);
#pragma unroll
    for (int r = 4; r < 16; r += 4) { a = max3f(a, p0[r], p0[r + 1]); b = max3f(b, p0[r + 2], p0[r + 3]); a = max3f(a, p1[r], p1[r + 1]); b = max3f(b, p1[r + 2], p1[r + 3]); }
    const float m = __builtin_fmaxf(a, b);
    const auto rr = __builtin_amdgcn_permlane32_swap(__float_as_uint(m), __float_as_uint(m), false, false);
    return __builtin_fmaxf(__uint_as_float(rr[0]), __uint_as_float(rr[1]));
}
struct St { f32x16 o[2]; float mref, l; bool moved; };
__device__ __forceinline__ void st_init(St& s) { s.o[0] = f32x16{}; s.o[1] = f32x16{}; s.mref = 0.f; s.l = 0.f; s.moved = false; }
template <class MaskF> __device__ __forceinline__ void tile_step(const W& w, int slot, const bf16x8 (&qr)[4], MaskF& MF, St& s) {
    f32x16 p0, p1;
    qkt(p0, p1, w.shm + L_K + slot * SLOTB, qr, w.r32, w.hi);
    if (__builtin_expect(s.moved, 0)) {
#pragma unroll
        for (int r = 0; r < 16; ++r) { p0[r] -= s.mref; p1[r] -= s.mref; } }
    MF.pre(p0, p1);
    const float rm = rowmax(p0, p1);
    if (__builtin_expect(__any(rm > THR), 0)) {
        const float dl = __builtin_fmaxf(rm, 0.f); s.mref += dl; s.moved = true;
#pragma unroll
        for (int r = 0; r < 16; ++r) { p0[r] -= dl; p1[r] -= dl; }
        const float f = __builtin_amdgcn_exp2f(-dl); s.l *= f;
        LAS float* wsf = (LAS float*)(w.shm + L_WS) + w.wid * 64;
        if (w.hi == 0) wsf[w.r32] = f;
        asm volatile("s_waitcnt lgkmcnt(0)" ::: "memory");
#pragma unroll
        for (int r = 0; r < 16; ++r) { const float fr = wsf[crow(r, w.hi)]; s.o[0][r] *= fr; s.o[1][r] *= fr; }
    }
#pragma unroll
    for (int r = 0; r < 16; ++r) { p0[r] = __builtin_amdgcn_exp2f(p0[r]); p1[r] = __builtin_amdgcn_exp2f(p1[r]); }
    MF.post(p0, p1);
    float sa = 0.f, sb = 0.f;
#pragma unroll
    for (int r = 0; r < 16; ++r) { sa += p0[r]; sb += p1[r]; }
    s.l += sa + sb;
    u32x4 pw[4];
#pragma unroll
    for (int k = 0; k < 4; ++k) { pw[0][k] = cvtpk(p0[2 * k], p0[2 * k + 1]); pw[1][k] = cvtpk(p0[8 + 2 * k], p0[9 + 2 * k]); pw[2][k] = cvtpk(p1[2 * k], p1[2 * k + 1]); pw[3][k] = cvtpk(p1[8 + 2 * k], p1[9 + 2 * k]); }
    const LAS unsigned char* vp = w.shm + L_V + slot * SLOTB + ((w.lane >> 4) & 1) * 32 + (w.lane & 3) * 8 + (4 * w.hi + ((w.lane & 15) >> 2)) * 64;
    pv(s.o, vp, pw);
}
template <class TS, class MaskF> __device__ __forceinline__ void run_branch(const W& w_in, const bf16* Kb, const bf16* Vb, int pitch, TS ts, bf16x8 (&qr)[4], MaskF& MF, St& s) {
    const W& w = w_in;
    const int n = ts.n;
    asm volatile("s_waitcnt vmcnt(0)" : "+v"(qr[0]), "+v"(qr[1]), "+v"(qr[2]), "+v"(qr[3]) :: "memory");
    int t0 = 0, t1 = 0, t2 = 0;
    if (n > 0) { t0 = ts.next(); MF.issue(t0); dma_tile(w, Kb, Vb, pitch, t0, 0); }
    if (n > 1) { t1 = ts.next(); dma_tile(w, Kb, Vb, pitch, t1, 1); MF.template settle<4>(); } else { MF.template settle<2>(); }
    int slot = 0;
#pragma nounroll
    for (int k = 0; k < n; ++k) {
        if (k + 1 < n) { FA_WAIT_BAR(2); } else { FA_WAIT_BAR(0); }
        MF.advance(t0);
        if (k + 1 < n) MF.issue(t1);
        if (k + 2 < n) { t2 = ts.next(); int s2 = slot + 2; s2 = s2 >= NSLOT ? s2 - NSLOT : s2; dma_tile(w, Kb, Vb, pitch, t2, s2); }
        if (MF.active(t0)) tile_step(w, slot, qr, MF, s);
        if (k + 2 < n) { MF.template settle<2>(); } else { MF.template settle<0>(); }
        slot = (slot == NSLOT - 1) ? 0 : slot + 1; t0 = t1; t1 = t2;
    }
    asm volatile("s_waitcnt lgkmcnt(0)\n\ts_barrier" ::: "memory");
}
__device__ __forceinline__ void finish_branch(const W& w, St& s, float gate, f32x16 (&oacc)[2]) {
    float l = s.l; { const auto rr = __builtin_amdgcn_permlane32_swap(__float_as_uint(l), __float_as_uint(l), false, false); l = __uint_as_float(rr[0]) + __uint_as_float(rr[1]); }
    LAS float* wsf = (LAS float*)(w.shm + L_WS) + w.wid * 64;
    if (w.hi == 0) wsf[32 + w.r32] = (l > 0.f) ? gate / l : 0.f;
    asm volatile("s_waitcnt lgkmcnt(0)" ::: "memory");
#pragma unroll
    for (int r = 0; r < 16; ++r) { const float sc = wsf[32 + crow(r, w.hi)]; oacc[0][r] += s.o[0][r] * sc; oacc[1][r] += s.o[1][r] * sc; }
    asm volatile("s_waitcnt lgkmcnt(0)" ::: "memory");
}
__device__ __forceinline__ void store_o(const W& w_in, const f32x16 (&oacc)[2], bf16* Ow, int opitch) {
    const W& w = w_in;
    LAS bf16* stg = (LAS bf16*)(w.shm + L_OST) + w.wid * 2048;
#pragma unroll
    for (int r = 0; r < 16; ++r) { const int orow = crow(r, w.hi);
#pragma unroll
        for (int d0 = 0; d0 < 2; ++d0) stg[orow * 64 + d0 * 32 + w.r32] = (bf16)(cvtpk(oacc[d0][r], 0.f) & 0xffffu); }
    asm volatile("s_waitcnt lgkmcnt(0)" ::: "memory");
#pragma unroll
    for (int i = 0; i < 4; ++i) { const int row = i * 8 + (w.lane >> 3), ch = w.lane & 7; const u32x4 v = *(const LAS u32x4*)(stg + row * 64 + ch * 8); *(u32x4*)(Ow + (size_t)row * opitch + ch * 8) = v; }
    asm volatile("s_waitcnt lgkmcnt(0)" ::: "memory");
}
struct SeqRange { int n, t; __device__ __forceinline__ int next() { return t++; } };
struct SeqBits { int n; unsigned rem; __device__ __forceinline__ int next() { const int t = __builtin_ctz(rem); rem &= rem - 1u; return t; } };
}

constexpr int L_MK = fa::L_END, L_MK_SLOT = 2048, DSA_LDS_END = L_MK + fa::NSLOT * L_MK_SLOT;
struct DsaMask {
    const LAS unsigned char* mlds;
    int hi, last_tile; unsigned w0, w1;
    __device__ __forceinline__ bool active(int t) const { return t <= last_tile; }
    __device__ __forceinline__ void advance_slot(int slot) { w0 = *(const LAS unsigned*)(mlds + slot * L_MK_SLOT) >> (16 * hi); w1 = *(const LAS unsigned*)(mlds + slot * L_MK_SLOT + 1024) >> (16 * hi); }
    __device__ __forceinline__ void pre(fa::f32x16&, fa::f32x16&) const {}
    __device__ __forceinline__ void post(fa::f32x16& p0, fa::f32x16& p1) const {
#pragma unroll
        for (int r = 0; r < 16; ++r) {
            unsigned m0, m1;
            asm("v_bfe_i32 %0, %1, %2, 1" : "=v"(m0) : "v"(w0), "n"(r));
            asm("v_bfe_i32 %0, %1, %2, 1" : "=v"(m1) : "v"(w1), "n"(r));
            p0[r] = __uint_as_float(__float_as_uint(p0[r]) & m0);
            p1[r] = __uint_as_float(__float_as_uint(p1[r]) & m1); }
    }
};
__device__ __forceinline__ void dsa_dma_tile(const fa::W& w, const bf16* Kb, const bf16* Vb, const unsigned* mk, int tile, int slot) {
    fa::dma_tile(w, Kb, Vb, PW, tile, slot);
    if (w.wid < 2) fa::glds16(mk + (size_t)(2 * tile + w.wid) * SEQ + 4 * w.lane, (unsigned)__builtin_amdgcn_readfirstlane((unsigned)(uintptr_t)(w.shm) + L_MK + slot * L_MK_SLOT + w.wid * 1024));
}
#define DSA_WAIT_BAR(wid_, N2, N3) do { if ((wid_) < 2) { FA_WAIT_BAR(N3); } else { FA_WAIT_BAR(N2); } } while (0)
__device__ __forceinline__ void run_branch_dsa(const fa::W& w, const bf16* Kb, const bf16* Vb, const unsigned* mk, int n, fa::bf16x8 (&qr)[4], DsaMask& MF, fa::St& s) {
    asm volatile("s_waitcnt vmcnt(0)" : "+v"(qr[0]), "+v"(qr[1]), "+v"(qr[2]), "+v"(qr[3]) :: "memory");
    dsa_dma_tile(w, Kb, Vb, mk, 0, 0);
    if (n > 1) dsa_dma_tile(w, Kb, Vb, mk, 1, 1);
    int slot = 0;
#pragma nounroll
    for (int k = 0; k < n; ++k) {
        if (k + 1 < n) { DSA_WAIT_BAR(w.wid, 2, 3); } else { FA_WAIT_BAR(0); }
        MF.advance_slot(slot);
        if (k + 2 < n) { int s2 = slot + 2; s2 = s2 >= fa::NSLOT ? s2 - fa::NSLOT : s2; dsa_dma_tile(w, Kb, Vb, mk, k + 2, s2); }
        if (MF.active(k)) fa::tile_step(w, slot, qr, MF, s);
        slot = (slot == fa::NSLOT - 1) ? 0 : slot + 1;
    }
    asm volatile("s_waitcnt lgkmcnt(0)\n\ts_barrier" ::: "memory");
}
__device__ __forceinline__ void dsa_mfma(Ctx& C0) {
    Ctx C = C0; C.tid = fresh_tid(C0); C.lane = C.tid & 63; __syncthreads();
    fa::W w; w.lane = C.lane; w.r32 = C.lane & 31; w.hi = C.lane >> 5; w.wid = C.wave; w.shm = C.lds + POOL_OFF;
    const bf16* P = (const bf16*)(AWS + WS_P); bf16* O = (bf16*)AOUT;        const unsigned* DMK = (const unsigned*)(AWS + WS_DMASK);
    const int G = C.G, bx = blockIdx.x, vcu = (G % 8 == 0) ? (bx % 8) * (G / 8) + bx / 8 : bx;
    for (int sl = vcu; sl < 256; sl += G) {
        const int bh = sl >> 1, sub = sl & 1, b = bh >> 3, h = bh & 7;
        for (int i = 0; i < 4; ++i) {
            const int qb = sub == 0 ? (i == 0 ? 7 : i == 1 ? 0 : i == 2 ? 4 : 3) : (i == 0 ? 6 : i == 1 ? 1 : i == 2 ? 5 : 2);
            { int tidu = fresh_tid(C0); w.lane = tidu & 63; w.r32 = w.lane & 31; w.hi = w.lane >> 5; w.wid = __builtin_amdgcn_readfirstlane(tidu >> 6); }
            const int q0 = qb * 256, tq = q0 + 32 * w.wid + w.r32;
            const bf16* Pb = P + (size_t)b * SEQ * PW;
            const bf16* Qrow = Pb + (size_t)tq * PW + C_DQ + h * 64;
            fa::bf16x8 qr[4];
#pragma unroll
            for (int d0 = 0; d0 < 4; ++d0) qr[d0] = *(const fa::bf16x8*)(Qrow + d0 * 16 + w.hi * 8);
            DsaMask MF; MF.mlds = w.shm + L_MK + (32 * w.wid + w.r32) * 4; MF.hi = w.hi; MF.last_tile = (q0 + 32 * w.wid + 31) >> 6; MF.w0 = MF.w1 = 0u;
            fa::St st; fa::st_init(st);
            run_branch_dsa(w, Pb + C_DK + h * 64, Pb + C_DV + h * 64, DMK + (size_t)b * 64 * SEQ + q0, (q0 + 256) / 64, qr, MF, st);
            fa::f32x16 oacc[2]; oacc[0] = fa::f32x16{}; oacc[1] = fa::f32x16{};
            fa::finish_branch(w, st, 1.0f, oacc);
            fa::store_o(w, oacc, O + (size_t)(b * SEQ + q0 + 32 * w.wid) * 1024 + 512 + h * 64, 1024);
        }
    }
}
struct NsaSlcMask {
    unsigned rowsel, wmask; int diag, tq, hi; unsigned cursel;
    __device__ __forceinline__ bool active(int t) const { return (wmask >> t) & 1u; }
    __device__ __forceinline__ void issue(int) {}
    template <int N> __device__ __forceinline__ void settle() {}
    int curt;
    __device__ __forceinline__ void advance(int t) { curt = t; cursel = ((rowsel >> t) & 1u) ? 0xffffffffu : 0u; }
    __device__ __forceinline__ void pre(fa::f32x16& p0, fa::f32x16& p1) const {
        if (curt == diag) {
            const int lim = tq - 64 * diag - 4 * hi;
#pragma unroll
            for (int r = 0; r < 16; ++r) { const int ko = (r & 3) + 8 * (r >> 2); if (ko > lim) p0[r] = -INFINITY; if (ko + 32 > lim) p1[r] = -INFINITY; }
        }
    }
    __device__ __forceinline__ void post(fa::f32x16& p0, fa::f32x16& p1) const {
#pragma unroll
        for (int r = 0; r < 16; ++r) { p0[r] = __uint_as_float(__float_as_uint(p0[r]) & cursel); p1[r] = __uint_as_float(__float_as_uint(p1[r]) & cursel); }
    }
};
struct NsaWinMask {
    int tq, hi, tq0, curt;
    __device__ __forceinline__ bool active(int t) const { return 64 * t + 63 >= tq0 - 511 && 64 * t <= tq0 + 31; }
    __device__ __forceinline__ void issue(int) {}
    template <int N> __device__ __forceinline__ void settle() {}
    __device__ __forceinline__ void advance(int t) { curt = t; }
    __device__ __forceinline__ void pre(fa::f32x16& p0, fa::f32x16& p1) const {
        const int k0 = 64 * curt;
        if (k0 < tq0 - 480 || k0 + 63 > tq0) {
            const int hiL = tq - k0 - 4 * hi, loL = hiL - 511;
#pragma unroll
            for (int r = 0; r < 16; ++r) { const int ko = (r & 3) + 8 * (r >> 2); if (ko > hiL || ko < loL) p0[r] = -INFINITY; if (ko + 32 > hiL || ko + 32 < loL) p1[r] = -INFINITY; }
        }
    }
    __device__ __forceinline__ void post(fa::f32x16&, fa::f32x16&) const {}
};
template <int MODE> __device__ __forceinline__ void nsa_mfma(Ctx& C0) {
    Ctx C = C0; C.tid = fresh_tid(C0); C.lane = C.tid & 63; __syncthreads();
    using namespace fa;
    W w; w.lane = C.lane; w.r32 = C.lane & 31; w.hi = C.lane >> 5; w.wid = C.wave; w.shm = C.lds + POOL_OFF;
    LAS float* impbuf = (LAS float*)(w.shm + L_END);
    LAS float* impsum = impbuf + 4 * 2 * 32 * 33;
    LAS unsigned* selm = (LAS unsigned*)(impsum + 64 * 33);
    const bf16* P = (const bf16*)(AWS + WS_P); bf16* O = (bf16*)AOUT;
    const bf16* KCB = (const bf16*)(AWS + WS_KCB);
    const int G = C.G, bx = blockIdx.x, vcu = (G % 8 == 0) ? (bx % 8) * (G / 8) + bx / 8 : bx;
    for (int sl = vcu; sl < 256; sl += G) {
        const int bg = sl >> 3, b = bg >> 1, g = bg & 1, s8 = sl & 7;
        for (int ui = 0; ui < 4; ++ui) {
            const int cur = (ui == 0) ? 31 - s8 : (ui == 1) ? s8 : (ui == 2) ? 16 + s8 : 15 - s8;
            int tidu = fresh_tid(C0);
            C.tid = tidu; C.lane = tidu & 63; C.wave = __builtin_amdgcn_readfirstlane(tidu >> 6);
            w.lane = C.lane; w.r32 = C.lane & 31; w.hi = C.lane >> 5; w.wid = C.wave;
            const int r = w.wid & 3, th = w.wid >> 2;
            const int q0 = 64 * cur, tq0 = q0 + 32 * th, tq = tq0 + w.r32, head = 4 * g + r;
            const bf16* Pb = P + (size_t)b * SEQ * PW; const bf16* Prow = Pb + (size_t)tq * PW;
            bf16x8 qr[4];
#pragma unroll
            for (int d0 = 0; d0 < 4; ++d0) qr[d0] = *(const bf16x8*)(Prow + C_NQ + head * 64 + d0 * 16 + w.hi * 8);
            const float g_c = bf2f(Prow[C_NG + 0 * 8 + head]), g_s = bf2f(Prow[C_NG + 1 * 8 + head]), g_w = bf2f(Prow[C_NG + 2 * 8 + head]);
            if (C.tid < 3) selm[64 + C.tid] = 0u;
            f32x16 oacc[2];
            {
                const bf16* kc = KCB + (size_t)((0 * NB + b) * 2 + g) * 128 * 64; const bf16* vc = KCB + (size_t)((1 * NB + b) * 2 + g) * 128 * 64;
                const bool two = (q0 >= 1024);
                asm volatile("s_waitcnt vmcnt(0)" : "+v"(qr[0]), "+v"(qr[1]), "+v"(qr[2]), "+v"(qr[3]) :: "memory");
                dma_tile(w, kc, vc, 64, 0, 0); if (two) dma_tile(w, kc, vc, 64, 1, 1);
                FA_WAIT_BAR(0);
                f32x16 p[4];
                qkt(p[0], p[1], w.shm + L_K, qr, w.r32, w.hi);
                if (two) qkt(p[2], p[3], w.shm + L_K + SLOTB, qr, w.r32, w.hi);
                else {
#pragma unroll
                    for (int i = 0; i < 16; ++i) { p[2][i] = -INFINITY; p[3][i] = -INFINITY; } }
                const int lim = (tq >= 31 ? ((tq - 31) >> 4) : -1) - 4 * w.hi;
                float m = -INFINITY;
#pragma unroll
                for (int T = 0; T < 4; ++T)
#pragma unroll
                    for (int i = 0; i < 16; ++i) { const int c = 32 * T + (i & 3) + 8 * (i >> 2); if (c > lim) p[T][i] = -INFINITY; m = __builtin_fmaxf(m, p[T][i]); }
                { const auto rr = __builtin_amdgcn_permlane32_swap(__float_as_uint(m), __float_as_uint(m), false, false); m = __builtin_fmaxf(__uint_as_float(rr[0]), __uint_as_float(rr[1])); }
                const float msub = (m == -INFINITY) ? 0.f : m; float l = 0.f;
#pragma unroll
                for (int T = 0; T < 4; ++T)
#pragma unroll
                    for (int i = 0; i < 16; ++i) { p[T][i] = __builtin_amdgcn_exp2f(p[T][i] - msub); l += p[T][i]; }
                { const auto rr = __builtin_amdgcn_permlane32_swap(__float_as_uint(l), __float_as_uint(l), false, false); l = __uint_as_float(rr[0]) + __uint_as_float(rr[1]); }
                const float inv = (l > 0.f) ? 1.0f / l : 0.f;
#pragma unroll
                for (int T = 0; T < 4; ++T)
#pragma unroll
                    for (int i = 0; i < 16; ++i) p[T][i] *= inv;
                if (cur >= 16) {
                    LAS float* ib = impbuf + ((r * 2 + th) * 32 + w.r32) * 33;
                    float prv = 0.f;
#pragma unroll
                    for (int T = 0; T < 4; ++T)
#pragma unroll
                        for (int a = 0; a < 4; ++a) {
                            const float car = 0.5f * p[T][4 * a + 3], part = (p[T][4 * a] + p[T][4 * a + 1]) + (p[T][4 * a + 2] + car);
                            const auto rr = __builtin_amdgcn_permlane32_swap(__float_as_uint(car), __float_as_uint(car), false, false);
                            const float oth = (w.hi == 0) ? __uint_as_float(rr[1]) : __uint_as_float(rr[0]);
                            ib[8 * T + 2 * a + w.hi] = part + (w.hi ? oth : prv); prv = oth; }
                }
                {
                    u32x4 pwA[4], pwB[4];
#pragma unroll
                    for (int k = 0; k < 4; ++k) { pwA[0][k] = cvtpk(p[0][2 * k], p[0][2 * k + 1]); pwA[1][k] = cvtpk(p[0][8 + 2 * k], p[0][9 + 2 * k]); pwA[2][k] = cvtpk(p[1][2 * k], p[1][2 * k + 1]); pwA[3][k] = cvtpk(p[1][8 + 2 * k], p[1][9 + 2 * k]);
                        pwB[0][k] = cvtpk(p[2][2 * k], p[2][2 * k + 1]); pwB[1][k] = cvtpk(p[2][8 + 2 * k], p[2][9 + 2 * k]); pwB[2][k] = cvtpk(p[3][2 * k], p[3][2 * k + 1]); pwB[3][k] = cvtpk(p[3][8 + 2 * k], p[3][9 + 2 * k]); }
                    asm volatile("" : "+v"(pwA[0]), "+v"(pwA[1]), "+v"(pwA[2]), "+v"(pwA[3]), "+v"(pwB[0]), "+v"(pwB[1]), "+v"(pwB[2]), "+v"(pwB[3]));
                    f32x16 oc[2]; oc[0] = f32x16{}; oc[1] = f32x16{};
                    const LAS unsigned char* vp = w.shm + L_V + ((w.lane >> 4) & 1) * 32 + (w.lane & 3) * 8 + (4 * w.hi + ((w.lane & 15) >> 2)) * 64;
                    pv(oc, vp, pwA);
                    if (two) pv(oc, vp + SLOTB, pwB);
                    LAS float* wsf = (LAS float*)(w.shm + L_WS) + w.wid * 64;
                    if (w.hi == 0) wsf[32 + w.r32] = g_c;
                    asm volatile("s_waitcnt lgkmcnt(0)" ::: "memory");
#pragma unroll
                    for (int i = 0; i < 16; ++i) { const float scl = wsf[32 + crow(i, w.hi)]; oacc[0][i] = oc[0][i] * scl; oacc[1][i] = oc[1][i] * scl; }
                }
                asm volatile("s_waitcnt lgkmcnt(0)\n\ts_barrier" ::: "memory");
            }
            unsigned rowsel, umask, wmask;
#ifndef NSA_NO_RANK
            if (cur >= 16) {
                for (int e = C.tid; e < 64 * 32; e += NTHR) { const int tk = e >> 5, j = e & 31; float a = 0.f;
#pragma unroll
                    for (int rr2 = 0; rr2 < 4; ++rr2) a += impbuf[((rr2 * 2 + (tk >> 5)) * 32 + (tk & 31)) * 33 + j];
                    impsum[tk * 33 + j] = a; }
                asm volatile("s_waitcnt lgkmcnt(0)\n\ts_barrier" ::: "memory");
                const int tk = C.tid >> 3, jg = C.tid & 7; float sv[32];
#pragma unroll
                for (int j = 0; j < 32; ++j) { const float im = impsum[tk * 33 + j]; sv[j] = (j > cur) ? -INFINITY : ((j == 0 || j == cur || j == cur - 1) ? 1e4f : im); }
                unsigned bits = 0u;
#pragma unroll
                for (int q = 0; q < 4; ++q) { const int j = 4 * jg + q; float mine = sv[0];
#pragma unroll
                    for (int i = 1; i < 32; ++i) mine = (i == j) ? sv[i] : mine;
                    int rank = 0;
#pragma unroll
                    for (int i = 0; i < 32; ++i) rank += (sv[i] > mine || (sv[i] == mine && i < j)) ? 1 : 0;
                    if (rank < 16 && j <= cur) bits |= 1u << j; }
                bits |= __shfl_xor(bits, 1); bits |= __shfl_xor(bits, 2); bits |= __shfl_xor(bits, 4);
                if (jg == 0) { selm[tk] = bits; __hip_atomic_fetch_or(&selm[64], bits, __ATOMIC_RELAXED, __HIP_MEMORY_SCOPE_WORKGROUP); __hip_atomic_fetch_or(&selm[65 + (tk >> 5)], bits, __ATOMIC_RELAXED, __HIP_MEMORY_SCOPE_WORKGROUP); }
                asm volatile("s_waitcnt lgkmcnt(0)\n\ts_barrier" ::: "memory");
                rowsel = selm[32 * th + w.r32]; umask = selm[64]; wmask = selm[65 + th];
            } else
#endif
            { rowsel = umask = wmask = (cur == 31) ? 0xffffffffu : ((1u << (cur + 1)) - 1u); }
            umask = (unsigned)__builtin_amdgcn_readfirstlane((int)umask); wmask = (unsigned)__builtin_amdgcn_readfirstlane((int)wmask);
#ifndef NSA_NO_SLC
            if (MODE == 0 || MODE >= 2) {
                NsaSlcMask MF; MF.rowsel = rowsel; MF.wmask = wmask; MF.diag = cur; MF.tq = tq; MF.hi = w.hi; MF.cursel = 0u; MF.curt = 0;
                St st; st_init(st);
                SeqBits ts{__builtin_popcount(umask), umask};
                run_branch(w, Pb + C_KSLC + g * 64, Pb + C_VSLC + g * 64, PW, ts, qr, MF, st);
                finish_branch(w, st, g_s, oacc);
            }
#endif
#ifndef NSA_NO_WIN
            if (MODE == 0 || MODE >= 3) {
                NsaWinMask MF; MF.tq = tq; MF.hi = w.hi; MF.tq0 = tq0; MF.curt = 0;
                St st; st_init(st);
                const int tlo = cur >= 8 ? cur - 8 : 0;
                SeqRange ts{cur - tlo + 1, tlo};
                run_branch(w, Pb + C_KWIN + g * 64, Pb + C_VWIN + g * 64, PW, ts, qr, MF, st);
                finish_branch(w, st, g_w, oacc);
            }
#endif
            if (MODE == 0) store_o(w, oacc, O + (size_t)(b * SEQ + tq0) * 1024 + head * 64, 1024); else asm volatile("" :: "v"(oacc[0]), "v"(oacc[1]));
            asm volatile("s_waitcnt lgkmcnt(0)\n\ts_barrier" ::: "memory");
        }
    }
}
__device__ __forceinline__ unsigned fkey32(float f) { const unsigned u = __float_as_uint(f + 0.0f); return (f == -INFINITY) ? 0u : ((u & 0x80000000u) ? ~u : (u | 0x80000000u)); }
__device__ __forceinline__ int wave_sum_i32(int v) {
    v += __builtin_amdgcn_update_dpp(0, v, 0xB1, 0xF, 0xF, true);
    v += __builtin_amdgcn_update_dpp(0, v, 0x4E, 0xF, 0xF, true);
    v += __builtin_amdgcn_update_dpp(0, v, 0x141, 0xF, 0xF, true);
    v += __builtin_amdgcn_update_dpp(0, v, 0x140, 0xF, 0xF, true);
    return __builtin_amdgcn_readlane(v, 0) + __builtin_amdgcn_readlane(v, 16) + __builtin_amdgcn_readlane(v, 32) + __builtin_amdgcn_readlane(v, 48);
}
__device__ __forceinline__ float wave_max_dpp(float v) {
#define WMD_STEP(CTRL) v = __builtin_fmaxf(v, __int_as_float(__builtin_amdgcn_update_dpp(__float_as_int(v), __float_as_int(v), CTRL, 0xF, 0xF, false)))
    WMD_STEP(0xB1); WMD_STEP(0x4E); WMD_STEP(0x141); WMD_STEP(0x140);
#undef WMD_STEP
    const float a = __int_as_float(__builtin_amdgcn_readlane(__float_as_int(v), 0)), b = __int_as_float(__builtin_amdgcn_readlane(__float_as_int(v), 16));
    const float c = __int_as_float(__builtin_amdgcn_readlane(__float_as_int(v), 32)), d = __int_as_float(__builtin_amdgcn_readlane(__float_as_int(v), 48));
    return __builtin_fmaxf(__builtin_fmaxf(a, b), __builtin_fmaxf(c, d));
}
__device__ __forceinline__ unsigned wave_excl_prefix(unsigned v, int lane) {
    unsigned x = v;
#pragma unroll
    for (int o = 1; o < 64; o <<= 1) { const unsigned y = __shfl_up(x, o); x += (lane >= o) ? y : 0u; }
    return x - v;
}
template <int MODE> __device__ __forceinline__ void idx_mfma(Ctx& C0) {
    Ctx C = C0; C.tid = fresh_tid(C0); C.lane = C.tid & 63; __syncthreads();
    typedef float f32x4_t __attribute__((ext_vector_type(4)));
    typedef short bf16x8 __attribute__((ext_vector_type(8)));
    constexpr int RS = 2113;
    LAS unsigned char* shm = C.lds + POOL_OFF;
    LAS unsigned char* qlds = shm;
    LAS float* scr = (LAS float*)shm;
    const bf16* P = (const bf16*)(AWS + WS_P); unsigned* DMK = (unsigned*)(AWS + WS_DMASK);
    const int G = C.G, bx = blockIdx.x, vcu = (G % 8 == 0) ? (bx % 8) * (G / 8) + bx / 8 : bx;
    for (int sl = vcu; sl < 256; sl += G) {
        const int b = sl >> 4, s16 = sl & 15;
#pragma nounroll
        for (int ui = 0; ui < 8; ++ui) {
            int tidu = fresh_tid(C0);
            const int tid = tidu, lane = tid & 63, tok = lane & 15, g = lane >> 4, wid = __builtin_amdgcn_readfirstlane(tid >> 6);
            const int q16 = ((ui & 1) ? (ui >> 1) * 32 + 31 - s16 : (ui >> 1) * 32 + s16);
            const int t = 16 * q16 + tok, nkt = (q16 >> 1) + 1;
            const bf16* Pb = P + (size_t)b * SEQ * PW;
#pragma unroll
            for (int k = 0; k < 2; ++k) { const int id = tid + 512 * k, tk = id >> 6, pc = id & 63;
                const v4u v = *(const v4u*)(Pb + (size_t)(16 * q16 + tk) * PW + C_IQ + pc * 8);
                *(LAS v4u*)(qlds + (pc * 16 + tk) * 16) = v; }
            const v4u wvp = *(const v4u*)(Pb + (size_t)t * PW + C_IW);
            asm volatile("s_waitcnt vmcnt(0) lgkmcnt(0)\n\ts_barrier" ::: "memory");
            float sv[8][8];
            bf16x8 qf[8][2];
#pragma unroll
            for (int h = 0; h < 8; ++h) { qf[h][0] = *(const LAS bf16x8*)(qlds + (g * 16 + tok) * 16 + (h * 8) * 256); qf[h][1] = *(const LAS bf16x8*)(qlds + (g * 16 + tok) * 16 + (h * 8 + 4) * 256); }
            bf16x8 ka0, ka1, kn0, kn1;
#define IDX_LOADK(d0, d1, kt_, s_) do { const bf16* krow_ = Pb + (size_t)(32 * (kt_) + 16 * (s_) + tok) * PW + C_IK + 8 * g; d0 = *(const bf16x8*)(krow_); d1 = *(const bf16x8*)(krow_ + 32); } while (0)
            if (wid < nkt) IDX_LOADK(ka0, ka1, wid, 0);
#pragma unroll
            for (int st = 0; st < 16; ++st) {
                const int j = st >> 1, s = st & 1, kt = wid + 8 * j;
                if (st + 1 < 16) { const int kt2 = wid + 8 * ((st + 1) >> 1); if (kt2 < nkt) IDX_LOADK(kn0, kn1, kt2, (st + 1) & 1); }
                if (kt < nkt) {
                    f32x4_t sc = {0.f, 0.f, 0.f, 0.f};
#pragma unroll
                    for (int h = 0; h < 8; ++h) {
                        f32x4_t acc = {0.f, 0.f, 0.f, 0.f};
                        acc = __builtin_amdgcn_mfma_f32_16x16x32_bf16(ka0, qf[h][0], acc, 0, 0, 0);
                        acc = __builtin_amdgcn_mfma_f32_16x16x32_bf16(ka1, qf[h][1], acc, 0, 0, 0);
                        const unsigned wpk = (h < 2) ? wvp.x : (h < 4) ? wvp.y : (h < 6) ? wvp.z : wvp.w; const float wh = (h & 1) ? pg8::bf_hi(wpk) : pg8::bf_lo(wpk);
#pragma unroll
                        for (int r = 0; r < 4; ++r) sc[r] = __builtin_fmaf(wh, __builtin_fmaxf(acc[r], 0.f), sc[r]);
                    }
                    const int kpos = 32 * kt + 16 * s + 4 * g;
#pragma unroll
                    for (int r = 0; r < 4; ++r) sv[j][4 * s + r] = (kpos + r <= t) ? sc[r] + 0.0f : -INFINITY;
                } else {
#pragma unroll
                    for (int r = 0; r < 4; ++r) sv[j][4 * s + r] = -INFINITY;
                }
                ka0 = kn0; ka1 = kn1;
            }
#undef IDX_LOADK
            if (q16 < 16) {
#pragma unroll
                for (int j = 0; j < 8; ++j) { const int kt = wid + 8 * j; unsigned bits = 0u;
#pragma unroll
                    for (int i = 0; i < 8; ++i) bits |= (sv[j][i] != -INFINITY) ? (1u << ((i & 3) + 8 * (i >> 2) + 4 * (g >> 1) + 16 * (g & 1))) : 0u;
                    bits |= __shfl_xor(bits, 16); bits |= __shfl_xor(bits, 32);
                    if (MODE == 0) { if (g == 0) DMK[(size_t)(b * 64 + kt) * SEQ + t] = bits; } else { asm volatile("" :: "v"(bits)); } }
                asm volatile("s_waitcnt lgkmcnt(0)\n\ts_barrier" ::: "memory");
                continue;
            }
            if (MODE == 1) { asm volatile("" :: "v"(sv[0][0]), "v"(sv[7][7])); asm volatile("s_waitcnt lgkmcnt(0)\n\ts_barrier" ::: "memory"); continue; }
            asm volatile("s_waitcnt lgkmcnt(0)\n\ts_barrier" ::: "memory");
#pragma unroll
            for (int j = 0; j < 8; ++j)
#pragma unroll
                for (int i = 0; i < 8; ++i) scr[tok * RS + 33 * (wid + 8 * j) + 16 * (i >> 2) + 4 * g + (i & 3)] = sv[j][i];
            asm volatile("s_waitcnt lgkmcnt(0)\n\ts_barrier" ::: "memory");
#pragma nounroll
            for (int tt = 0; tt < 2; ++tt) {
                const int tau = wid + 8 * tt, tq = 16 * q16 + tau;
                float v[32];
#pragma unroll
                for (int u = 0; u < 32; ++u) v[u] = scr[tau * RS + 33 * lane + u];
#define IDX_CNT(PRED, OUT) do { int c_ = 0; _Pragma("unroll") for (int u = 0; u < 32; ++u) { const float fx = v[u]; c_ += (PRED) ? 1 : 0; } OUT = wave_sum_i32(c_); } while (0)
                float mx = -INFINITY, mn = INFINITY;
#pragma unroll
                for (int u = 0; u < 32; ++u) { mx = __builtin_fmaxf(mx, v[u]); mn = (v[u] == -INFINITY) ? mn : __builtin_fminf(mn, v[u]); }
                mx = wave_max_dpp(mx); mn = -wave_max_dpp(-mn);
#define IDX_CNTLT(PIV, OUT) do { const float pb_ = (PIV) * 1.2676506002282294e30f; float a0_ = 0.f, a1_ = 0.f; \
                    _Pragma("unroll") for (int u = 0; u < 32; u += 2) { a0_ += __builtin_amdgcn_fmed3f(__builtin_fmaf(v[u], -1.2676506002282294e30f, pb_), 0.f, 1.f); a1_ += __builtin_amdgcn_fmed3f(__builtin_fmaf(v[u + 1], -1.2676506002282294e30f, pb_), 0.f, 1.f); } \
                    OUT = wave_sum_i32((int)(a0_ + a1_)); } while (0)
                int cp, c0;
                {
                    float ap = 0.f, an = 0.f;
#pragma unroll
                    for (int u = 0; u < 32; ++u) { ap += __builtin_amdgcn_fmed3f(v[u] * 1.2676506002282294e30f, 0.f, 1.f); an += __builtin_amdgcn_fmed3f(v[u] * -1.2676506002282294e30f, 0.f, 1.f); }
                    cp = wave_sum_i32((int)ap); c0 = 2048 - wave_sum_i32((int)an);
                    if (cp == 256) { int ce; IDX_CNT(fx > 0.f, ce); cp = ce; }
                }
                float thr = 0.f, tv = 0.f; int need = 0; bool tie = false, done = false, strict = false;
                float lo, hi_, clo, chi, wprev = INFINITY;
                if (cp >= 256) { lo = 0.f; hi_ = mx; clo = (float)cp; chi = 1.f; if (cp == 256) { done = true; strict = true; thr = 0.f; } }
                else if (c0 < 256) { lo = mn; hi_ = 0.f; clo = (float)(tq + 1); chi = (float)c0; }
                else { lo = hi_ = clo = chi = 0.f; tie = true; tv = 0.f; need = 256 - cp; done = true; }
#pragma nounroll
                for (int rd = 0; rd < 64 && !done; ++rd) {
                    const float wdt = hi_ - lo, fi = __builtin_fminf(__builtin_fmaxf((clo - 256.5f) / (clo - chi), 0.02f), 0.98f);
                    const float frac = ((rd & 1) && wdt > 0.5f * wprev) ? 0.5f : fi;
                    if (!(rd & 1)) wprev = wdt;
                    const float mid = lo + wdt * frac;
                    if (!(mid > lo) || !(mid < hi_)) {
                        int cg; IDX_CNT(fx >= hi_, cg); tie = true; done = true; need = 256 - cg;
                        float below = -INFINITY;
#pragma unroll
                        for (int u = 0; u < 32; ++u) below = (v[u] < hi_) ? __builtin_fmaxf(below, v[u]) : below;
                        tv = wave_max_dpp(below);
                        break; }
                    int c; { int clt; IDX_CNTLT(mid, clt); c = 2048 - clt; }
                    if (c == 256) { int ce; IDX_CNT(fx >= mid, ce); c = ce; }
                    if (c == 256) { done = true; thr = mid; } else if (c > 256) { lo = mid; clo = (float)c; } else { hi_ = mid; chi = (float)c; }
                }
                bool redo = !done;
                if (tie && !redo) { int cgt, ceq; IDX_CNT(fx > tv, cgt); IDX_CNT(fx == tv, ceq); need = 256 - cgt; redo = (need < 1 || need > ceq); }
                if (__builtin_expect(redo, 0)) {
                    unsigned T = 0u;
#pragma nounroll
                    for (int bit = 31; bit >= 0; --bit) { const unsigned cand = T | (1u << bit); int c; IDX_CNT(fkey32(fx) >= cand, c); if (c >= 256) T = cand; }
                    tv = __uint_as_float((T & 0x80000000u) ? (T ^ 0x80000000u) : ~T); tie = true; strict = false;
                    int cgt; IDX_CNT(fx > tv, cgt); need = 256 - cgt;
                }
                unsigned word = 0u;
                if (!tie) {
#pragma unroll
                    for (int u = 0; u < 32; ++u) word |= ((strict ? v[u] > thr : v[u] >= thr)) ? (1u << ((u & 3) + 4 * (u >> 3) + 16 * ((u >> 2) & 1))) : 0u;
                } else {
                    unsigned nt = 0u;
#pragma unroll
                    for (int u = 0; u < 32; ++u) nt += (v[u] == tv) ? 1u : 0u;
                    unsigned rank = wave_excl_prefix(nt, lane);
#pragma unroll
                    for (int u = 0; u < 32; ++u) { const bool eq = (v[u] == tv); const bool sel = (v[u] > tv) || (eq && (int)rank < need); rank += eq ? 1u : 0u;
                        word |= sel ? (1u << ((u & 3) + 4 * (u >> 3) + 16 * ((u >> 2) & 1))) : 0u; }
                }
                DMK[(size_t)(b * 64 + lane) * SEQ + tq] = word;
#undef IDX_CNT
#undef IDX_CNTLT
            }
            asm volatile("s_waitcnt lgkmcnt(0)\n\ts_barrier" ::: "memory");
        }
    }
}
__device__ __forceinline__ void compress_mfma(Ctx& C0, int l) {
    Ctx C = C0; C.tid = fresh_tid(C0); C.lane = C.tid & 63; __syncthreads();
    typedef float f32x16 __attribute__((ext_vector_type(16)));
    typedef short bf16x8 __attribute__((ext_vector_type(8)));
    LAS float* hidp = (LAS float*)(C.lds + POOL_OFF);
    LAS float* hid = hidp + 2 * 32 * 132;
    const bf16* P = (const bf16*)(AWS + WS_P);
    const int lane = C.lane, r32 = lane & 31, hi = lane >> 5, wid = C.wave, nb = wid & 3, kh = wid >> 2;
    for (int u = blockIdx.x; u < 256; u += C.G) {
        const int kv = u >> 7, b = (u >> 3) & 15, g = (u >> 2) & 1, mb = u & 3, c0 = 32 * mb;
        const int crow_ = (c0 + r32 < 127) ? c0 + r32 : 126;
        const bf16* arow = P + (size_t)(b * SEQ + 16 * crow_) * PW + (kv ? C_VCMP : C_KCMP) + g * 64 + 8 * hi;
        const bf16* brow = (const bf16*)(AWS + WS_W1B) + ((size_t)(l * 2 + kv) * 128 + 32 * nb + r32) * 2048 + 1024 * kh + 8 * hi;
        f32x16 acc = f32x16{};
#pragma unroll 8
        for (int kk = 0; kk < 64; ++kk) {
            const int k = 1024 * kh + 16 * kk;
            const bf16x8 a = *(const bf16x8*)(arow + (size_t)(k >> 6) * PW + (k & 63));
            const bf16x8 bq = *(const bf16x8*)(brow + 16 * kk);
            acc = __builtin_amdgcn_mfma_f32_32x32x16_bf16(a, bq, acc, 0, 0, 0);
        }
        __syncthreads();
#pragma unroll
        for (int i = 0; i < 16; ++i) hidp[(kh * 32 + (i & 3) + 8 * (i >> 2) + 4 * hi) * 132 + 32 * nb + r32] = acc[i];
        __syncthreads();
        LAS float* cb1 = hid + 32 * 132;
        if (C.tid < 128) { const float* cp = (const float*)(AWS + WS_CB1) + (size_t)(l * 2 + kv) * 64 * 128 + C.tid; float a = AIN(kv ? 10 : 5)[l * 128 + C.tid];
            for (int ks = 0; ks < 64; ++ks) a += cp[ks * 128];
            cb1[C.tid] = a; }
        __syncthreads();
        for (int e = C.tid; e < 32 * 128; e += NTHR) { const int c = e >> 7, n = e & 127; hid[c * 132 + n] = gelu_tanh(hidp[c * 132 + n] + hidp[(32 + c) * 132 + n] + cb1[n]); }
        __syncthreads();
        {
            const float* w2 = AIN(kv ? 11 : 6) + (size_t)l * 128 * 64; const float* b2 = AIN(kv ? 12 : 7) + l * 64;
            const int c = C.tid >> 4, d4 = (C.tid & 15) * 4;
            f32x4 a = *(const f32x4*)(b2 + d4);
            for (int n = 0; n < 128; ++n) a += hid[c * 132 + n] * *(const f32x4*)(w2 + n * 64 + d4);
            if (c0 + c >= 127) a = (f32x4){0.f, 0.f, 0.f, 0.f};
            const size_t o = ((size_t)((kv * NB + b) * 2 + g) * 128 + c0 + c) * 64 + d4;
            *(f32x4*)((float*)(AWS + WS_KC) + o) = a;
            *(unsigned long long*)((bf16*)(AWS + WS_KCB) + o) = (unsigned long long)pk2(a.x, a.y) | ((unsigned long long)pk2(a.z, a.w) << 32);
        }
    }
    __syncthreads();
}
#ifndef MK_N_LAUNCHES
#define MK_N_LAUNCHES 1
#endif
constexpr int NPH = 18;
constexpr int N_LAUNCHES = MK_N_LAUNCHES;
#define GRID_BAR() do { if (N_LAUNCHES == 1) { XcdBarrier bar_; bar_.bar = (unsigned*)((gu32*)(AWS + WS_CTL) + CW_BAR); bar_.x = xb_xcc_id(); bar_.st = (volatile LAS unsigned*)(C.lds + MISC_OFF) + 8; xcd_barrier(bar_); } } while (0)
#define lo (kargs()->ph_lo)
#define hi (kargs()->ph_hi)
#ifndef REP_PHASE
#define REP_PHASE -1
#endif
#ifndef PH_EN
#define PH_EN 0xFFFFFFFFu
#endif
#define IN(k) (((PH_EN >> ((k) > 8 ? ((k) - 8 > 8 ? 17 : (k) - 8) : (k))) & 1u) && lo <= (k) && (k) < hi)
#define BOTH(k) (IN(k) && IN((k) + 1))
#define RING (C.lds + POOL_OFF)
#define XG_ ((bf16*)(AWS + WS_R1))
#define OB_ ((bf16*)AOUT)
#define P_ ((bf16*)(AWS + WS_P))
#define H_ ((bf16*)(AWS + WS_P))
#define RSS_ ((float*)(AWS + WS_RSS))
#define RCOS_ ((const float*)(AWS + WS_ROPE))
#define RSIN_ ((const float*)(AWS + WS_ROPE) + 2048 * 8)

template <int l> __device__ __forceinline__ void layer_phases(Ctx& C) {
        const int pb = 1 + 8 * l;
        if (IN(pb)) {
            pg8::Gemm g{XG_, (const bf16*)(AWS + WS_WIN + l * SZ_WIN), MTOK, PW, DM, DM, DM, nullptr, nullptr}; pg8::StaticOrder S; S.init(MTOK, PW, C.G, (int)blockIdx.x);
            pg8::EpiProj E{P_, RSS_, RCOS_, RSIN_};
            pg8::gemm_phase<pg8::EpiProj, pg8::StaticOrder, true, true>(RING, g, S, E, C.wave);
            if (REP_PHASE == 1) pg8::gemm_phase<pg8::EpiProj, pg8::StaticOrder, true, true>(RING, g, S, E, C.wave);
            if (BOTH(pb)) GRID_BAR();
        }
        if (IN(pb + 1)) { compress_mfma(C, l); if (REP_PHASE == 2) compress_mfma(C, l); idx_mfma<0>(C); if (REP_PHASE == 3) idx_mfma<0>(C); if (REP_PHASE == 31) idx_mfma<1>(C); if (BOTH(pb + 1)) GRID_BAR(); }
        if (IN(pb + 2)) { nsa_mfma<0>(C); if (REP_PHASE == 4) nsa_mfma<0>(C); if (REP_PHASE == 41) nsa_mfma<1>(C); if (REP_PHASE == 42) nsa_mfma<2>(C); dsa_mfma(C); if (REP_PHASE == 5) dsa_mfma(C); if (BOTH(pb + 2)) GRID_BAR(); }
        if (IN(pb + 3)) {
            pg8::Gemm g{OB_, (const bf16*)(AWS + WS_WBN + l * SZ_WBR), MTOK, DM, 512, DM, 512, OB_ + 512, (const bf16*)(AWS + WS_WBD + l * SZ_WBR)}; pg8::DualOrder S; S.init(MTOK, DM, C.G, (int)blockIdx.x);
            pg8::EpiBranch2 E{P_, C_GN, C_GD, C_TMP, C_MRG};
            pg8::gemm_phase<pg8::EpiBranch2, pg8::DualOrder, true, true>(RING, g, S, E, C.wave);
            if (BOTH(pb + 3)) GRID_BAR();
        }
        if (IN(pb + 4)) { }
        if (IN(pb + 5)) {
            pg8::Gemm g{P_ + C_MRG, (const bf16*)(AWS + WS_WOUT + l * SZ_WOUT), MTOK, DM, DM, PW, DM, nullptr, nullptr}; pg8::StaticOrder S; S.init(MTOK, DM, C.G, (int)blockIdx.x);
            pg8::EpiResid E{XG_, RSS_};
            pg8::gemm_phase<pg8::EpiResid, pg8::StaticOrder, true, true>(RING, g, S, E, C.wave);
            if (BOTH(pb + 5)) GRID_BAR();
        }
        if (IN(pb + 6)) {
            pg8::Gemm g{XG_, (const bf16*)(AWS + WS_WGU + l * SZ_WGU), MTOK, PW, DM, DM, DM, nullptr, nullptr}; pg8::StaticOrder S; S.init(MTOK, PW, C.G, (int)blockIdx.x);
            pg8::EpiSwiglu E{H_, RSS_};
            pg8::gemm_phase<pg8::EpiSwiglu, pg8::StaticOrder, true, true>(RING, g, S, E, C.wave);
            if (REP_PHASE == 7) pg8::gemm_phase<pg8::EpiSwiglu, pg8::StaticOrder, true, true>(RING, g, S, E, C.wave);
            if (BOTH(pb + 6)) GRID_BAR();
        }
        if (IN(pb + 7)) {
            pg8::Gemm g{H_, (const bf16*)(AWS + WS_WDN + l * SZ_WDN), MTOK, DM, DFF, DFF, DFF, nullptr, nullptr}; pg8::StaticOrder S; S.init(MTOK, DM, C.G, (int)blockIdx.x);
            pg8::EpiResid E{XG_, RSS_};
            pg8::gemm_phase<pg8::EpiResid, pg8::StaticOrder, true, true>(RING, g, S, E, C.wave);
            if (BOTH(pb + 7)) GRID_BAR();
        }
}
__global__ void __launch_bounds__(NTHR, 2) hybrid_fwd(Args args) {
    extern __shared__ __attribute__((aligned(16))) unsigned char lds_raw[];
    Ctx C;
    C.lds = (LAS unsigned char*)lds_raw; C.tid = threadIdx.x; C.lane = 0; C.wave = __builtin_amdgcn_readfirstlane((int)threadIdx.x >> 6); C.G = gridDim.x;
    for (int u = C.tid; u < POOL_OFF / 4; u += NTHR) ((LAS unsigned*)(C.lds + LDSCTL_OFF))[u] = 0u;
    __syncthreads();
    if (N_LAUNCHES == 1) (void)xcd_barrier_post((unsigned*)((gu32*)(AWS + WS_CTL) + CW_BAR), (volatile LAS unsigned*)(C.lds + MISC_OFF) + 8);
    if (IN(0)) { p0_prologue(C); if (REP_PHASE == 0) p0_prologue(C); if (BOTH(0)) GRID_BAR(); }
    layer_phases<0>(C);
    layer_phases<1>(C);
    if (IN(17)) final_norm(C);
#ifdef IDX_DIAG
    if (IN(17)) { __syncthreads(); const unsigned nfb = __hip_atomic_load((unsigned*)(AWS + WS_CTL) + 2048, __ATOMIC_RELAXED, __HIP_MEMORY_SCOPE_AGENT); if (nfb > IDX_DIAG && blockIdx.x == 0) { AOUT[C.tid] = __builtin_nanf(""); } }
#endif
#undef IN
#undef BOTH
#undef lo
#undef hi
}

extern "C" void kernel_launch(void* const* d_in, const int* in_sizes, int n_in, void* d_out, int out_size, void* d_ws, size_t ws_size, hipStream_t stream) {
    static int grid = 0;
    if (grid == 0) {
        if (n_in != 21 || out_size != MTOK * DM || ws_size < WS_END) { fprintf(stderr, "kernel_launch: unexpected shapes (n_in %d out %d ws %zu)\n", n_in, out_size, ws_size); grid = -1; return; }
        int dev = 0, cus = 0, per_cu = 0;
        if (hipGetDevice(&dev) != hipSuccess || hipDeviceGetAttribute(&cus, hipDeviceAttributeMultiprocessorCount, dev) != hipSuccess) { grid = -1; return; }
        if (hipFuncSetAttribute((const void*)hybrid_fwd, hipFuncAttributeMaxDynamicSharedMemorySize, LDS_BYTES) != hipSuccess) { fprintf(stderr, "kernel_launch: hipFuncSetAttribute failed\n"); grid = -1; return; }
        if (hipOccupancyMaxActiveBlocksPerMultiprocessor(&per_cu, (const void*)hybrid_fwd, NTHR, LDS_BYTES) != hipSuccess || per_cu < 1) fprintf(stderr, "kernel_launch: occupancy query reports %d\n", per_cu);
        (void)hipGetLastError();
        grid = cus;
    }
    if (grid < 0) return;
    (void)hipMemsetAsync((char*)d_ws + WS_CTL, 0, CTL_ZERO_BYTES, stream);
    Args a{};
    for (int i = 0; i < 21; ++i) a.in[i] = (const float*)d_in[i];
    a.out = (float*)d_out; a.ws = (unsigned char*)d_ws;
    for (int li = 0; li < N_LAUNCHES; ++li) {
        a.ph_lo = (N_LAUNCHES == 1) ? 0 : li; a.ph_hi = (N_LAUNCHES == 1) ? NPH : li + 1; a.li = li;
        hipLaunchKernelGGL(hybrid_fwd, dim3(grid), dim3(NTHR), LDS_BYTES, stream, a);
    }
}
```

```cpp
#include <hip/hip_runtime.h>
#include <cstdio>
#include <cstdint>
namespace pg8 {
#define PG8_LAS __attribute__((address_space(3)))
typedef unsigned short bf16_t;
typedef short bf16x8 __attribute__((ext_vector_type(8)));
typedef float f32x4 __attribute__((ext_vector_type(4)));
typedef unsigned u32x4 __attribute__((ext_vector_type(4)));
constexpr int BM = 256, BK = 64, HALF = 128, HTB = HALF * BK * 2  , STAGE_BYTES = 8 * HTB, NXCD = 8, WGM = 8;

__host__ __device__ __forceinline__ int lds_byte(int r, int c) { const int st = (r >> 4) * 2 + (c >> 5), rr = r & 15, cc = c & 31, ob = rr * 64 + cc * 2; return st * 1024 + (ob ^ (((ob >> 9) & 1) << 5)); }
__host__ __device__ __forceinline__ void stage_rc(int b, int& R, int& C) { const int st = b / 1024, sb = b % 1024, swz = sb ^ (((sb >> 9) & 1) << 5); R = (st >> 1) * 16 + swz / 64; C = (st & 1) * 32 + (swz % 64) / 2; }
__host__ __device__ __forceinline__ int perm32(int rho) { const int n = rho >> 4, i = rho & 15; return 8 * (i >> 2) + 4 * n + (i & 3); }

struct Unit { int pm, pn, z; };
struct Gemm { const bf16_t* A; const bf16_t* Bt; int M, N, K, lda, ldb; const bf16_t* A2; const bf16_t* Bt2; };

struct StaticOrder {
    int nM, nN, nwg, G, c;
    __host__ __device__ void init(int M, int N, int G_, int c_) { nM = M / BM; nN = N / BM; nwg = nM * nN; G = G_; c = c_; }
    __host__ __device__ bool next(int i, Unit& u) const {
        const long L = (long)i * G + c; if (L >= nwg) return false;
        int wgid = (int)L; { const int q = nwg / NXCD, r = nwg % NXCD, xcd = wgid % NXCD, off = wgid / NXCD; wgid = (xcd < r ? xcd * (q + 1) : r * (q + 1) + (xcd - r) * q) + off; }
        const int nig = WGM * nN, gid = wgid / nig, fm = gid * WGM, gsz = (nM - fm) < WGM ? (nM - fm) : WGM;
        u.pm = fm + ((wgid % nig) % gsz); u.pn = (wgid % nig) / gsz; u.z = 0; return true;
    }
    __device__ __forceinline__ void a_ready(const Unit&) const {}
    __device__ __forceinline__ void done(const Unit&) const {}
};
struct DualOrder {
    StaticOrder S;
    __host__ __device__ void init(int M, int N, int G_, int c_) { S.init(M, N, G_, c_); }
    __host__ __device__ bool next(int i, Unit& u) const { if (!S.next(i >> 1, u)) return false; u.z = i & 1; return true; }
    __device__ __forceinline__ void a_ready(const Unit&) const {}
    __device__ __forceinline__ void done(const Unit&) const {}
};

__device__ __forceinline__ unsigned cvt_pk_bf16(float lo, float hi) { unsigned r; asm volatile("v_cvt_pk_bf16_f32 %0, %1, %2" : "=v"(r) : "v"(lo), "v"(hi)); return r; }
__device__ __forceinline__ float bf_lo(unsigned w) { return __uint_as_float(w << 16); }
__device__ __forceinline__ float bf_hi(unsigned w) { return __uint_as_float(w & 0xffff0000u); }
__device__ __forceinline__ float sigmoidf_(float x) { return __builtin_amdgcn_rcpf(1.0f + __builtin_amdgcn_exp2f(x * -1.4426950408889634f)); }
constexpr int PW = 5632;
constexpr float RMS_EPS = 1e-6f;
__device__ __forceinline__ float row_rstd(const float* rowss, int row) {
    const f32x4* p = (const f32x4*)(rowss + (size_t)row * 16);
    const f32x4 a = p[0], b = p[1], c = p[2], d = p[3];
    const float s = ((a[0] + a[1]) + (a[2] + a[3])) + ((b[0] + b[1]) + (b[2] + b[3])) + ((c[0] + c[1]) + (c[2] + c[3])) + ((d[0] + d[1]) + (d[2] + d[3]));
    float eps; asm volatile("s_mov_b32 %0, 0x358637bd" : "=s"(eps));
    return __builtin_amdgcn_rsqf(s * (1.0f / 1024.0f) + eps);
}
struct EpiProj {
    static constexpr bool PERM = true, AFTER_DRAIN = false;
    bf16_t* P; const float* rowss; const float* rcos; const float* rsin;
    __device__ __forceinline__ void operator()(const f32x4 (&acc)[2][2][4][2], const Unit& u, int wr, int wc, int fr, int fq) const {
        const int pn = u.pn;
        const bool rope_head = (pn <= 1) || (pn >= 5 && pn <= 8) || (pn == 11) || (pn == 12) || ((pn >= 2 && pn <= 4) && wc < 2) || (pn == 13 && wc == 0);
#pragma unroll
        for (int ai = 0; ai < 2; ++ai)
#pragma unroll
            for (int m = 0; m < 4; ++m) {
                const int row = u.pm * BM + ai * HALF + wr * 64 + m * 16 + fr;
                const float rs = row_rstd(rowss, row) * ((pn <= 1 || pn == 5 || pn == 6) ? 0.18033688011112042f : 1.0f);
                const int pos = row & 2047;
#pragma unroll
                for (int bj = 0; bj < 2; ++bj) {
                    f32x4 v0 = acc[ai][bj][m][0] * rs, v1 = acc[ai][bj][m][1] * rs;
                    if (rope_head && bj == 0) {
                        const f32x4 c0 = *(const f32x4*)(rcos + pos * 8), c1 = *(const f32x4*)(rcos + pos * 8 + 4);
                        const f32x4 s0 = *(const f32x4*)(rsin + pos * 8), s1 = *(const f32x4*)(rsin + pos * 8 + 4);
                        f32x4 p0, p1;
#pragma unroll
                        for (int e = 0; e < 4; ++e) { p0[e] = __shfl_xor(v0[e], 16); p1[e] = __shfl_xor(v1[e], 16); }
                        if (fq == 0) { v0 = v0 * c0 - p0 * s0; v1 = v1 * c1 - p1 * s1; }
                        else if (fq == 1) { v0 = v0 * c0 + p0 * s0; v1 = v1 * c1 + p1 * s1; }
                    }
                    if (pn >= 14) {
#pragma unroll
                        for (int e = 0; e < 4; ++e) { v0[e] = sigmoidf_(v0[e]); v1[e] = sigmoidf_(v1[e]); }
                    } else if (pn == 13 && wc == 1 && bj == 0) {
                        if (fq == 0) { v0 = v0 * 0.044194173824159216f; v1 = v1 * 0.044194173824159216f; }
                        else {
#pragma unroll
                            for (int e = 0; e < 4; ++e) { v0[e] = sigmoidf_(v0[e]); v1[e] = sigmoidf_(v1[e]); }
                        }
                    }
                    u32x4 w; w.x = cvt_pk_bf16(v0[0], v0[1]); w.y = cvt_pk_bf16(v0[2], v0[3]); w.z = cvt_pk_bf16(v1[0], v1[1]); w.w = cvt_pk_bf16(v1[2], v1[3]);
                    *(u32x4*)(P + (size_t)row * PW + pn * BM + wc * 64 + bj * 32 + 8 * fq) = w;
                }
            }
    }
};
struct EpiNull { static constexpr bool PERM = true, AFTER_DRAIN = false;
    __device__ __forceinline__ void operator()(const f32x4 (&acc)[2][2][4][2], const Unit&, int, int, int, int) const {
#pragma unroll
        for (int a = 0; a < 2; ++a)
#pragma unroll
            for (int b = 0; b < 2; ++b)
#pragma unroll
                for (int m = 0; m < 4; ++m) asm volatile("" :: "v"(acc[a][b][m][0]), "v"(acc[a][b][m][1])); } };
struct EpiBranch2 {
    static constexpr bool PERM = true, AFTER_DRAIN = false;
    bf16_t* Pb; int cg0, cg1, ct, co;
    __device__ __forceinline__ void operator()(const f32x4 (&acc)[2][2][4][2], const Unit& u, int wr, int wc, int fr, int fq) const {
        const int cg = u.z ? cg1 : cg0, cst = u.z ? co : ct;
#pragma unroll
        for (int ai = 0; ai < 2; ++ai)
#pragma unroll
            for (int m = 0; m < 4; ++m) {
                const int row = u.pm * BM + ai * HALF + wr * 64 + m * 16 + fr;
#pragma unroll
                for (int bj = 0; bj < 2; ++bj) {
                    const size_t off = (size_t)row * PW + u.pn * BM + wc * 64 + bj * 32 + 8 * fq;
                    const u32x4 gw = __builtin_nontemporal_load((const u32x4*)(Pb + off + cg));
                    f32x4 v0 = acc[ai][bj][m][0], v1 = acc[ai][bj][m][1];
                    v0[0] *= bf_lo(gw.x); v0[1] *= bf_hi(gw.x); v0[2] *= bf_lo(gw.y); v0[3] *= bf_hi(gw.y);
                    v1[0] *= bf_lo(gw.z); v1[1] *= bf_hi(gw.z); v1[2] *= bf_lo(gw.w); v1[3] *= bf_hi(gw.w);
                    if (u.z) { const u32x4 tw = *(const u32x4*)(Pb + off + ct);
                        v0[0] += bf_lo(tw.x); v0[1] += bf_hi(tw.x); v0[2] += bf_lo(tw.y); v0[3] += bf_hi(tw.y);
                        v1[0] += bf_lo(tw.z); v1[1] += bf_hi(tw.z); v1[2] += bf_lo(tw.w); v1[3] += bf_hi(tw.w); }
                    u32x4 w; w.x = cvt_pk_bf16(v0[0], v0[1]); w.y = cvt_pk_bf16(v0[2], v0[3]); w.z = cvt_pk_bf16(v1[0], v1[1]); w.w = cvt_pk_bf16(v1[2], v1[3]);
                    *(u32x4*)(Pb + off + cst) = w;
                }
            }
    }
};
struct EpiResid {
    static constexpr bool PERM = true, AFTER_DRAIN = false;
    bf16_t* X; float* ss;
    __device__ __forceinline__ void operator()(const f32x4 (&acc)[2][2][4][2], const Unit& u, int wr, int wc, int fr, int fq) const {
#pragma unroll
        for (int ai = 0; ai < 2; ++ai)
#pragma unroll
            for (int m = 0; m < 4; ++m) {
                const int row = u.pm * BM + ai * HALF + wr * 64 + m * 16 + fr;
                float q = 0.f;
#pragma unroll
                for (int bj = 0; bj < 2; ++bj) {
                    bf16_t* px = X + (size_t)row * 1024 + u.pn * BM + wc * 64 + bj * 32 + 8 * fq;
                    const u32x4 xw = *(const u32x4*)px;
                    f32x4 v0 = acc[ai][bj][m][0], v1 = acc[ai][bj][m][1];
                    v0[0] += bf_lo(xw.x); v0[1] += bf_hi(xw.x); v0[2] += bf_lo(xw.y); v0[3] += bf_hi(xw.y);
                    v1[0] += bf_lo(xw.z); v1[1] += bf_hi(xw.z); v1[2] += bf_lo(xw.w); v1[3] += bf_hi(xw.w);
                    q += ((v0[0] * v0[0] + v0[1] * v0[1]) + (v0[2] * v0[2] + v0[3] * v0[3])) + ((v1[0] * v1[0] + v1[1] * v1[1]) + (v1[2] * v1[2] + v1[3] * v1[3]));
                    u32x4 w; w.x = cvt_pk_bf16(v0[0], v0[1]); w.y = cvt_pk_bf16(v0[2], v0[3]); w.z = cvt_pk_bf16(v1[0], v1[1]); w.w = cvt_pk_bf16(v1[2], v1[3]);
                    *(u32x4*)px = w;
                }
                q += __shfl_xor(q, 16); q += __shfl_xor(q, 32);
                if (fq == 0) ss[(size_t)row * 16 + u.pn * 4 + wc] = q;
            }
    }
};
struct EpiSwiglu {
    static constexpr bool PERM = true, AFTER_DRAIN = false;
    bf16_t* H; const float* rowss;
    __device__ __forceinline__ void operator()(const f32x4 (&acc)[2][2][4][2], const Unit& u, int wr, int wc, int fr, int fq) const {
#pragma unroll
        for (int ai = 0; ai < 2; ++ai)
#pragma unroll
            for (int m = 0; m < 4; ++m) {
                const int row = u.pm * BM + ai * HALF + wr * 64 + m * 16 + fr;
                const float rs = row_rstd(rowss, row);
                float o[8];
#pragma unroll
                for (int n = 0; n < 2; ++n)
#pragma unroll
                    for (int e = 0; e < 4; ++e) { const float g = acc[ai][0][m][n][e] * rs, uu = acc[ai][1][m][n][e] * rs; o[n * 4 + e] = g * sigmoidf_(g) * uu; }
                u32x4 w; w.x = cvt_pk_bf16(o[0], o[1]); w.y = cvt_pk_bf16(o[2], o[3]); w.z = cvt_pk_bf16(o[4], o[5]); w.w = cvt_pk_bf16(o[6], o[7]);
                *(u32x4*)(H + (size_t)row * 2816 + u.pn * HALF + wc * 32 + 8 * fq) = w;
            }
    }
};
template <class Epi, class Sched, bool ALIGN_EPI = false, bool SP2 = false>
__device__ __forceinline__ void gemm_phase(PG8_LAS unsigned char* lds, const Gemm g, const Sched& S, const Epi& E, int wave_in) {
    int tid_; asm volatile("v_mbcnt_lo_u32_b32 %0, -1, 0\n\tv_mbcnt_hi_u32_b32 %0, -1, %0" : "=v"(tid_)); tid_ += wave_in * 64;
    const int tid = tid_, wid = __builtin_amdgcn_readfirstlane(tid >> 6), lane = tid & 63, wr = wid >> 2, wc = wid & 3, fr = lane & 15, fq = lane >> 4;
    const int K = g.K, nt = K / BK;
    unsigned voffA[2], voffB[2];
#pragma unroll
    for (int i = 0; i < 2; ++i) { int R, C; stage_rc(tid * 16 + i * 8192, R, C); const int Rb = Epi::PERM ? ((R & ~31) + perm32(R & 31)) : R;
        voffA[i] = (unsigned)(R * g.lda + C) * 2u; voffB[i] = (unsigned)(Rb * g.ldb + C) * 2u; }
    const size_t kstep = (size_t)(BK * 2);
    const size_t hstepA = (size_t)HALF * g.lda * 2, hstepB = (size_t)HALF * g.ldb * 2;
    const size_t tstepA = 2 * hstepA, tstepB = 2 * hstepB;
    const unsigned ldsw = (unsigned)wid * 1024u;
    const int aoff = lds_byte(wr * 64 + fr, fq * 8), boff = lds_byte(wc * 32 + fr, fq * 8);
#define PG8_SA(b, h) (((b) * 2 + (h)) * HTB)
#define PG8_SB(b, h) ((4 + (b) * 2 + (h)) * HTB)
#define PG8_STAGE(bufoff, gbase, voff) do { _Pragma("unroll") for (int _i = 0; _i < 2; ++_i) \
        __builtin_amdgcn_global_load_lds((const unsigned*)((const char*)(gbase) + (voff)[_i]), (PG8_LAS unsigned*)(lds + (bufoff) + ldsw + _i * 8192), 16, 0, 0); } while (0)
#define PG8_LDA(dst, b, h) do { _Pragma("unroll") for (int m = 0; m < 4; ++m) _Pragma("unroll") for (int k = 0; k < 2; ++k) dst[m][k] = *(const PG8_LAS bf16x8*)(lds + PG8_SA(b, h) + aoff + m * 2048 + k * 1024); } while (0)
#define PG8_LDB(dst, b, h) do { _Pragma("unroll") for (int n = 0; n < 2; ++n) _Pragma("unroll") for (int k = 0; k < 2; ++k) dst[n][k] = *(const PG8_LAS bf16x8*)(lds + PG8_SB(b, h) + boff + n * 2048 + k * 1024); } while (0)
#define PG8_MMA(ai, bj, At, Bt) do { __builtin_amdgcn_s_setprio(1); _Pragma("unroll") for (int m = 0; m < 4; ++m) _Pragma("unroll") for (int n = 0; n < 2; ++n) _Pragma("unroll") for (int k = 0; k < 2; ++k) \
        acc[ai][bj][m][n] = __builtin_amdgcn_mfma_f32_16x16x32_bf16(Bt[n][k], At[m][k], acc[ai][bj][m][n], 0, 0, 0); __builtin_amdgcn_s_setprio(0); } while (0)
#define PG8_WAIT_V(n) asm volatile("s_waitcnt vmcnt(" #n ")" ::: "memory")
#define PG8_WAIT_L(n) asm volatile("s_waitcnt lgkmcnt(" #n ")" ::: "memory")
#define PG8_BAR __builtin_amdgcn_s_barrier()
#define PG8_SCHED __builtin_amdgcn_sched_barrier(0)
    Unit cur, nxt; int ui = 0;
    if (!S.next(0, cur)) return;
    f32x4 acc[2][2][4][2];
#pragma unroll
    for (int a = 0; a < 2; ++a)
#pragma unroll
        for (int b = 0; b < 2; ++b)
#pragma unroll
            for (int m = 0; m < 4; ++m)
#pragma unroll
                for (int n = 0; n < 2; ++n) acc[a][b][m][n] = (f32x4){0.f, 0.f, 0.f, 0.f};
    bf16x8 At[4][2], B0[2][2], B1[2][2];
    const long dA2 = (const char*)g.A2 - (const char*)g.A, dB2 = (const char*)g.Bt2 - (const char*)g.Bt;
    const char* cA = (const char*)g.A + (cur.z ? dA2 : 0) + (size_t)cur.pm * tstepA; const char* cB = (const char*)g.Bt + (cur.z ? dB2 : 0) + (size_t)cur.pn * tstepB;
    S.a_ready(cur);
    if constexpr (SP2) {
        PG8_STAGE(PG8_SB(0, 0), cB, voffB); PG8_STAGE(PG8_SB(0, 1), cB + hstepB, voffB); PG8_STAGE(PG8_SA(0, 0), cA, voffA); PG8_STAGE(PG8_SA(0, 1), cA + hstepA, voffA);
        if (wr == 1) PG8_BAR;
        PG8_WAIT_V(2); PG8_BAR;
        PG8_STAGE(PG8_SB(1, 0), cB + kstep, voffB); PG8_STAGE(PG8_SA(1, 0), cA + kstep, voffA); PG8_STAGE(PG8_SB(1, 1), cB + hstepB + kstep, voffB);
        PG8_WAIT_V(6); PG8_BAR;
    } else {
        PG8_STAGE(PG8_SB(0, 0), cB, voffB); PG8_STAGE(PG8_SA(0, 0), cA, voffA); PG8_STAGE(PG8_SB(0, 1), cB + hstepB, voffB); PG8_STAGE(PG8_SA(0, 1), cA + hstepA, voffA);
        if (wr == 1) PG8_BAR;
        PG8_WAIT_V(4); PG8_BAR;
        PG8_STAGE(PG8_SB(1, 0), cB + kstep, voffB); PG8_STAGE(PG8_SA(1, 0), cA + kstep, voffA); PG8_STAGE(PG8_SB(1, 1), cB + hstepB + kstep, voffB);
        PG8_WAIT_V(6); PG8_BAR;
    }
    for (;;) {
        const bool has_next = S.next(ui + 1, nxt);
        const char* nA = has_next ? (const char*)g.A + (nxt.z ? dA2 : 0) + (size_t)nxt.pm * tstepA : cA; const char* nB = has_next ? (const char*)g.Bt + (nxt.z ? dB2 : 0) + (size_t)nxt.pn * tstepB : cB;
        for (int t = 0; t < nt; t += 2) {
            const bool last = (t == nt - 2);
            const char* a1 = cA + (size_t)(t + 1) * kstep;
            const char* a2 = last ? nA : cA + (size_t)(t + 2) * kstep; const char* b2 = last ? nB : cB + (size_t)(t + 2) * kstep;
            const char* a3 = a2 + kstep; const char* b3 = b2 + kstep;
            if (last && has_next) S.a_ready(nxt);
            if constexpr (SP2) {
            PG8_LDB(B0, 0, 0); PG8_LDB(B1, 0, 1); PG8_SCHED; PG8_LDA(At, 0, 0); PG8_STAGE(PG8_SA(1, 1), a1 + hstepA, voffA);
            PG8_WAIT_V(8); PG8_WAIT_L(0); PG8_BAR; PG8_MMA(0, 0, At, B0); PG8_MMA(0, 1, At, B1); PG8_BAR; PG8_SCHED;
            PG8_LDA(At, 0, 1); PG8_STAGE(PG8_SB(0, 0), b2, voffB); PG8_STAGE(PG8_SB(0, 1), b2 + hstepB, voffB); PG8_STAGE(PG8_SA(0, 0), a2, voffA);
            PG8_WAIT_V(8); PG8_WAIT_L(0); PG8_BAR; PG8_MMA(1, 0, At, B0); PG8_MMA(1, 1, At, B1); PG8_BAR; PG8_SCHED;
            PG8_LDB(B0, 1, 0); PG8_LDB(B1, 1, 1); PG8_SCHED; PG8_LDA(At, 1, 0); PG8_STAGE(PG8_SA(0, 1), a2 + hstepA, voffA);
            PG8_WAIT_V(8); PG8_WAIT_L(0); PG8_BAR; PG8_MMA(0, 0, At, B0); PG8_MMA(0, 1, At, B1); PG8_BAR; PG8_SCHED;
            PG8_LDA(At, 1, 1); PG8_STAGE(PG8_SB(1, 0), b3, voffB); PG8_STAGE(PG8_SB(1, 1), b3 + hstepB, voffB); PG8_STAGE(PG8_SA(1, 0), a3, voffA);
            PG8_WAIT_V(8); PG8_WAIT_L(0); PG8_BAR; PG8_MMA(1, 0, At, B0); PG8_MMA(1, 1, At, B1); PG8_BAR; PG8_SCHED;
            } else {
            PG8_LDB(B0, 0, 0); PG8_SCHED; PG8_LDA(At, 0, 0); PG8_STAGE(PG8_SA(1, 1), a1 + hstepA, voffA);
            PG8_WAIT_L(8); PG8_BAR; PG8_WAIT_L(0); PG8_MMA(0, 0, At, B0); PG8_BAR; PG8_SCHED;
            PG8_LDB(B1, 0, 1); PG8_STAGE(PG8_SB(0, 0), b2, voffB);
            PG8_BAR; PG8_WAIT_L(0); PG8_MMA(0, 1, At, B1); PG8_BAR;
            PG8_LDA(At, 0, 1); PG8_STAGE(PG8_SA(0, 0), a2, voffA);
            PG8_BAR; PG8_WAIT_L(0); PG8_MMA(1, 0, At, B0); PG8_BAR; PG8_SCHED;
            PG8_STAGE(PG8_SB(0, 1), b2 + hstepB, voffB);
            PG8_WAIT_V(6); PG8_BAR; PG8_MMA(1, 1, At, B1); PG8_BAR;
            PG8_LDB(B0, 1, 0); PG8_SCHED; PG8_LDA(At, 1, 0); PG8_STAGE(PG8_SA(0, 1), a2 + hstepA, voffA);
            PG8_WAIT_L(8); PG8_BAR; PG8_WAIT_L(0); PG8_MMA(0, 0, At, B0); PG8_BAR; PG8_SCHED;
            PG8_LDB(B1, 1, 1); PG8_STAGE(PG8_SB(1, 0), b3, voffB);
            PG8_BAR; PG8_WAIT_L(0); PG8_MMA(0, 1, At, B1); PG8_BAR;
            PG8_LDA(At, 1, 1); PG8_STAGE(PG8_SA(1, 0), a3, voffA);
            PG8_BAR; PG8_WAIT_L(0); PG8_MMA(1, 0, At, B0); PG8_BAR; PG8_SCHED;
            PG8_STAGE(PG8_SB(1, 1), b3 + hstepB, voffB);
            PG8_WAIT_V(6); PG8_BAR; PG8_MMA(1, 1, At, B1); PG8_BAR;
            }
        }
        if constexpr (ALIGN_EPI) { if (wr == 0) PG8_BAR; }
        if constexpr (!Epi::AFTER_DRAIN) { E(acc, cur, wr, wc, fr, fq); S.done(cur); }
        if (!has_next) break;
#pragma unroll
        for (int a = 0; a < 2; ++a)
#pragma unroll
            for (int b = 0; b < 2; ++b)
#pragma unroll
                for (int m = 0; m < 4; ++m)
#pragma unroll
                    for (int n = 0; n < 2; ++n) acc[a][b][m][n] = (f32x4){0.f, 0.f, 0.f, 0.f};
        cur = nxt; cA = nA; cB = nB; ++ui;
        if constexpr (ALIGN_EPI) { if (wr == 1) PG8_BAR; }
    }
    PG8_WAIT_V(0);
    if constexpr (!ALIGN_EPI) { if (wr == 0) PG8_BAR; }
    PG8_BAR;
    if constexpr (Epi::AFTER_DRAIN) { E.fused(acc, cur, wr, wc, fr, fq, lds, wid, lane); S.done(cur); }
#undef PG8_SA
#undef PG8_SB
#undef PG8_STAGE
#undef PG8_LDA
#undef PG8_LDB
#undef PG8_MMA
#undef PG8_WAIT_V
#undef PG8_WAIT_L
#undef PG8_BAR
#undef PG8_SCHED
}
}

constexpr int NB = 16, SEQ = 2048, DM = 1024, MTOK = NB * SEQ, DEPTH = 2, DIN = 5472, DFF = 2816;
using pg8::PW;
constexpr int C_NQ = 0, C_KCMP = 512, C_VCMP = 640, C_KSLC = 768, C_VSLC = 896, C_KWIN = 1024, C_VWIN = 1152, C_DQ = 1280, C_DK = 1792, C_DV = 2304,
              C_IQ = 2816, C_IK = 3328, C_IW = 3392, C_NG = 3400, C_GN = 3584, C_GD = 4608;
constexpr int C_TMP = 0, C_MRG = 1024;
__host__ __device__ __forceinline__ int proj_src_col(int n) {
    if (n < 1280) return n;
    if (n < 2816) return n - 1280 + 1304;
    if (n < 3328) return n - 2816 + 2840;
    if (n < 3392) return n - 3328 + 3352;
    if (n < 3400) return n - 3392 + 3416;
    if (n < 3424) return n - 3400 + 1280;
    if (n < 3584) return -1;
    return n - 3584 + 3424;
}
constexpr size_t MiB = 1u << 20;
constexpr size_t WS_CTL = 0, CTL_ZERO_BYTES = 65536;
constexpr size_t WS_ROPE = 1 * MiB;
constexpr size_t WS_CB1 = WS_ROPE + 131072;
constexpr size_t WS_RSS = 2 * MiB;
constexpr size_t WS_KC = 4 * MiB;
constexpr size_t WS_KCB = 6 * MiB;
constexpr size_t WS_SELM = 7 * MiB;
constexpr size_t WS_DMASK = 8 * MiB;
constexpr size_t WS_WIN = 16 * MiB;
constexpr size_t SZ_WIN = (size_t)PW * DM * 2, SZ_WBR = (size_t)DM * 512 * 2, SZ_WOUT = (size_t)DM * DM * 2, SZ_WGU = (size_t)PW * DM * 2, SZ_WDN = (size_t)DM * DFF * 2;
constexpr size_t WS_WBN = WS_WIN + DEPTH * SZ_WIN, WS_WBD = WS_WBN + DEPTH * SZ_WBR, WS_WOUT = WS_WBD + DEPTH * SZ_WBR, WS_WGU = WS_WOUT + DEPTH * SZ_WOUT, WS_WDN = WS_WGU + DEPTH * SZ_WGU;
constexpr size_t WS_W1B = WS_WDN + DEPTH * SZ_WDN;
constexpr size_t WS_R1 = 88 * MiB;
constexpr size_t WS_P = 152 * MiB;
constexpr size_t WS_END = WS_P + (size_t)MTOK * PW * 2;
static_assert(WS_W1B + 2 * MiB <= WS_R1 && WS_END <= 512 * MiB, "d_ws map");
constexpr int CW_TMO = 0, CW_CODE = 1, CW_BAR = 4096;

constexpr int LDSCTL_OFF = 0, MISC_OFF = 320, POOL_OFF = 1024;
constexpr int LDS_BYTES = 147456, POOL_BYTES = LDS_BYTES - POOL_OFF;
constexpr int NWAVES = 8, NTHR = 512;
#define GAS __attribute__((address_space(1)))
#define LAS __attribute__((address_space(3)))
typedef unsigned short bf16;
typedef unsigned v4u __attribute__((ext_vector_type(4)));
typedef float f32x4 __attribute__((ext_vector_type(4)));
typedef short bf16x8 __attribute__((ext_vector_type(8)));
typedef GAS unsigned gu32;
typedef GAS unsigned long long gu64;
#define RLX_AGENT __ATOMIC_RELAXED, __HIP_MEMORY_SCOPE_AGENT
#define LDS_WAIT() asm volatile("s_waitcnt lgkmcnt(0)" ::: "memory")
#define VM_WAIT() asm volatile("s_waitcnt vmcnt(0)" ::: "memory")
__device__ __forceinline__ unsigned long long rt() { return __builtin_amdgcn_s_memrealtime(); }
__device__ __forceinline__ unsigned f2bf(float f) { unsigned u = __builtin_bit_cast(unsigned, f); return (u + 0x7fffu + ((u >> 16) & 1u)) >> 16; }
__device__ __forceinline__ unsigned pk2(float lo, float hi) { return f2bf(lo) | (f2bf(hi) << 16); }

#define XB_TMO      128
#define XB_XCNT(j)  (256  + 64 * (j))
#define XB_XSUB(j)  (1280 + 64 * (j))
#define XB_XGEN(j)  (2304 + 64 * (j))
#define XB_TOP      3328
#define XB_TOPGEN   3392
#define XCD_BAR_WORDS 3456
#define XB_SPIN_CAP (1u << 18)

__device__ __forceinline__ unsigned xb_ld(unsigned* p)              { return __hip_atomic_load(p, __ATOMIC_RELAXED, __HIP_MEMORY_SCOPE_AGENT); }
__device__ __forceinline__ unsigned xb_add(unsigned* p, unsigned v) { return __hip_atomic_fetch_add(p, v, __ATOMIC_RELAXED, __HIP_MEMORY_SCOPE_AGENT); }
__device__ __forceinline__ unsigned xb_xcc_id() { return (unsigned)__builtin_amdgcn_s_getreg((3 << 11) | 20) & 0xFu; }
#define XB_SPIN(cond, bar) do { unsigned _sp = 0; while (cond) { __builtin_amdgcn_s_sleep(1); \
    if ((++_sp & 255u) == 0u) { if (xb_ld(&(bar)[XB_TMO])) break; if (_sp > XB_SPIN_CAP) { atomicAdd(&(bar)[XB_TMO], 1u); break; } } } } while (0)

struct XcdBarrier {
    unsigned* bar; unsigned x;
    volatile LAS unsigned* st;
};

__device__ __forceinline__ XcdBarrier xcd_barrier_post(unsigned* bar, volatile LAS unsigned* st) {
    XcdBarrier b; b.bar = bar; b.x = xb_xcc_id(); b.st = st;
    if (threadIdx.x == 0) (void)xb_add(&bar[XB_XCNT(b.x)], 1u);
    return b;
}
__device__ __forceinline__ void xcd_barrier_complete(unsigned* bar, unsigned x, unsigned& nloc, unsigned& nx) {
    const unsigned G = gridDim.x * gridDim.y * gridDim.z;
    unsigned sum, cnt, mine, sp = 0u;
    for (;;) {
        sum = 0u; cnt = 0u; mine = 0u;
#pragma unroll
        for (unsigned j = 0; j < 16; ++j) { const unsigned c = xb_ld(&bar[XB_XCNT(j)]); sum += c; cnt += (c > 0u) ? 1u : 0u; mine = (j == x) ? c : mine; }
        if (sum == G) break;
        __builtin_amdgcn_s_sleep(1);
        if ((++sp & 255u) == 0u) { if (xb_ld(&bar[XB_TMO])) break; if (sp > XB_SPIN_CAP) { atomicAdd(&bar[XB_TMO], 1u); break; } }
    }
    nloc = mine > 0u ? mine : 1u; nx = cnt > 0u ? cnt : 1u;
}

__device__ __forceinline__ void xcd_barrier(const XcdBarrier& b) {
    asm volatile("s_waitcnt vmcnt(0)" ::: "memory");
    __syncthreads();
    if (threadIdx.x == 0) {
        unsigned* bar = b.bar;
        __builtin_amdgcn_s_waitcnt(0);
        unsigned nloc = b.st[0], nx = b.st[1];
        if (nloc == 0u) { xcd_barrier_complete(bar, b.x, nloc, nx); b.st[0] = nloc; b.st[1] = nx; }
        const unsigned old = xb_add(&bar[XB_XSUB(b.x)], 1u);
        const unsigned gen = old / nloc;
        if (old + 1u == (gen + 1u) * nloc) {
            __builtin_amdgcn_fence(__ATOMIC_RELEASE, "agent");
            asm volatile("s_waitcnt vmcnt(0)" ::: "memory");
            const unsigned og = xb_add(&bar[XB_TOP], 1u);
            const unsigned tg = og / nx;
            if (og + 1u == (tg + 1u) * nx) xb_add(&bar[XB_TOPGEN], 1u);
            else XB_SPIN(xb_ld(&bar[XB_TOPGEN]) == tg, bar);
            __builtin_amdgcn_fence(__ATOMIC_ACQUIRE, "agent");
            xb_add(&bar[XB_XGEN(b.x)], 1u);
            asm volatile("s_waitcnt vmcnt(0)" ::: "memory");
        } else {
            XB_SPIN(xb_ld(&bar[XB_XGEN(b.x)]) == gen, bar);
            __builtin_amdgcn_fence(__ATOMIC_ACQUIRE, "agent");
            asm volatile("s_waitcnt vmcnt(0)" ::: "memory");
        }
    }
    __syncthreads();
}
struct Args { const float* in[21]; float* out; unsigned char* ws; int ph_lo, ph_hi, li, pad; };
struct Ctx { LAS unsigned char* lds; int tid, lane, wave, G; };
typedef const __attribute__((address_space(4))) Args* KArgs;
__device__ __forceinline__ KArgs kargs() { KArgs p = (KArgs)__builtin_amdgcn_kernarg_segment_ptr(); asm volatile("" : "+s"(p)); return p; }
__device__ __forceinline__ int fresh_tid(const Ctx& C0) { int ln; asm volatile("v_mbcnt_lo_u32_b32 %0, -1, 0\n\tv_mbcnt_hi_u32_b32 %0, -1, %0" : "=v"(ln)); return C0.wave * 64 + ln; }
#define AIN(i) (kargs()->in[i])
#define AOUT (kargs()->out)
#define AWS (kargs()->ws)
__device__ __forceinline__ float bf2f(bf16 b) { return __uint_as_float((unsigned)b << 16); }
__device__ __forceinline__ float wave_sum(float v) {
#pragma unroll
    for (int o = 1; o < 64; o <<= 1) v += __shfl_xor(v, o);
    return v;
}
__device__ __forceinline__ float wave_max(float v) {
#pragma unroll
    for (int o = 1; o < 64; o <<= 1) v = fmaxf(v, __shfl_xor(v, o));
    return v;
}
__host__ __device__ __forceinline__ int mask_bitpos(int u) { return (u & 3) + 4 * (u >> 3) + 16 * ((u >> 2) & 1); }

__device__ __forceinline__ void p0_transpose_item(const float* srcp, int Ns, bf16* WT, int K, int k0, int n0, LAS float* scr, int lane, const float* gk = nullptr) {
    float tv[32];
#pragma unroll
    for (int i = 0; i < 32; ++i) { const int kk = 2 * i + (lane >> 5); tv[i] = srcp ? __builtin_nontemporal_load(srcp + (size_t)(k0 + kk) * Ns) : 0.f; }
#pragma unroll
    for (int i = 0; i < 32; ++i) { const int kk = 2 * i + (lane >> 5); scr[kk * 33 + (lane & 31)] = gk ? tv[i] * gk[k0 + kk] : tv[i]; }
    LDS_WAIT(); asm volatile("" ::: "memory");
    const int c = lane & 7;
#pragma unroll
    for (int j = 0; j < 4; ++j) { const int n = (lane >> 3) + 8 * j; const LAS float* s = scr + (8 * c) * 33 + n;
        v4u o; o.x = pk2(s[0 * 33], s[1 * 33]); o.y = pk2(s[2 * 33], s[3 * 33]); o.z = pk2(s[4 * 33], s[5 * 33]); o.w = pk2(s[6 * 33], s[7 * 33]);
        *(GAS v4u*)(WT + (size_t)(n0 + n) * K + k0 + 8 * c) = o; }
    LDS_WAIT(); asm volatile("" ::: "memory");
}
__device__ __forceinline__ void sincos_small(double r, double& s, double& c) {
    const double r2 = r * r; double ts = 1.0, tc = 1.0, ss = 1.0, cc = 1.0;
#pragma unroll
    for (int k = 1; k <= 14; ++k) { tc = -tc * r2 * (1.0 / (double)((2 * k - 1) * (2 * k))); ts = -ts * r2 * (1.0 / (double)((2 * k) * (2 * k + 1))); cc += tc; ss += ts; }
    s = r * ss; c = cc;
}
__device__ __forceinline__ void p0_prologue(Ctx& C0) {
    Ctx C = C0; C.tid = fresh_tid(C0); C.lane = C.tid & 63;
    LAS float* scr = (LAS float*)(C.lds + POOL_OFF + C.wave * 16384);
    const int gw = blockIdx.x * NWAVES + C.wave, NGW = C.G * NWAVES, lane = C.lane;
    constexpr int I_WIN = 16 * (PW / 32), I_WBR = 8 * 32, I_WOUT = 16 * 32, I_WGU = 16 * (PW / 32), I_WDN = 44 * 32, I_L = I_WIN + 2 * I_WBR + I_WOUT + I_WGU + I_WDN;
    for (int it = gw; it < DEPTH * I_L; it += NGW) {
        const int l = it / I_L; int r = it % I_L;
        if (r < I_WIN) { const int nblk = PW / 32, kb = r / nblk, nb = r % nblk, n = nb * 32 + (lane & 31), rho = n & 255,
                sc = proj_src_col((n & ~255) + 64 * ((rho >> 5) & 3) + 32 * (rho >> 7) + (rho & 31));
            p0_transpose_item(sc >= 0 ? AIN(2) + (size_t)l * DM * DIN + sc : nullptr, DIN, (bf16*)(AWS + WS_WIN + l * SZ_WIN), DM, kb * 64, nb * 32, scr, lane, AIN(1) + l * DM); continue; } r -= I_WIN;
        if (r < I_WBR) { const int kb = r / 32, nb = r % 32, n0_ = nb * 32 + (lane & 31), rho = n0_ & 255, n = (n0_ & ~255) + 64 * ((rho >> 5) & 3) + 32 * (rho >> 7) + (rho & 31);
            p0_transpose_item(AIN(13) + (size_t)l * 512 * DM + n, DM, (bf16*)(AWS + WS_WBN + l * SZ_WBR), 512, kb * 64, nb * 32, scr, lane); continue; } r -= I_WBR;
        if (r < I_WBR) { const int kb = r / 32, nb = r % 32, n0_ = nb * 32 + (lane & 31), rho = n0_ & 255, n = (n0_ & ~255) + 64 * ((rho >> 5) & 3) + 32 * (rho >> 7) + (rho & 31);
            p0_transpose_item(AIN(14) + (size_t)l * 512 * DM + n, DM, (bf16*)(AWS + WS_WBD + l * SZ_WBR), 512, kb * 64, nb * 32, scr, lane); continue; } r -= I_WBR;
        if (r < I_WOUT) { const int kb = r / 32, nb = r % 32, n0_ = nb * 32 + (lane & 31), rho = n0_ & 255, n = (n0_ & ~255) + 64 * ((rho >> 5) & 3) + 32 * (rho >> 7) + (rho & 31);
            p0_transpose_item(AIN(15) + (size_t)l * DM * DM + n, DM, (bf16*)(AWS + WS_WOUT + l * SZ_WOUT), DM, kb * 64, nb * 32, scr, lane); continue; } r -= I_WOUT;
        if (r < I_WGU) { const int nblk = PW / 32, kb = r / nblk, nb = r % nblk, n = nb * 32 + (lane & 31), j = n & 255, hcol = (n >> 8) * 128 + (j & 127);
            const float* src = (j < 128 ? AIN(17) : AIN(18)) + (size_t)l * DM * DFF + hcol;
            p0_transpose_item(src, DFF, (bf16*)(AWS + WS_WGU + l * SZ_WGU), DM, kb * 64, nb * 32, scr, lane, AIN(16) + l * DM); continue; } r -= I_WGU;
        { const int kb = r / 32, nb = r % 32, n0_ = nb * 32 + (lane & 31), rho = n0_ & 255, n = (n0_ & ~255) + 64 * ((rho >> 5) & 3) + 32 * (rho >> 7) + (rho & 31);
            p0_transpose_item(AIN(19) + (size_t)l * DFF * DM + n, DM, (bf16*)(AWS + WS_WDN + l * SZ_WDN), DFF, kb * 64, nb * 32, scr, lane); }
    }
    for (int it = gw; it < DEPTH * 2 * 32 * 4; it += NGW) {
        const int l = it / 256, r = it % 256, kv = r / 128, kb = (r % 128) / 4, nb = r % 4, n = nb * 32 + (lane & 31);
        p0_transpose_item(AIN(kv ? 9 : 4) + (size_t)l * 2048 * 128 + n, 128, (bf16*)(AWS + WS_W1B) + (size_t)(l * 2 + kv) * 128 * 2048, 2048, kb * 64, nb * 32, scr, lane);
    }
    {
        bf16* XG = (bf16*)(AWS + WS_R1); float* rss = (float*)(AWS + WS_RSS);
        const float* xin = AIN(0);
        for (int m0 = gw * 2; m0 < MTOK; m0 += NGW * 2) {
            f32x4 v[2][4];
#pragma unroll
            for (int rr = 0; rr < 2; ++rr)
#pragma unroll
                for (int j = 0; j < 4; ++j) v[rr][j] = __builtin_nontemporal_load((const GAS f32x4*)(xin + (size_t)(m0 + rr) * DM) + lane + 64 * j);
#pragma unroll
            for (int rr = 0; rr < 2; ++rr) { const int m = m0 + rr;
                GAS unsigned long long* o8 = (GAS unsigned long long*)(XG + (size_t)m * DM) + lane;
                float s = 0.f;
#pragma unroll
                for (int j = 0; j < 4; ++j) { const f32x4 vv = v[rr][j]; s += (vv.x * vv.x + vv.y * vv.y) + (vv.z * vv.z + vv.w * vv.w); const f32x4 y = vv;
                    o8[64 * j] = (unsigned long long)pk2(y.x, y.y) | ((unsigned long long)pk2(y.z, y.w) << 32); }
                s = wave_sum(s);
                if (lane < 16) rss[(size_t)m * 16 + lane] = (lane == 0) ? s : 0.f; }
        }
    }
    {
        float* rc = (float*)(AWS + WS_ROPE); float* rsn = rc + 2048 * 8;
        const float invf[8] = {1.0f, 0.1939227432012558f, 0.03760603070259094f, 0.007292664609849453f, 0.0014142135623842478f, 0.00027424818836152554f, 5.3182957344688475e-05f, 1.0313385246263351e-05f};
        for (int i = blockIdx.x * NTHR + C.tid; i < 2048 * 8; i += C.G * NTHR) {
            const int pos = i >> 3, j = i & 7; float f = invf[0];
#pragma unroll
            for (int q = 1; q < 8; ++q) f = (j == q) ? invf[q] : f;
            const float ang = (float)pos * f; const double a = (double)ang;
            const double k = __builtin_rint(a * 0.15915494309189535); const double r = (a - k * 6.283185307179586) - k * 2.4492935982947064e-16;
            double s, c; sincos_small(r, s, c);
            rc[i] = (float)c; rsn[i] = (float)s;
        }
    }
    for (int it = blockIdx.x; it < DEPTH * 2 * 64; it += C.G) {
        const int lkv = it >> 6, ks = it & 63, l = lkv >> 1, kv = lkv & 1; const float* pos = AIN(kv ? 8 : 3) + (size_t)l * 2048; const float* w1 = AIN(kv ? 9 : 4) + (size_t)l * 2048 * 128;
        LAS float* red = (LAS float*)(C.lds + POOL_OFF);
        __syncthreads();
        const int n = C.tid & 127, q = C.tid >> 7; float a = 0.f;
#pragma unroll
        for (int k = 32 * ks + 8 * q; k < 32 * ks + 8 * q + 8; ++k) a += pos[k] * w1[(size_t)k * 128 + n];
        red[C.tid] = a; __syncthreads();
        if (C.tid < 128) ((float*)(AWS + WS_CB1))[(lkv * 64 + ks) * 128 + n] = (red[n] + red[128 + n]) + (red[256 + n] + red[384 + n]);
        __syncthreads();
    }
}
__device__ __forceinline__ float gelu_tanh(float x) { const float u = 0.7978845608028654f * (x + 0.044715f * x * x * x); const float t = 1.0f - 2.0f / (__expf(2.0f * u) + 1.0f); return 0.5f * x * (1.0f + t); }
__device__ __forceinline__ void final_norm(Ctx& C0) {
    Ctx C = C0; C.tid = fresh_tid(C0); C.lane = C.tid & 63; __syncthreads();
    const float* gn = AIN(20); const int lane = C.lane, wave = C.tid >> 6; const float* rss = (const float*)(AWS + WS_RSS); const bf16* X = (const bf16*)(AWS + WS_R1);
    f32x4 g[4];
#pragma unroll
    for (int j = 0; j < 4; ++j) g[j] = ((const f32x4*)gn)[lane + 64 * j];
    for (int m = blockIdx.x * NWAVES + wave; m < MTOK; m += C.G * NWAVES) {
        GAS f32x4* orow = (GAS f32x4*)(AOUT + (size_t)m * DM) + lane;
        const unsigned long long* xr = (const unsigned long long*)(X + (size_t)m * DM) + lane;
        const float rs = pg8::row_rstd(rss, m);
#pragma unroll
        for (int j = 0; j < 4; ++j) { const unsigned long long w = __builtin_nontemporal_load(xr + 64 * j); const unsigned wl = (unsigned)w, wh = (unsigned)(w >> 32);
            const f32x4 x = {pg8::bf_lo(wl), pg8::bf_hi(wl), pg8::bf_lo(wh), pg8::bf_hi(wh)};
            __builtin_nontemporal_store(x * rs * g[j], orow + 64 * j); }
    }
}
namespace fa {
typedef float f32x16 __attribute__((ext_vector_type(16)));
typedef short s16x4 __attribute__((ext_vector_type(4)));
typedef short v4i16_t __attribute__((ext_vector_type(4)));
typedef short bf16x8 __attribute__((ext_vector_type(8)));
typedef unsigned u32x4 __attribute__((ext_vector_type(4)));
typedef float f32x2_t __attribute__((ext_vector_type(2))); typedef __bf16 bf16x2_t __attribute__((ext_vector_type(2)));
constexpr int SLOTB = 8192, NSLOT = 3;
constexpr int L_K = 0, L_V = NSLOT * SLOTB, L_WS = 2 * NSLOT * SLOTB, L_OST = L_WS + 8 * 256, L_END = L_OST + 8 * 4096;
constexpr float BIGSUM = 1.0e18f;
struct W { int lane, r32, hi, wid; LAS unsigned char* shm; };
__device__ __forceinline__ int crow(int r, int hi) { return (r & 3) + 8 * (r >> 2) + 4 * hi; }
__device__ __forceinline__ unsigned cvtpk(float lo, float hi) { f32x2_t v = {lo, hi}; bf16x2_t b = __builtin_convertvector(v, bf16x2_t); return __builtin_bit_cast(unsigned, b); }
__device__ __forceinline__ float max3f(float a, float b, float c) { return __builtin_fmaxf(__builtin_fmaxf(a, b), c); }
#define FA_WAIT_BAR(N) asm volatile("s_waitcnt vmcnt(" #N ") lgkmcnt(0)\n\ts_barrier" ::: "memory")
__device__ __forceinline__ void glds16(const void* gsrc, unsigned lds_dst) { unsigned keep;
    asm volatile("s_mov_b32 %0, m0\n\ts_mov_b32 m0, %2\n\ts_nop 0\n\tglobal_load_lds_dwordx4 %1, off\n\ts_mov_b32 m0, %0" : "=&s"(keep) : "v"(gsrc), "s"(lds_dst) : "memory"); }
__device__ __forceinline__ void dma_tile(const W& w, const bf16* Kb, const bf16* Vb, int pitch, int tile, int slot) {
    const bf16* ks = Kb + (size_t)(64 * tile + w.lane) * pitch + w.wid * 8;
    const bf16* vs = Vb + (size_t)(64 * tile + 16 * (w.wid & 3) + (w.lane >> 2)) * pitch + (w.wid >> 2) * 32 + (w.lane & 3) * 8;
    const unsigned l0 = (unsigned)(uintptr_t)(w.shm) + slot * SLOTB + w.wid * 1024;
    glds16(ks, (unsigned)__builtin_amdgcn_readfirstlane(l0 + L_K)); glds16(vs, (unsigned)__builtin_amdgcn_readfirstlane(l0 + L_V));
}
__device__ __forceinline__ void qkt(f32x16& p0, f32x16& p1, const LAS unsigned char* Kslot, const bf16x8 (&qr)[4], int r32, int hi) {
    const f32x16 zero = f32x16{};
    const LAS unsigned char* kb = Kslot + hi * 1024 + r32 * 16;
#pragma unroll
    for (int dh = 0; dh < 2; ++dh) {
        bf16x8 b0[2], b1[2];
#pragma unroll
        for (int d = 0; d < 2; ++d) { b0[d] = *(const LAS bf16x8*)(kb + (2 * dh + d) * 2048); b1[d] = *(const LAS bf16x8*)(kb + (2 * dh + d) * 2048 + 512); }
        __builtin_amdgcn_sched_barrier(0);
#pragma unroll
        for (int d = 0; d < 2; ++d) { const int d0 = 2 * dh + d;
            if (d0 == 0) { p0 = __builtin_amdgcn_mfma_f32_32x32x16_bf16(b0[d], qr[0], zero, 0, 0, 0); p1 = __builtin_amdgcn_mfma_f32_32x32x16_bf16(b1[d], qr[0], zero, 0, 0, 0); }
            else { p0 = __builtin_amdgcn_mfma_f32_32x32x16_bf16(b0[d], qr[d0], p0, 0, 0, 0); p1 = __builtin_amdgcn_mfma_f32_32x32x16_bf16(b1[d], qr[d0], p1, 0, 0, 0); } }
    }
}
__device__ __forceinline__ s16x4 vtr(const LAS unsigned char* p) { return __builtin_bit_cast(s16x4, __builtin_amdgcn_ds_read_tr16_b64_v4i16((LAS v4i16_t*)p)); }
__device__ __forceinline__ void pv(f32x16 (&o)[2], const LAS unsigned char* vp, const u32x4 (&pw)[4]) {
#pragma unroll
    for (int d0 = 0; d0 < 2; ++d0) {
        s16x4 lo[4], hi[4];
#pragma unroll
        for (int ks = 0; ks < 4; ++ks) { lo[ks] = vtr(vp + d0 * 4096 + ks * 1024); hi[ks] = vtr(vp + d0 * 4096 + ks * 1024 + 512); }
        __builtin_amdgcn_sched_barrier(0);
#pragma unroll
        for (int ks = 0; ks < 4; ++ks) { const bf16x8 vf = {lo[ks][0], lo[ks][1], lo[ks][2], lo[ks][3], hi[ks][0], hi[ks][1], hi[ks][2], hi[ks][3]};
            o[d0] = __builtin_amdgcn_mfma_f32_32x32x16_bf16(__builtin_bit_cast(bf16x8, pw[ks]), vf, o[d0], 0, 0, 0); }
    }
}
__device__ __forceinline__ float half_swap(float v) { const auto rr = __builtin_amdgcn_permlane32_swap(__float_as_uint(v), __float_as_uint(v), false, false); return __uint_as_float(rr[0] == __float_as_uint(v) ? rr[1] : rr[0]); }
__device__ __forceinline__ float rowmax(const f32x16& p0, const f32x16& p1) {
    float a = max3f(p0[0], p0[1], p1[0]), b = max3f(p0[2], p0[3], p1[1]); a = max3f(a, p1[2], p1[3]);
#pragma unroll
    for (int r = 4; r < 16; r += 4) { a = max3f(a, p0[r], p0[r + 1]); b = max3f(b, p0[r + 2], p0[r + 3]); a = max3f(a, p1[r], p1[r + 1]); b = max3f(b, p1[r + 2], p1[r + 3]); }
    const float m = __builtin_fmaxf(a, b);
    const auto rr = __builtin_amdgcn_permlane32_swap(__float_as_uint(m), __float_as_uint(m), false, false);
    return __builtin_fmaxf(__uint_as_float(rr[0]), __uint_as_float(rr[1]));
}
struct St { f32x16 o[2]; float mref, l; bool moved; };
__device__ __forceinline__ void st_init(St& s) { s.o[0] = f32x16{}; s.o[1] = f32x16{}; s.mref = 0.f; s.l = 0.f; s.moved = false; }
template <class MaskF> __device__ __forceinline__ void tile_step(const W& w, int slot, const bf16x8 (&qr)[4], MaskF& MF, St& s) {
    f32x16 p0, p1;
    qkt(p0, p1, w.shm + L_K + slot * SLOTB, qr, w.r32, w.hi);
    if (__builtin_expect(s.moved, 0)) {
#pragma unroll
        for (int r = 0; r < 16; ++r) { p0[r] -= s.mref; p1[r] -= s.mref; } }
    MF.pre(p0, p1);
#pragma unroll
    for (int r = 0; r < 16; ++r) { p0[r] = __builtin_amdgcn_exp2f(p0[r]); p1[r] = __builtin_amdgcn_exp2f(p1[r]); }
    MF.post(p0, p1);
    float sa = 0.f, sb = 0.f;
#pragma unroll
    for (int r = 0; r < 16; ++r) { sa += p0[r]; sb += p1[r]; }
    float tot = sa + sb;
    if (__builtin_expect(__any(!(tot < BIGSUM)), 0)) {
        qkt(p0, p1, w.shm + L_K + slot * SLOTB, qr, w.r32, w.hi);
        if (s.moved) {
#pragma unroll
            for (int r = 0; r < 16; ++r) { p0[r] -= s.mref; p1[r] -= s.mref; } }
        MF.pre(p0, p1); MF.pre_slow(p0, p1);
        const float rm = rowmax(p0, p1);
        const float dl = __builtin_fmaxf(rm, 0.f); s.mref += dl; s.moved = true;
#pragma unroll
        for (int r = 0; r < 16; ++r) { p0[r] -= dl; p1[r] -= dl; }
        const float f = __builtin_amdgcn_exp2f(-dl); s.l *= f;
        LAS float* wsf = (LAS float*)(w.shm + L_WS) + w.wid * 64;
        if (w.hi == 0) wsf[w.r32] = f;
        asm volatile("s_waitcnt lgkmcnt(0)" ::: "memory");
#pragma unroll
        for (int r = 0; r < 16; ++r) { const float fr = wsf[crow(r, w.hi)]; s.o[0][r] *= fr; s.o[1][r] *= fr; }
#pragma unroll
        for (int r = 0; r < 16; ++r) { p0[r] = __builtin_amdgcn_exp2f(p0[r]); p1[r] = __builtin_amdgcn_exp2f(p1[r]); }
        MF.post(p0, p1);
        sa = 0.f; sb = 0.f;
#pragma unroll
        for (int r = 0; r < 16; ++r) { sa += p0[r]; sb += p1[r]; }
        tot = sa + sb;
    }
    s.l += tot;
    u32x4 pw[4];
#pragma unroll
    for (int k = 0; k < 4; ++k) { pw[0][k] = cvtpk(p0[2 * k], p0[2 * k + 1]); pw[1][k] = cvtpk(p0[8 + 2 * k], p0[9 + 2 * k]); pw[2][k] = cvtpk(p1[2 * k], p1[2 * k + 1]); pw[3][k] = cvtpk(p1[8 + 2 * k], p1[9 + 2 * k]); }
    const LAS unsigned char* vp = w.shm + L_V + slot * SLOTB + ((w.lane >> 4) & 1) * 32 + (w.lane & 3) * 8 + (4 * w.hi + ((w.lane & 15) >> 2)) * 64;
    pv(s.o, vp, pw);
}
template <class TS, class MaskF> __device__ __forceinline__ void run_branch(const W& w_in, const bf16* Kb, const bf16* Vb, int pitch, TS ts, bf16x8 (&qr)[4], MaskF& MF, St& s) {
    const W& w = w_in;
    const int n = ts.n;
    asm volatile("s_waitcnt vmcnt(0)" : "+v"(qr[0]), "+v"(qr[1]), "+v"(qr[2]), "+v"(qr[3]) :: "memory");
    int t0 = 0, t1 = 0, t2 = 0;
    if (n > 0) { t0 = ts.next(); MF.issue(t0); dma_tile(w, Kb, Vb, pitch, t0, 0); }
    if (n > 1) { t1 = ts.next(); dma_tile(w, Kb, Vb, pitch, t1, 1); MF.template settle<4>(); } else { MF.template settle<2>(); }
    int slot = 0;
#pragma nounroll
    for (int k = 0; k < n; ++k) {
        if (k + 1 < n) { FA_WAIT_BAR(2); } else { FA_WAIT_BAR(0); }
        MF.advance(t0);
        if (k + 1 < n) MF.issue(t1);
        if (k + 2 < n) { t2 = ts.next(); int s2 = slot + 2; s2 = s2 >= NSLOT ? s2 - NSLOT : s2; dma_tile(w, Kb, Vb, pitch, t2, s2); }
        if (MF.active(t0)) tile_step(w, slot, qr, MF, s);
        if (k + 2 < n) { MF.template settle<2>(); } else { MF.template settle<0>(); }
        slot = (slot == NSLOT - 1) ? 0 : slot + 1; t0 = t1; t1 = t2;
    }
    asm volatile("s_waitcnt lgkmcnt(0)\n\ts_barrier" ::: "memory");
}
__device__ __forceinline__ void finish_branch(const W& w, St& s, float gate, f32x16 (&oacc)[2]) {
    float l = s.l; { const auto rr = __builtin_amdgcn_permlane32_swap(__float_as_uint(l), __float_as_uint(l), false, false); l = __uint_as_float(rr[0]) + __uint_as_float(rr[1]); }
    LAS float* wsf = (LAS float*)(w.shm + L_WS) + w.wid * 64;
    if (w.hi == 0) wsf[32 + w.r32] = (l > 0.f) ? gate / l : 0.f;
    asm volatile("s_waitcnt lgkmcnt(0)" ::: "memory");
#pragma unroll
    for (int r = 0; r < 16; ++r) { const float sc = wsf[32 + crow(r, w.hi)]; oacc[0][r] += s.o[0][r] * sc; oacc[1][r] += s.o[1][r] * sc; }
    asm volatile("s_waitcnt lgkmcnt(0)" ::: "memory");
}
__device__ __forceinline__ void store_o(const W& w_in, const f32x16 (&oacc)[2], bf16* Ow, int opitch) {
    const W& w = w_in;
    LAS bf16* stg = (LAS bf16*)(w.shm + L_OST) + w.wid * 2048;
#pragma unroll
    for (int r = 0; r < 16; ++r) { const int orow = crow(r, w.hi);
#pragma unroll
        for (int d0 = 0; d0 < 2; ++d0) stg[orow * 64 + d0 * 32 + w.r32] = (bf16)(cvtpk(oacc[d0][r], 0.f) & 0xffffu); }
    asm volatile("s_waitcnt lgkmcnt(0)" ::: "memory");
#pragma unroll
    for (int i = 0; i < 4; ++i) { const int row = i * 8 + (w.lane >> 3), ch = w.lane & 7; const u32x4 v = *(const LAS u32x4*)(stg + row * 64 + ch * 8); *(u32x4*)(Ow + (size_t)row * opitch + ch * 8) = v; }
    asm volatile("s_waitcnt lgkmcnt(0)" ::: "memory");
}
struct SeqRange { int n, t; __device__ __forceinline__ int next() { return t++; } };
struct SeqBits { int n; unsigned rem; __device__ __forceinline__ int next() { const int t = __builtin_ctz(rem); rem &= rem - 1u; return t; } };
}

constexpr int L_MK = fa::L_END, L_MK_SLOT = 2048, DSA_LDS_END = L_MK + fa::NSLOT * L_MK_SLOT;
struct DsaMask {
    const LAS unsigned char* mlds;
    int hi, last_tile; unsigned w0, w1;
    __device__ __forceinline__ bool active(int t) const { return t <= last_tile; }
    __device__ __forceinline__ void advance_slot(int slot) { w0 = *(const LAS unsigned*)(mlds + slot * L_MK_SLOT) >> (16 * hi); w1 = *(const LAS unsigned*)(mlds + slot * L_MK_SLOT + 1024) >> (16 * hi); }
    __device__ __forceinline__ void pre(fa::f32x16&, fa::f32x16&) const {}
    __device__ __forceinline__ void pre_slow(fa::f32x16& p0, fa::f32x16& p1) const {
#pragma unroll
        for (int r = 0; r < 16; ++r) {
            if (!((w0 >> r) & 1u)) p0[r] = -INFINITY;
            if (!((w1 >> r) & 1u)) p1[r] = -INFINITY; }
    }
    __device__ __forceinline__ void post(fa::f32x16& p0, fa::f32x16& p1) const {
#pragma unroll
        for (int r = 0; r < 16; ++r) {
            unsigned m0, m1;
            asm("v_bfe_i32 %0, %1, %2, 1" : "=v"(m0) : "v"(w0), "n"(r));
            asm("v_bfe_i32 %0, %1, %2, 1" : "=v"(m1) : "v"(w1), "n"(r));
            p0[r] = __uint_as_float(__float_as_uint(p0[r]) & m0);
            p1[r] = __uint_as_float(__float_as_uint(p1[r]) & m1); }
    }
};
__device__ __forceinline__ void dsa_dma_tile(const fa::W& w, const bf16* Kb, const bf16* Vb, const unsigned* mk, int tile, int slot) {
    fa::dma_tile(w, Kb, Vb, PW, tile, slot);
    if (w.wid < 2) fa::glds16(mk + (size_t)(2 * tile + w.wid) * SEQ + 4 * w.lane, (unsigned)__builtin_amdgcn_readfirstlane((unsigned)(uintptr_t)(w.shm) + L_MK + slot * L_MK_SLOT + w.wid * 1024));
}
#define DSA_WAIT_BAR(wid_, N2, N3) do { if ((wid_) < 2) { FA_WAIT_BAR(N3); } else { FA_WAIT_BAR(N2); } } while (0)
__device__ __forceinline__ void run_branch_dsa(const fa::W& w, const bf16* Kb, const bf16* Vb, const unsigned* mk, int n, fa::bf16x8 (&qr)[4], DsaMask& MF, fa::St& s) {
    asm volatile("s_waitcnt vmcnt(0)" : "+v"(qr[0]), "+v"(qr[1]), "+v"(qr[2]), "+v"(qr[3]) :: "memory");
    dsa_dma_tile(w, Kb, Vb, mk, 0, 0);
    if (n > 1) dsa_dma_tile(w, Kb, Vb, mk, 1, 1);
    int slot = 0;
#pragma nounroll
    for (int k = 0; k < n; ++k) {
        if (k + 1 < n) { DSA_WAIT_BAR(w.wid, 2, 3); } else { FA_WAIT_BAR(0); }
        MF.advance_slot(slot);
        if (k + 2 < n) { int s2 = slot + 2; s2 = s2 >= fa::NSLOT ? s2 - fa::NSLOT : s2; dsa_dma_tile(w, Kb, Vb, mk, k + 2, s2); }
        if (MF.active(k)) fa::tile_step(w, slot, qr, MF, s);
        slot = (slot == fa::NSLOT - 1) ? 0 : slot + 1;
    }
    asm volatile("s_waitcnt lgkmcnt(0)\n\ts_barrier" ::: "memory");
}
__device__ __forceinline__ void dsa_mfma(Ctx& C0) {
    Ctx C = C0; C.tid = fresh_tid(C0); C.lane = C.tid & 63; __syncthreads();
    fa::W w; w.lane = C.lane; w.r32 = C.lane & 31; w.hi = C.lane >> 5; w.wid = C.wave; w.shm = C.lds + POOL_OFF;
    const bf16* P = (const bf16*)(AWS + WS_P); bf16* O = (bf16*)AOUT;        const unsigned* DMK = (const unsigned*)(AWS + WS_DMASK);
    const int G = C.G, bx = blockIdx.x, vcu = (G % 8 == 0) ? (bx % 8) * (G / 8) + bx / 8 : bx;
    for (int sl = vcu; sl < 256; sl += G) {
        const int bh = sl >> 1, sub = sl & 1, b = bh >> 3, h = bh & 7;
        for (int i = 0; i < 4; ++i) {
            const int qb = sub == 0 ? (i == 0 ? 7 : i == 1 ? 0 : i == 2 ? 4 : 3) : (i == 0 ? 6 : i == 1 ? 1 : i == 2 ? 5 : 2);
            { int tidu = fresh_tid(C0); w.lane = tidu & 63; w.r32 = w.lane & 31; w.hi = w.lane >> 5; w.wid = __builtin_amdgcn_readfirstlane(tidu >> 6); }
            const int q0 = qb * 256, tq = q0 + 32 * w.wid + w.r32;
            const bf16* Pb = P + (size_t)b * SEQ * PW;
            const bf16* Qrow = Pb + (size_t)tq * PW + C_DQ + h * 64;
            fa::bf16x8 qr[4];
#pragma unroll
            for (int d0 = 0; d0 < 4; ++d0) qr[d0] = *(const fa::bf16x8*)(Qrow + d0 * 16 + w.hi * 8);
            DsaMask MF; MF.mlds = w.shm + L_MK + (32 * w.wid + w.r32) * 4; MF.hi = w.hi; MF.last_tile = (q0 + 32 * w.wid + 31) >> 6; MF.w0 = MF.w1 = 0u;
            fa::St st; fa::st_init(st);
            run_branch_dsa(w, Pb + C_DK + h * 64, Pb + C_DV + h * 64, DMK + (size_t)b * 64 * SEQ + q0, (q0 + 256) / 64, qr, MF, st);
            fa::f32x16 oacc[2]; oacc[0] = fa::f32x16{}; oacc[1] = fa::f32x16{};
            fa::finish_branch(w, st, 1.0f, oacc);
            fa::store_o(w, oacc, O + (size_t)(b * SEQ + q0 + 32 * w.wid) * 1024 + 512 + h * 64, 1024);
        }
    }
}
struct NsaSlcMask {
    unsigned rowsel, wmask; int diag, tq, hi; unsigned cursel;
    __device__ __forceinline__ bool active(int t) const { return (wmask >> t) & 1u; }
    __device__ __forceinline__ void issue(int) {}
    template <int N> __device__ __forceinline__ void settle() {}
    int curt;
    __device__ __forceinline__ void advance(int t) { curt = t; cursel = ((rowsel >> t) & 1u) ? 0xffffffffu : 0u; }
    __device__ __forceinline__ void pre(fa::f32x16& p0, fa::f32x16& p1) const {
        if (curt == diag) {
            const int lim = tq - 64 * diag - 4 * hi;
#pragma unroll
            for (int r = 0; r < 16; ++r) { const int ko = (r & 3) + 8 * (r >> 2); if (ko > lim) p0[r] = -INFINITY; if (ko + 32 > lim) p1[r] = -INFINITY; }
        }
    }
    __device__ __forceinline__ void pre_slow(fa::f32x16& p0, fa::f32x16& p1) const {
        if (!cursel) {
#pragma unroll
            for (int r = 0; r < 16; ++r) { p0[r] = -INFINITY; p1[r] = -INFINITY; } }
    }
    __device__ __forceinline__ void post(fa::f32x16& p0, fa::f32x16& p1) const {
#pragma unroll
        for (int r = 0; r < 16; ++r) { p0[r] = __uint_as_float(__float_as_uint(p0[r]) & cursel); p1[r] = __uint_as_float(__float_as_uint(p1[r]) & cursel); }
    }
};
struct NsaWinMask {
    int tq, hi, tq0, curt;
    __device__ __forceinline__ bool active(int t) const { return 64 * t + 63 >= tq0 - 511 && 64 * t <= tq0 + 31; }
    __device__ __forceinline__ void issue(int) {}
    template <int N> __device__ __forceinline__ void settle() {}
    __device__ __forceinline__ void advance(int t) { curt = t; }
    __device__ __forceinline__ void pre(fa::f32x16& p0, fa::f32x16& p1) const {
        const int k0 = 64 * curt;
        if (k0 < tq0 - 480 || k0 + 63 > tq0) {
            const int hiL = tq - k0 - 4 * hi, loL = hiL - 511;
#pragma unroll
            for (int r = 0; r < 16; ++r) { const int ko = (r & 3) + 8 * (r >> 2); if (ko > hiL || ko < loL) p0[r] = -INFINITY; if (ko + 32 > hiL || ko + 32 < loL) p1[r] = -INFINITY; }
        }
    }
    __device__ __forceinline__ void pre_slow(fa::f32x16&, fa::f32x16&) const {}
    __device__ __forceinline__ void post(fa::f32x16&, fa::f32x16&) const {}
};
template <int MODE> __device__ __forceinline__ void nsa_mfma(Ctx& C0) {
    Ctx C = C0; C.tid = fresh_tid(C0); C.lane = C.tid & 63; __syncthreads();
    using namespace fa;
    W w; w.lane = C.lane; w.r32 = C.lane & 31; w.hi = C.lane >> 5; w.wid = C.wave; w.shm = C.lds + POOL_OFF;
    LAS float* impbuf = (LAS float*)(w.shm + L_END);
    LAS float* impsum = impbuf + 4 * 2 * 32 * 33;
    LAS unsigned* selm = (LAS unsigned*)(impsum + 64 * 33);
    const bf16* P = (const bf16*)(AWS + WS_P); bf16* O = (bf16*)AOUT;
    const bf16* KCB = (const bf16*)(AWS + WS_KCB);
    const int G = C.G, bx = blockIdx.x, vcu = (G % 8 == 0) ? (bx % 8) * (G / 8) + bx / 8 : bx;
    for (int sl = vcu; sl < 256; sl += G) {
        const int bg = sl >> 3, b = bg >> 1, g = bg & 1, s8 = sl & 7;
        for (int ui = 0; ui < 4; ++ui) {
            const int cur = (ui == 0) ? 31 - s8 : (ui == 1) ? s8 : (ui == 2) ? 16 + s8 : 15 - s8;
            int tidu = fresh_tid(C0);
            C.tid = tidu; C.lane = tidu & 63; C.wave = __builtin_amdgcn_readfirstlane(tidu >> 6);
            w.lane = C.lane; w.r32 = C.lane & 31; w.hi = C.lane >> 5; w.wid = C.wave;
            const int r = w.wid & 3, th = w.wid >> 2;
            const int q0 = 64 * cur, tq0 = q0 + 32 * th, tq = tq0 + w.r32, head = 4 * g + r;
            const bf16* Pb = P + (size_t)b * SEQ * PW; const bf16* Prow = Pb + (size_t)tq * PW;
            bf16x8 qr[4];
#pragma unroll
            for (int d0 = 0; d0 < 4; ++d0) qr[d0] = *(const bf16x8*)(Prow + C_NQ + head * 64 + d0 * 16 + w.hi * 8);
            const float g_c = bf2f(Prow[C_NG + 0 * 8 + head]), g_s = bf2f(Prow[C_NG + 1 * 8 + head]), g_w = bf2f(Prow[C_NG + 2 * 8 + head]);
            if (C.tid < 3) selm[64 + C.tid] = 0u;
            f32x16 oacc[2];
            {
                const bf16* kc = KCB + (size_t)((0 * NB + b) * 2 + g) * 128 * 64; const bf16* vc = KCB + (size_t)((1 * NB + b) * 2 + g) * 128 * 64;
                const bool two = (q0 >= 1024);
                asm volatile("s_waitcnt vmcnt(0)" : "+v"(qr[0]), "+v"(qr[1]), "+v"(qr[2]), "+v"(qr[3]) :: "memory");
                dma_tile(w, kc, vc, 64, 0, 0); if (two) dma_tile(w, kc, vc, 64, 1, 1);
                FA_WAIT_BAR(0);
                f32x16 p[4];
                qkt(p[0], p[1], w.shm + L_K, qr, w.r32, w.hi);
                if (two) qkt(p[2], p[3], w.shm + L_K + SLOTB, qr, w.r32, w.hi);
                else {
#pragma unroll
                    for (int i = 0; i < 16; ++i) { p[2][i] = -INFINITY; p[3][i] = -INFINITY; } }
                const int lim = (tq >= 31 ? ((tq - 31) >> 4) : -1) - 4 * w.hi;
                float m = -INFINITY;
#pragma unroll
                for (int T = 0; T < 4; ++T)
#pragma unroll
                    for (int i = 0; i < 16; ++i) { const int c = 32 * T + (i & 3) + 8 * (i >> 2); if (c > lim) p[T][i] = -INFINITY; m = __builtin_fmaxf(m, p[T][i]); }
                { const auto rr = __builtin_amdgcn_permlane32_swap(__float_as_uint(m), __float_as_uint(m), false, false); m = __builtin_fmaxf(__uint_as_float(rr[0]), __uint_as_float(rr[1])); }
                const float msub = (m == -INFINITY) ? 0.f : m; float l = 0.f;
#pragma unroll
                for (int T = 0; T < 4; ++T)
#pragma unroll
                    for (int i = 0; i < 16; ++i) { p[T][i] = __builtin_amdgcn_exp2f(p[T][i] - msub); l += p[T][i]; }
                { const auto rr = __builtin_amdgcn_permlane32_swap(__float_as_uint(l), __float_as_uint(l), false, false); l = __uint_as_float(rr[0]) + __uint_as_float(rr[1]); }
                const float inv = (l > 0.f) ? 1.0f / l : 0.f;
#pragma unroll
                for (int T = 0; T < 4; ++T)
#pragma unroll
                    for (int i = 0; i < 16; ++i) p[T][i] *= inv;
                if (cur >= 16) {
                    LAS float* ib = impbuf + ((r * 2 + th) * 32 + w.r32) * 33;
                    float prv = 0.f;
#pragma unroll
                    for (int T = 0; T < 4; ++T)
#pragma unroll
                        for (int a = 0; a < 4; ++a) {
                            const float car = 0.5f * p[T][4 * a + 3], part = (p[T][4 * a] + p[T][4 * a + 1]) + (p[T][4 * a + 2] + car);
                            const auto rr = __builtin_amdgcn_permlane32_swap(__float_as_uint(car), __float_as_uint(car), false, false);
                            const float oth = (w.hi == 0) ? __uint_as_float(rr[1]) : __uint_as_float(rr[0]);
                            ib[8 * T + 2 * a + w.hi] = part + (w.hi ? oth : prv); prv = oth; }
                }
                {
                    u32x4 pwA[4], pwB[4];
#pragma unroll
                    for (int k = 0; k < 4; ++k) { pwA[0][k] = cvtpk(p[0][2 * k], p[0][2 * k + 1]); pwA[1][k] = cvtpk(p[0][8 + 2 * k], p[0][9 + 2 * k]); pwA[2][k] = cvtpk(p[1][2 * k], p[1][2 * k + 1]); pwA[3][k] = cvtpk(p[1][8 + 2 * k], p[1][9 + 2 * k]);
                        pwB[0][k] = cvtpk(p[2][2 * k], p[2][2 * k + 1]); pwB[1][k] = cvtpk(p[2][8 + 2 * k], p[2][9 + 2 * k]); pwB[2][k] = cvtpk(p[3][2 * k], p[3][2 * k + 1]); pwB[3][k] = cvtpk(p[3][8 + 2 * k], p[3][9 + 2 * k]); }
                    asm volatile("" : "+v"(pwA[0]), "+v"(pwA[1]), "+v"(pwA[2]), "+v"(pwA[3]), "+v"(pwB[0]), "+v"(pwB[1]), "+v"(pwB[2]), "+v"(pwB[3]));
                    f32x16 oc[2]; oc[0] = f32x16{}; oc[1] = f32x16{};
                    const LAS unsigned char* vp = w.shm + L_V + ((w.lane >> 4) & 1) * 32 + (w.lane & 3) * 8 + (4 * w.hi + ((w.lane & 15) >> 2)) * 64;
                    pv(oc, vp, pwA);
                    if (two) pv(oc, vp + SLOTB, pwB);
                    LAS float* wsf = (LAS float*)(w.shm + L_WS) + w.wid * 64;
                    if (w.hi == 0) wsf[32 + w.r32] = g_c;
                    asm volatile("s_waitcnt lgkmcnt(0)" ::: "memory");
#pragma unroll
                    for (int i = 0; i < 16; ++i) { const float scl = wsf[32 + crow(i, w.hi)]; oacc[0][i] = oc[0][i] * scl; oacc[1][i] = oc[1][i] * scl; }
                }
                asm volatile("s_waitcnt lgkmcnt(0)\n\ts_barrier" ::: "memory");
            }
            unsigned rowsel, umask, wmask;
#ifndef NSA_NO_RANK
            if (cur >= 16) {
                for (int e = C.tid; e < 64 * 32; e += NTHR) { const int tk = e >> 5, j = e & 31; float a = 0.f;
#pragma unroll
                    for (int rr2 = 0; rr2 < 4; ++rr2) a += impbuf[((rr2 * 2 + (tk >> 5)) * 32 + (tk & 31)) * 33 + j];
                    impsum[tk * 33 + j] = a; }
                asm volatile("s_waitcnt lgkmcnt(0)\n\ts_barrier" ::: "memory");
                const int tk = C.tid >> 3, jg = C.tid & 7; float sv[32];
#pragma unroll
                for (int j = 0; j < 32; ++j) { const float im = impsum[tk * 33 + j]; sv[j] = (j > cur) ? -INFINITY : ((j == 0 || j == cur || j == cur - 1) ? 1e4f : im); }
                unsigned bits = 0u;
#pragma unroll
                for (int q = 0; q < 4; ++q) { const int j = 4 * jg + q; float mine = sv[0];
#pragma unroll
                    for (int i = 1; i < 32; ++i) mine = (i == j) ? sv[i] : mine;
                    int rank = 0;
#pragma unroll
                    for (int i = 0; i < 32; ++i) rank += (sv[i] > mine || (sv[i] == mine && i < j)) ? 1 : 0;
                    if (rank < 16 && j <= cur) bits |= 1u << j; }
                bits |= __shfl_xor(bits, 1); bits |= __shfl_xor(bits, 2); bits |= __shfl_xor(bits, 4);
                if (jg == 0) { selm[tk] = bits; __hip_atomic_fetch_or(&selm[64], bits, __ATOMIC_RELAXED, __HIP_MEMORY_SCOPE_WORKGROUP); __hip_atomic_fetch_or(&selm[65 + (tk >> 5)], bits, __ATOMIC_RELAXED, __HIP_MEMORY_SCOPE_WORKGROUP); }
                asm volatile("s_waitcnt lgkmcnt(0)\n\ts_barrier" ::: "memory");
                rowsel = selm[32 * th + w.r32]; umask = selm[64]; wmask = selm[65 + th];
            } else
#endif
            { rowsel = umask = wmask = (cur == 31) ? 0xffffffffu : ((1u << (cur + 1)) - 1u); }
            umask = (unsigned)__builtin_amdgcn_readfirstlane((int)umask); wmask = (unsigned)__builtin_amdgcn_readfirstlane((int)wmask);
#ifndef NSA_NO_SLC
            if (MODE == 0 || MODE >= 2) {
                NsaSlcMask MF; MF.rowsel = rowsel; MF.wmask = wmask; MF.diag = cur; MF.tq = tq; MF.hi = w.hi; MF.cursel = 0u; MF.curt = 0;
                St st; st_init(st);
                SeqBits ts{__builtin_popcount(umask), umask};
                run_branch(w, Pb + C_KSLC + g * 64, Pb + C_VSLC + g * 64, PW, ts, qr, MF, st);
                finish_branch(w, st, g_s, oacc);
            }
#endif
#ifndef NSA_NO_WIN
            if (MODE == 0 || MODE >= 3) {
                NsaWinMask MF; MF.tq = tq; MF.hi = w.hi; MF.tq0 = tq0; MF.curt = 0;
                St st; st_init(st);
                const int tlo = cur >= 8 ? cur - 8 : 0;
                SeqRange ts{cur - tlo + 1, tlo};
                run_branch(w, Pb + C_KWIN + g * 64, Pb + C_VWIN + g * 64, PW, ts, qr, MF, st);
                finish_branch(w, st, g_w, oacc);
            }
#endif
            if (MODE == 0) store_o(w, oacc, O + (size_t)(b * SEQ + tq0) * 1024 + head * 64, 1024); else asm volatile("" :: "v"(oacc[0]), "v"(oacc[1]));
            asm volatile("s_waitcnt lgkmcnt(0)\n\ts_barrier" ::: "memory");
        }
    }
}
__device__ __forceinline__ unsigned fkey32(float f) { const unsigned u = __float_as_uint(f + 0.0f); return (f == -INFINITY) ? 0u : ((u & 0x80000000u) ? ~u : (u | 0x80000000u)); }
__device__ __forceinline__ int wave_sum_i32(int v) {
    v += __builtin_amdgcn_update_dpp(0, v, 0xB1, 0xF, 0xF, true);
    v += __builtin_amdgcn_update_dpp(0, v, 0x4E, 0xF, 0xF, true);
    v += __builtin_amdgcn_update_dpp(0, v, 0x141, 0xF, 0xF, true);
    v += __builtin_amdgcn_update_dpp(0, v, 0x140, 0xF, 0xF, true);
    return __builtin_amdgcn_readlane(v, 0) + __builtin_amdgcn_readlane(v, 16) + __builtin_amdgcn_readlane(v, 32) + __builtin_amdgcn_readlane(v, 48);
}
__device__ __forceinline__ float wave_max_dpp(float v) {
#define WMD_STEP(CTRL) v = __builtin_fmaxf(v, __int_as_float(__builtin_amdgcn_update_dpp(__float_as_int(v), __float_as_int(v), CTRL, 0xF, 0xF, false)))
    WMD_STEP(0xB1); WMD_STEP(0x4E); WMD_STEP(0x141); WMD_STEP(0x140);
#undef WMD_STEP
    const float a = __int_as_float(__builtin_amdgcn_readlane(__float_as_int(v), 0)), b = __int_as_float(__builtin_amdgcn_readlane(__float_as_int(v), 16));
    const float c = __int_as_float(__builtin_amdgcn_readlane(__float_as_int(v), 32)), d = __int_as_float(__builtin_amdgcn_readlane(__float_as_int(v), 48));
    return __builtin_fmaxf(__builtin_fmaxf(a, b), __builtin_fmaxf(c, d));
}
__device__ __forceinline__ unsigned wave_excl_prefix(unsigned v, int lane) {
    unsigned x = v;
#pragma unroll
    for (int o = 1; o < 64; o <<= 1) { const unsigned y = __shfl_up(x, o); x += (lane >= o) ? y : 0u; }
    return x - v;
}
template <int MODE> __device__ __forceinline__ void idx_mfma(Ctx& C0) {
    Ctx C = C0; C.tid = fresh_tid(C0); C.lane = C.tid & 63; __syncthreads();
    typedef float f32x4_t __attribute__((ext_vector_type(4)));
    typedef short bf16x8 __attribute__((ext_vector_type(8)));
    constexpr int RS = 2113;
    LAS unsigned char* shm = C.lds + POOL_OFF;
    LAS unsigned char* qlds = shm;
    LAS float* scr = (LAS float*)shm;
    const bf16* P = (const bf16*)(AWS + WS_P); unsigned* DMK = (unsigned*)(AWS + WS_DMASK);
    const int G = C.G, bx = blockIdx.x, vcu = (G % 8 == 0) ? (bx % 8) * (G / 8) + bx / 8 : bx;
    for (int sl = vcu; sl < 256; sl += G) {
        const int b = sl >> 4, s16 = sl & 15;
#pragma nounroll
        for (int ui = 0; ui < 8; ++ui) {
            int tidu = fresh_tid(C0);
            const int tid = tidu, lane = tid & 63, tok = lane & 15, g = lane >> 4, wid = __builtin_amdgcn_readfirstlane(tid >> 6);
            const int q16 = ((ui & 1) ? (ui >> 1) * 32 + 31 - s16 : (ui >> 1) * 32 + s16);
            const int t = 16 * q16 + tok, nkt = (q16 >> 1) + 1;
            const bf16* Pb = P + (size_t)b * SEQ * PW;
#pragma unroll
            for (int k = 0; k < 2; ++k) { const int id = tid + 512 * k, tk = id >> 6, pc = id & 63;
                const v4u v = *(const v4u*)(Pb + (size_t)(16 * q16 + tk) * PW + C_IQ + pc * 8);
                *(LAS v4u*)(qlds + (pc * 16 + tk) * 16) = v; }
            const v4u wvp = *(const v4u*)(Pb + (size_t)t * PW + C_IW);
            asm volatile("s_waitcnt vmcnt(0) lgkmcnt(0)\n\ts_barrier" ::: "memory");
            float sv[8][8];
            bf16x8 qf[8][2];
#pragma unroll
            for (int h = 0; h < 8; ++h) { qf[h][0] = *(const LAS bf16x8*)(qlds + (g * 16 + tok) * 16 + (h * 8) * 256); qf[h][1] = *(const LAS bf16x8*)(qlds + (g * 16 + tok) * 16 + (h * 8 + 4) * 256); }
            bf16x8 ka0, ka1, kn0, kn1;
#define IDX_LOADK(d0, d1, kt_, s_) do { const bf16* krow_ = Pb + (size_t)(32 * (kt_) + 16 * (s_) + tok) * PW + C_IK + 8 * g; d0 = *(const bf16x8*)(krow_); d1 = *(const bf16x8*)(krow_ + 32); } while (0)
            if (wid < nkt) IDX_LOADK(ka0, ka1, wid, 0);
#pragma unroll
            for (int st = 0; st < 16; ++st) {
                const int j = st >> 1, s = st & 1, kt = wid + 8 * j;
                if (st + 1 < 16) { const int kt2 = wid + 8 * ((st + 1) >> 1); if (kt2 < nkt) IDX_LOADK(kn0, kn1, kt2, (st + 1) & 1); }
                if (kt < nkt) {
                    f32x4_t sc = {0.f, 0.f, 0.f, 0.f};
#pragma unroll
                    for (int h = 0; h < 8; ++h) {
                        f32x4_t acc = {0.f, 0.f, 0.f, 0.f};
                        acc = __builtin_amdgcn_mfma_f32_16x16x32_bf16(ka0, qf[h][0], acc, 0, 0, 0);
                        acc = __builtin_amdgcn_mfma_f32_16x16x32_bf16(ka1, qf[h][1], acc, 0, 0, 0);
                        const unsigned wpk = (h < 2) ? wvp.x : (h < 4) ? wvp.y : (h < 6) ? wvp.z : wvp.w; const float wh = (h & 1) ? pg8::bf_hi(wpk) : pg8::bf_lo(wpk);
#pragma unroll
                        for (int r = 0; r < 4; ++r) sc[r] = __builtin_fmaf(wh, __builtin_fmaxf(acc[r], 0.f), sc[r]);
                    }
                    const int kpos = 32 * kt + 16 * s + 4 * g;
#pragma unroll
                    for (int r = 0; r < 4; ++r) sv[j][4 * s + r] = (kpos + r <= t) ? sc[r] + 0.0f : -INFINITY;
                } else {
#pragma unroll
                    for (int r = 0; r < 4; ++r) sv[j][4 * s + r] = -INFINITY;
                }
                ka0 = kn0; ka1 = kn1;
            }
#undef IDX_LOADK
            if (q16 < 16) {
#pragma unroll
                for (int j = 0; j < 8; ++j) { const int kt = wid + 8 * j; unsigned bits = 0u;
#pragma unroll
                    for (int i = 0; i < 8; ++i) bits |= (sv[j][i] != -INFINITY) ? (1u << ((i & 3) + 8 * (i >> 2) + 4 * (g >> 1) + 16 * (g & 1))) : 0u;
                    bits |= __shfl_xor(bits, 16); bits |= __shfl_xor(bits, 32);
                    if (MODE == 0) { if (g == 0) DMK[(size_t)(b * 64 + kt) * SEQ + t] = bits; } else { asm volatile("" :: "v"(bits)); } }
                asm volatile("s_waitcnt lgkmcnt(0)\n\ts_barrier" ::: "memory");
                continue;
            }
            if (MODE == 1) { asm volatile("" :: "v"(sv[0][0]), "v"(sv[7][7])); asm volatile("s_waitcnt lgkmcnt(0)\n\ts_barrier" ::: "memory"); continue; }
            asm volatile("s_waitcnt lgkmcnt(0)\n\ts_barrier" ::: "memory");
#pragma unroll
            for (int j = 0; j < 8; ++j)
#pragma unroll
                for (int i = 0; i < 8; ++i) scr[tok * RS + 33 * (wid + 8 * j) + 16 * (i >> 2) + 4 * g + (i & 3)] = sv[j][i];
            asm volatile("s_waitcnt lgkmcnt(0)\n\ts_barrier" ::: "memory");
#pragma nounroll
            for (int tt = 0; tt < 2; ++tt) {
                const int tau = wid + 8 * tt, tq = 16 * q16 + tau;
                float v[32];
#pragma unroll
                for (int u = 0; u < 32; ++u) v[u] = scr[tau * RS + 33 * lane + u];
#define IDX_CNT(PRED, OUT) do { int c_ = 0; _Pragma("unroll") for (int u = 0; u < 32; ++u) { const float fx = v[u]; c_ += (PRED) ? 1 : 0; } OUT = wave_sum_i32(c_); } while (0)
                float mx = -INFINITY, mn = INFINITY;
#pragma unroll
                for (int u = 0; u < 32; ++u) { mx = __builtin_fmaxf(mx, v[u]); mn = (v[u] == -INFINITY) ? mn : __builtin_fminf(mn, v[u]); }
                mx = wave_max_dpp(mx); mn = -wave_max_dpp(-mn);
#define IDX_CNTLT(PIV, OUT) do { const float pb_ = (PIV) * 1.2676506002282294e30f; float a0_ = 0.f, a1_ = 0.f; \
                    _Pragma("unroll") for (int u = 0; u < 32; u += 2) { a0_ += __builtin_amdgcn_fmed3f(__builtin_fmaf(v[u], -1.2676506002282294e30f, pb_), 0.f, 1.f); a1_ += __builtin_amdgcn_fmed3f(__builtin_fmaf(v[u + 1], -1.2676506002282294e30f, pb_), 0.f, 1.f); } \
                    OUT = wave_sum_i32((int)(a0_ + a1_)); } while (0)
                int cp, c0;
                {
                    float ap = 0.f, an = 0.f;
#pragma unroll
                    for (int u = 0; u < 32; ++u) { ap += __builtin_amdgcn_fmed3f(v[u] * 1.2676506002282294e30f, 0.f, 1.f); an += __builtin_amdgcn_fmed3f(v[u] * -1.2676506002282294e30f, 0.f, 1.f); }
                    cp = wave_sum_i32((int)ap); c0 = 2048 - wave_sum_i32((int)an);
                    if (cp == 256) { int ce; IDX_CNT(fx > 0.f, ce); cp = ce; }
                }
                float thr = 0.f, tv = 0.f; int need = 0; bool tie = false, done = false, strict = false;
                float lo, hi_, clo, chi, wprev = INFINITY;
                if (cp >= 256) { lo = 0.f; hi_ = mx; clo = (float)cp; chi = 1.f; if (cp == 256) { done = true; strict = true; thr = 0.f; } }
                else if (c0 < 256) { lo = mn; hi_ = 0.f; clo = (float)(tq + 1); chi = (float)c0; }
                else { lo = hi_ = clo = chi = 0.f; tie = true; tv = 0.f; need = 256 - cp; done = true; }
#pragma nounroll
                for (int rd = 0; rd < 64 && !done; ++rd) {
                    const float wdt = hi_ - lo, fi = __builtin_fminf(__builtin_fmaxf((clo - 256.5f) / (clo - chi), 0.02f), 0.98f);
                    const float frac = ((rd & 1) && wdt > 0.5f * wprev) ? 0.5f : fi;
                    if (!(rd & 1)) wprev = wdt;
                    const float mid = lo + wdt * frac;
                    if (!(mid > lo) || !(mid < hi_)) {
                        int cg; IDX_CNT(fx >= hi_, cg); tie = true; done = true; need = 256 - cg;
                        float below = -INFINITY;
#pragma unroll
                        for (int u = 0; u < 32; ++u) below = (v[u] < hi_) ? __builtin_fmaxf(below, v[u]) : below;
                        tv = wave_max_dpp(below);
                        break; }
                    int c; { int clt; IDX_CNTLT(mid, clt); c = 2048 - clt; }
                    if (c == 256) { int ce; IDX_CNT(fx >= mid, ce); c = ce; }
                    if (c == 256) { done = true; thr = mid; } else if (c > 256) { lo = mid; clo = (float)c; } else { hi_ = mid; chi = (float)c; }
                }
                bool redo = !done;
                if (tie && !redo) { int cgt, ceq; IDX_CNT(fx > tv, cgt); IDX_CNT(fx == tv, ceq); need = 256 - cgt; redo = (need < 1 || need > ceq); }
                if (__builtin_expect(redo, 0)) {
                    unsigned T = 0u;
#pragma nounroll
                    for (int bit = 31; bit >= 0; --bit) { const unsigned cand = T | (1u << bit); int c; IDX_CNT(fkey32(fx) >= cand, c); if (c >= 256) T = cand; }
                    tv = __uint_as_float((T & 0x80000000u) ? (T ^ 0x80000000u) : ~T); tie = true; strict = false;
                    int cgt; IDX_CNT(fx > tv, cgt); need = 256 - cgt;
                }
                unsigned word = 0u;
                if (!tie) {
#pragma unroll
                    for (int u = 0; u < 32; ++u) word |= ((strict ? v[u] > thr : v[u] >= thr)) ? (1u << ((u & 3) + 4 * (u >> 3) + 16 * ((u >> 2) & 1))) : 0u;
                } else {
                    unsigned nt = 0u;
#pragma unroll
                    for (int u = 0; u < 32; ++u) nt += (v[u] == tv) ? 1u : 0u;
                    unsigned rank = wave_excl_prefix(nt, lane);
#pragma unroll
                    for (int u = 0; u < 32; ++u) { const bool eq = (v[u] == tv); const bool sel = (v[u] > tv) || (eq && (int)rank < need); rank += eq ? 1u : 0u;
                        word |= sel ? (1u << ((u & 3) + 4 * (u >> 3) + 16 * ((u >> 2) & 1))) : 0u; }
                }
                DMK[(size_t)(b * 64 + lane) * SEQ + tq] = word;
#undef IDX_CNT
#undef IDX_CNTLT
            }
            asm volatile("s_waitcnt lgkmcnt(0)\n\ts_barrier" ::: "memory");
        }
    }
}
__device__ __forceinline__ void compress_mfma(Ctx& C0, int l) {
    Ctx C = C0; C.tid = fresh_tid(C0); C.lane = C.tid & 63; __syncthreads();
    typedef float f32x16 __attribute__((ext_vector_type(16)));
    typedef short bf16x8 __attribute__((ext_vector_type(8)));
    LAS float* hidp = (LAS float*)(C.lds + POOL_OFF);
    LAS float* hid = hidp + 2 * 32 * 132;
    const bf16* P = (const bf16*)(AWS + WS_P);
    const int lane = C.lane, r32 = lane & 31, hi = lane >> 5, wid = C.wave, nb = wid & 3, kh = wid >> 2;
    for (int u = blockIdx.x; u < 256; u += C.G) {
        const int kv = u >> 7, b = (u >> 3) & 15, g = (u >> 2) & 1, mb = u & 3, c0 = 32 * mb;
        const int crow_ = (c0 + r32 < 127) ? c0 + r32 : 126;
        const bf16* arow = P + (size_t)(b * SEQ + 16 * crow_) * PW + (kv ? C_VCMP : C_KCMP) + g * 64 + 8 * hi;
        const bf16* brow = (const bf16*)(AWS + WS_W1B) + ((size_t)(l * 2 + kv) * 128 + 32 * nb + r32) * 2048 + 1024 * kh + 8 * hi;
        f32x16 acc = f32x16{};
#pragma unroll 8
        for (int kk = 0; kk < 64; ++kk) {
            const int k = 1024 * kh + 16 * kk;
            const bf16x8 a = *(const bf16x8*)(arow + (size_t)(k >> 6) * PW + (k & 63));
            const bf16x8 bq = *(const bf16x8*)(brow + 16 * kk);
            acc = __builtin_amdgcn_mfma_f32_32x32x16_bf16(a, bq, acc, 0, 0, 0);
        }
        __syncthreads();
#pragma unroll
        for (int i = 0; i < 16; ++i) hidp[(kh * 32 + (i & 3) + 8 * (i >> 2) + 4 * hi) * 132 + 32 * nb + r32] = acc[i];
        __syncthreads();
        LAS float* cb1 = hid + 32 * 132;
        if (C.tid < 128) { const float* cp = (const float*)(AWS + WS_CB1) + (size_t)(l * 2 + kv) * 64 * 128 + C.tid; float a = AIN(kv ? 10 : 5)[l * 128 + C.tid];
            for (int ks = 0; ks < 64; ++ks) a += cp[ks * 128];
            cb1[C.tid] = a; }
        __syncthreads();
        for (int e = C.tid; e < 32 * 128; e += NTHR) { const int c = e >> 7, n = e & 127; hid[c * 132 + n] = gelu_tanh(hidp[c * 132 + n] + hidp[(32 + c) * 132 + n] + cb1[n]); }
        __syncthreads();
        {
            const float* w2 = AIN(kv ? 11 : 6) + (size_t)l * 128 * 64; const float* b2 = AIN(kv ? 12 : 7) + l * 64;
            const int c = C.tid >> 4, d4 = (C.tid & 15) * 4;
            f32x4 a = *(const f32x4*)(b2 + d4);
            for (int n = 0; n < 128; ++n) a += hid[c * 132 + n] * *(const f32x4*)(w2 + n * 64 + d4);
            if (c0 + c >= 127) a = (f32x4){0.f, 0.f, 0.f, 0.f};
            const size_t o = ((size_t)((kv * NB + b) * 2 + g) * 128 + c0 + c) * 64 + d4;
            *(f32x4*)((float*)(AWS + WS_KC) + o) = a;
            *(unsigned long long*)((bf16*)(AWS + WS_KCB) + o) = (unsigned long long)pk2(a.x, a.y) | ((unsigned long long)pk2(a.z, a.w) << 32);
        }
    }
    __syncthreads();
}
#ifndef MK_N_LAUNCHES
#define MK_N_LAUNCHES 1
#endif
constexpr int NPH = 18;
constexpr int N_LAUNCHES = MK_N_LAUNCHES;
#define GRID_BAR() do { if (N_LAUNCHES == 1) { XcdBarrier bar_; bar_.bar = (unsigned*)((gu32*)(AWS + WS_CTL) + CW_BAR); bar_.x = xb_xcc_id(); bar_.st = (volatile LAS unsigned*)(C.lds + MISC_OFF) + 8; xcd_barrier(bar_); } } while (0)
#define lo (kargs()->ph_lo)
#define hi (kargs()->ph_hi)
#ifndef REP_PHASE
#define REP_PHASE -1
#endif
#ifndef PH_EN
#define PH_EN 0xFFFFFFFFu
#endif
#define IN(k) (((PH_EN >> ((k) > 8 ? ((k) - 8 > 8 ? 17 : (k) - 8) : (k))) & 1u) && lo <= (k) && (k) < hi)
#define BOTH(k) (IN(k) && IN((k) + 1))
#define RING (C.lds + POOL_OFF)
#define XG_ ((bf16*)(AWS + WS_R1))
#define OB_ ((bf16*)AOUT)
#define P_ ((bf16*)(AWS + WS_P))
#define H_ ((bf16*)(AWS + WS_P))
#define RSS_ ((float*)(AWS + WS_RSS))
#define RCOS_ ((const float*)(AWS + WS_ROPE))
#define RSIN_ ((const float*)(AWS + WS_ROPE) + 2048 * 8)

template <int l> __device__ __forceinline__ void layer_phases(Ctx& C) {
        const int pb = 1 + 8 * l;
        if (IN(pb)) {
            pg8::Gemm g{XG_, (const bf16*)(AWS + WS_WIN + l * SZ_WIN), MTOK, PW, DM, DM, DM, nullptr, nullptr}; pg8::StaticOrder S; S.init(MTOK, PW, C.G, (int)blockIdx.x);
            pg8::EpiProj E{P_, RSS_, RCOS_, RSIN_};
            pg8::gemm_phase<pg8::EpiProj, pg8::StaticOrder, true, true>(RING, g, S, E, C.wave);
            if (REP_PHASE == 1) pg8::gemm_phase<pg8::EpiProj, pg8::StaticOrder, true, true>(RING, g, S, E, C.wave);
            if (BOTH(pb)) GRID_BAR();
        }
        if (IN(pb + 1)) { compress_mfma(C, l); if (REP_PHASE == 2) compress_mfma(C, l); idx_mfma<0>(C); if (REP_PHASE == 3) idx_mfma<0>(C); if (REP_PHASE == 31) idx_mfma<1>(C); if (BOTH(pb + 1)) GRID_BAR(); }
        if (IN(pb + 2)) { nsa_mfma<0>(C); if (REP_PHASE == 4) nsa_mfma<0>(C); if (REP_PHASE == 41) nsa_mfma<1>(C); if (REP_PHASE == 42) nsa_mfma<2>(C); dsa_mfma(C); if (REP_PHASE == 5) dsa_mfma(C); if (BOTH(pb + 2)) GRID_BAR(); }
        if (IN(pb + 3)) {
            pg8::Gemm g{OB_, (const bf16*)(AWS + WS_WBN + l * SZ_WBR), MTOK, DM, 512, DM, 512, OB_ + 512, (const bf16*)(AWS + WS_WBD + l * SZ_WBR)}; pg8::DualOrder S; S.init(MTOK, DM, C.G, (int)blockIdx.x);
            pg8::EpiBranch2 E{P_, C_GN, C_GD, C_TMP, C_MRG};
            pg8::gemm_phase<pg8::EpiBranch2, pg8::DualOrder, true, true>(RING, g, S, E, C.wave);
            if (BOTH(pb + 3)) GRID_BAR();
        }
        if (IN(pb + 4)) { }
        if (IN(pb + 5)) {
            pg8::Gemm g{P_ + C_MRG, (const bf16*)(AWS + WS_WOUT + l * SZ_WOUT), MTOK, DM, DM, PW, DM, nullptr, nullptr}; pg8::StaticOrder S; S.init(MTOK, DM, C.G, (int)blockIdx.x);
            pg8::EpiResid E{XG_, RSS_};
            pg8::gemm_phase<pg8::EpiResid, pg8::StaticOrder, true, true>(RING, g, S, E, C.wave);
            if (BOTH(pb + 5)) GRID_BAR();
        }
        if (IN(pb + 6)) {
            pg8::Gemm g{XG_, (const bf16*)(AWS + WS_WGU + l * SZ_WGU), MTOK, PW, DM, DM, DM, nullptr, nullptr}; pg8::StaticOrder S; S.init(MTOK, PW, C.G, (int)blockIdx.x);
            pg8::EpiSwiglu E{H_, RSS_};
            pg8::gemm_phase<pg8::EpiSwiglu, pg8::StaticOrder, true, true>(RING, g, S, E, C.wave);
            if (REP_PHASE == 7) pg8::gemm_phase<pg8::EpiSwiglu, pg8::StaticOrder, true, true>(RING, g, S, E, C.wave);
            if (BOTH(pb + 6)) GRID_BAR();
        }
        if (IN(pb + 7)) {
            pg8::Gemm g{H_, (const bf16*)(AWS + WS_WDN + l * SZ_WDN), MTOK, DM, DFF, DFF, DFF, nullptr, nullptr}; pg8::StaticOrder S; S.init(MTOK, DM, C.G, (int)blockIdx.x);
            pg8::EpiResid E{XG_, RSS_};
            pg8::gemm_phase<pg8::EpiResid, pg8::StaticOrder, true, true>(RING, g, S, E, C.wave);
            if (BOTH(pb + 7)) GRID_BAR();
        }
}
__global__ void __launch_bounds__(NTHR, 2) hybrid_fwd(Args args) {
    extern __shared__ __attribute__((aligned(16))) unsigned char lds_raw[];
    Ctx C;
    C.lds = (LAS unsigned char*)lds_raw; C.tid = threadIdx.x; C.lane = 0; C.wave = __builtin_amdgcn_readfirstlane((int)threadIdx.x >> 6); C.G = gridDim.x;
    for (int u = C.tid; u < POOL_OFF / 4; u += NTHR) ((LAS unsigned*)(C.lds + LDSCTL_OFF))[u] = 0u;
    __syncthreads();
    if (N_LAUNCHES == 1) (void)xcd_barrier_post((unsigned*)((gu32*)(AWS + WS_CTL) + CW_BAR), (volatile LAS unsigned*)(C.lds + MISC_OFF) + 8);
    if (IN(0)) { p0_prologue(C); if (REP_PHASE == 0) p0_prologue(C); if (BOTH(0)) GRID_BAR(); }
    layer_phases<0>(C);
    layer_phases<1>(C);
    if (IN(17)) final_norm(C);
#ifdef IDX_DIAG
    if (IN(17)) { __syncthreads(); const unsigned nfb = __hip_atomic_load((unsigned*)(AWS + WS_CTL) + 2048, __ATOMIC_RELAXED, __HIP_MEMORY_SCOPE_AGENT); if (nfb > IDX_DIAG && blockIdx.x == 0) { AOUT[C.tid] = __builtin_nanf(""); } }
#endif
#undef IN
#undef BOTH
#undef lo
#undef hi
}

extern "C" void kernel_launch(void* const* d_in, const int* in_sizes, int n_in, void* d_out, int out_size, void* d_ws, size_t ws_size, hipStream_t stream) {
    static int grid = 0;
    if (grid == 0) {
        if (n_in != 21 || out_size != MTOK * DM || ws_size < WS_END) { fprintf(stderr, "kernel_launch: unexpected shapes (n_in %d out %d ws %zu)\n", n_in, out_size, ws_size); grid = -1; return; }
        int dev = 0, cus = 0, per_cu = 0;
        if (hipGetDevice(&dev) != hipSuccess || hipDeviceGetAttribute(&cus, hipDeviceAttributeMultiprocessorCount, dev) != hipSuccess) { grid = -1; return; }
        if (hipFuncSetAttribute((const void*)hybrid_fwd, hipFuncAttributeMaxDynamicSharedMemorySize, LDS_BYTES) != hipSuccess) { fprintf(stderr, "kernel_launch: hipFuncSetAttribute failed\n"); grid = -1; return; }
        if (hipOccupancyMaxActiveBlocksPerMultiprocessor(&per_cu, (const void*)hybrid_fwd, NTHR, LDS_BYTES) != hipSuccess || per_cu < 1) fprintf(stderr, "kernel_launch: occupancy query reports %d\n", per_cu);
        (void)hipGetLastError();
        grid = cus;
    }
    if (grid < 0) return;
    (void)hipMemsetAsync((char*)d_ws + WS_CTL, 0, CTL_ZERO_BYTES, stream);
    Args a{};
    for (int i = 0; i < 21; ++i) a.in[i] = (const float*)d_in[i];
    a.out = (float*)d_out; a.ws = (unsigned char*)d_ws;
    for (int li = 0; li < N_LAUNCHES; ++li) {
        a.ph_lo = (N_LAUNCHES == 1) ? 0 : li; a.ph_hi = (N_LAUNCHES == 1) ? NPH : li + 1; a.li = li;
        hipLaunchKernelGGL(hybrid_fwd, dim3(grid), dim3(NTHR), LDS_BYTES, stream, a);
    }
}
```

```cpp
#include <hip/hip_runtime.h>
#include <cstdio>
#include <cstdint>
namespace pg8 {
#define PG8_LAS __attribute__((address_space(3)))
typedef unsigned short bf16_t;
typedef short bf16x8 __attribute__((ext_vector_type(8)));
typedef float f32x4 __attribute__((ext_vector_type(4)));
typedef unsigned u32x4 __attribute__((ext_vector_type(4)));
constexpr int BM = 256, BK = 64, HALF = 128, HTB = HALF * BK * 2  , STAGE_BYTES = 8 * HTB, NXCD = 8, WGM = 8;

__host__ __device__ __forceinline__ int lds_byte(int r, int c) { const int st = (r >> 4) * 2 + (c >> 5), rr = r & 15, cc = c & 31, ob = rr * 64 + cc * 2; return st * 1024 + (ob ^ (((ob >> 9) & 1) << 5)); }
__host__ __device__ __forceinline__ void stage_rc(int b, int& R, int& C) { const int st = b / 1024, sb = b % 1024, swz = sb ^ (((sb >> 9) & 1) << 5); R = (st >> 1) * 16 + swz / 64; C = (st & 1) * 32 + (swz % 64) / 2; }
__host__ __device__ __forceinline__ int perm32(int rho) { const int n = rho >> 4, i = rho & 15; return 8 * (i >> 2) + 4 * n + (i & 3); }

struct Unit { int pm, pn, z; };
struct Gemm { const bf16_t* A; const bf16_t* Bt; int M, N, K, lda, ldb; const bf16_t* A2; const bf16_t* Bt2; };

struct StaticOrder {
    int nM, nN, nwg, G, c;
    __host__ __device__ void init(int M, int N, int G_, int c_) { nM = M / BM; nN = N / BM; nwg = nM * nN; G = G_; c = c_; }
    __host__ __device__ bool next(int i, Unit& u) const {
        const long L = (long)i * G + c; if (L >= nwg) return false;
        int wgid = (int)L; { const int q = nwg / NXCD, r = nwg % NXCD, xcd = wgid % NXCD, off = wgid / NXCD; wgid = (xcd < r ? xcd * (q + 1) : r * (q + 1) + (xcd - r) * q) + off; }
        const int nig = WGM * nN, gid = wgid / nig, fm = gid * WGM, gsz = (nM - fm) < WGM ? (nM - fm) : WGM;
        u.pm = fm + ((wgid % nig) % gsz); u.pn = (wgid % nig) / gsz; u.z = 0; return true;
    }
    __device__ __forceinline__ void a_ready(const Unit&) const {}
    __device__ __forceinline__ void done(const Unit&) const {}
};
struct DualOrder {
    StaticOrder S;
    __host__ __device__ void init(int M, int N, int G_, int c_) { S.init(M, N, G_, c_); }
    __host__ __device__ bool next(int i, Unit& u) const { if (!S.next(i >> 1, u)) return false; u.z = i & 1; return true; }
    __device__ __forceinline__ void a_ready(const Unit&) const {}
    __device__ __forceinline__ void done(const Unit&) const {}
};

__device__ __forceinline__ unsigned cvt_pk_bf16(float lo, float hi) { unsigned r; asm volatile("v_cvt_pk_bf16_f32 %0, %1, %2" : "=v"(r) : "v"(lo), "v"(hi)); return r; }
__device__ __forceinline__ float bf_lo(unsigned w) { return __uint_as_float(w << 16); }
__device__ __forceinline__ float bf_hi(unsigned w) { return __uint_as_float(w & 0xffff0000u); }
__device__ __forceinline__ float sigmoidf_(float x) { return __builtin_amdgcn_rcpf(1.0f + __builtin_amdgcn_exp2f(x * -1.4426950408889634f)); }
constexpr int PW = 5632;
constexpr float RMS_EPS = 1e-6f;
__device__ __forceinline__ float row_rstd(const float* rowss, int row) {
    const f32x4* p = (const f32x4*)(rowss + (size_t)row * 16);
    const f32x4 a = p[0], b = p[1], c = p[2], d = p[3];
    const float s = ((a[0] + a[1]) + (a[2] + a[3])) + ((b[0] + b[1]) + (b[2] + b[3])) + ((c[0] + c[1]) + (c[2] + c[3])) + ((d[0] + d[1]) + (d[2] + d[3]));
    float eps; asm volatile("s_mov_b32 %0, 0x358637bd" : "=s"(eps));
    return __builtin_amdgcn_rsqf(s * (1.0f / 1024.0f) + eps);
}
__device__ __forceinline__ int erow(int r) { return (r >> 2) * HALF + (r & 3) * 16; }
__device__ __forceinline__ float rstd_quarter(const f32x4 a) {
    float s = (a[0] + a[1]) + (a[2] + a[3]);
    s += __shfl_xor(s, 16); s += __shfl_xor(s, 32);
    float eps; asm volatile("s_mov_b32 %0, 0x358637bd" : "=s"(eps));
    return __builtin_amdgcn_rsqf(s * (1.0f / 1024.0f) + eps);
}
struct EpiProj {
    static constexpr bool PERM = true, AFTER_DRAIN = false;
    bf16_t* P; const float* rowss; const float* rtab;
    __device__ __forceinline__ void operator()(const f32x4 (&acc)[2][2][4][2], const Unit& u, int wr, int wc, int fr, int fq) const {
        const int pn = u.pn;
        const bool rope_head = (pn <= 1) || (pn >= 5 && pn <= 8) || (pn == 11) || (pn == 12) || ((pn >= 2 && pn <= 4) && wc < 2) || (pn == 13 && wc == 0);
        const int row0 = u.pm * BM + wr * 64 + fr;
        f32x4 q[8], tq[8];
        { const float* rq = rowss + (size_t)row0 * 16 + fq * 4;
#pragma unroll
          for (int r = 0; r < 8; ++r) q[r] = *(const f32x4*)(rq + erow(r) * 16); }
        if (rope_head) {
            const float* tb = rtab + (size_t)(row0 & 2047) * 16 + fq * 4;
#pragma unroll
            for (int r = 0; r < 8; ++r) tq[r] = *(const f32x4*)(tb + erow(r) * 16);
        }
        float rsv[8];
        { const float qs = (pn <= 1 || pn == 5 || pn == 6) ? 0.18033688011112042f : 1.0f;
#pragma unroll
          for (int r = 0; r < 8; ++r) rsv[r] = rstd_quarter(q[r]) * qs; }
#pragma unroll
        for (int ai = 0; ai < 2; ++ai)
#pragma unroll
            for (int m = 0; m < 4; ++m) {
                const int r = ai * 4 + m, row = row0 + erow(r);
                const float rs = rsv[r];
#pragma unroll
                for (int bj = 0; bj < 2; ++bj) {
                    f32x4 v0 = acc[ai][bj][m][0] * rs, v1 = acc[ai][bj][m][1] * rs;
                    if (rope_head && bj == 0) {
                        f32x4 c0, c1, s0, s1, p0, p1;
#pragma unroll
                        for (int e = 0; e < 4; ++e) { c0[e] = __shfl(tq[r][e], fr); c1[e] = __shfl(tq[r][e], fr + 16); s0[e] = __shfl(tq[r][e], fr + 32); s1[e] = __shfl(tq[r][e], fr + 48); }
#pragma unroll
                        for (int e = 0; e < 4; ++e) { p0[e] = __shfl_xor(v0[e], 16); p1[e] = __shfl_xor(v1[e], 16); }
                        if (fq == 0) { v0 = v0 * c0 - p0 * s0; v1 = v1 * c1 - p1 * s1; }
                        else if (fq == 1) { v0 = v0 * c0 + p0 * s0; v1 = v1 * c1 + p1 * s1; }
                    }
                    if (pn >= 14) {
#pragma unroll
                        for (int e = 0; e < 4; ++e) { v0[e] = sigmoidf_(v0[e]); v1[e] = sigmoidf_(v1[e]); }
                    } else if (pn == 13 && wc == 1 && bj == 0) {
                        if (fq == 0) { v0 = v0 * 0.044194173824159216f; v1 = v1 * 0.044194173824159216f; }
                        else {
#pragma unroll
                            for (int e = 0; e < 4; ++e) { v0[e] = sigmoidf_(v0[e]); v1[e] = sigmoidf_(v1[e]); }
                        }
                    }
                    u32x4 w; w.x = cvt_pk_bf16(v0[0], v0[1]); w.y = cvt_pk_bf16(v0[2], v0[3]); w.z = cvt_pk_bf16(v1[0], v1[1]); w.w = cvt_pk_bf16(v1[2], v1[3]);
                    *(u32x4*)(P + (size_t)row * PW + pn * BM + wc * 64 + bj * 32 + 8 * fq) = w;
                }
            }
    }
};
struct EpiNull { static constexpr bool PERM = true, AFTER_DRAIN = false;
    __device__ __forceinline__ void operator()(const f32x4 (&acc)[2][2][4][2], const Unit&, int, int, int, int) const {
#pragma unroll
        for (int a = 0; a < 2; ++a)
#pragma unroll
            for (int b = 0; b < 2; ++b)
#pragma unroll
                for (int m = 0; m < 4; ++m) asm volatile("" :: "v"(acc[a][b][m][0]), "v"(acc[a][b][m][1])); } };
struct EpiBranch2 {
    static constexpr bool PERM = true, AFTER_DRAIN = false;
    bf16_t* Pb; int cg0, cg1, ct, co;
    __device__ __forceinline__ void operator()(const f32x4 (&acc)[2][2][4][2], const Unit& u, int wr, int wc, int fr, int fq) const {
        const int cg = u.z ? cg1 : cg0, cst = u.z ? co : ct;
        bf16_t* p0 = Pb + (size_t)(u.pm * BM + wr * 64 + fr) * PW + u.pn * BM + wc * 64 + 8 * fq;
        u32x4 gw[8][2], tw[2][2];
#pragma unroll
        for (int r = 0; r < 8; ++r)
#pragma unroll
            for (int bj = 0; bj < 2; ++bj) gw[r][bj] = __builtin_nontemporal_load((const u32x4*)(p0 + (size_t)erow(r) * PW + bj * 32 + cg));
        if (u.z) {
#pragma unroll
            for (int r = 0; r < 2; ++r)
#pragma unroll
                for (int bj = 0; bj < 2; ++bj) tw[r][bj] = *(const u32x4*)(p0 + (size_t)erow(r) * PW + bj * 32 + ct);
        }
#pragma unroll
        for (int ai = 0; ai < 2; ++ai)
#pragma unroll
            for (int m = 0; m < 4; ++m) {
                const int r = ai * 4 + m;
                u32x4 w[2];
#pragma unroll
                for (int bj = 0; bj < 2; ++bj) {
                    const u32x4 g = gw[r][bj];
                    f32x4 v0 = acc[ai][bj][m][0], v1 = acc[ai][bj][m][1];
                    v0[0] *= bf_lo(g.x); v0[1] *= bf_hi(g.x); v0[2] *= bf_lo(g.y); v0[3] *= bf_hi(g.y);
                    v1[0] *= bf_lo(g.z); v1[1] *= bf_hi(g.z); v1[2] *= bf_lo(g.w); v1[3] *= bf_hi(g.w);
                    if (u.z) { const u32x4 t = tw[r & 1][bj];
                        v0[0] += bf_lo(t.x); v0[1] += bf_hi(t.x); v0[2] += bf_lo(t.y); v0[3] += bf_hi(t.y);
                        v1[0] += bf_lo(t.z); v1[1] += bf_hi(t.z); v1[2] += bf_lo(t.w); v1[3] += bf_hi(t.w); }
                    w[bj].x = cvt_pk_bf16(v0[0], v0[1]); w[bj].y = cvt_pk_bf16(v0[2], v0[3]); w[bj].z = cvt_pk_bf16(v1[0], v1[1]); w[bj].w = cvt_pk_bf16(v1[2], v1[3]);
                }
                if (u.z && r + 2 < 8) {
#pragma unroll
                    for (int bj = 0; bj < 2; ++bj) tw[r & 1][bj] = *(const u32x4*)(p0 + (size_t)erow(r + 2) * PW + bj * 32 + ct);
                }
#pragma unroll
                for (int bj = 0; bj < 2; ++bj) *(u32x4*)(p0 + (size_t)erow(r) * PW + bj * 32 + cst) = w[bj];
            }
    }
};
struct EpiResid {
    static constexpr bool PERM = true, AFTER_DRAIN = false;
    bf16_t* X; float* ss;
    __device__ __forceinline__ void operator()(const f32x4 (&acc)[2][2][4][2], const Unit& u, int wr, int wc, int fr, int fq) const {
        const int row0 = u.pm * BM + wr * 64 + fr;
        bf16_t* px0 = X + (size_t)row0 * 1024 + u.pn * BM + wc * 64 + 8 * fq;
        u32x4 xw[8][2];
#pragma unroll
        for (int r = 0; r < 8; ++r)
#pragma unroll
            for (int bj = 0; bj < 2; ++bj) xw[r][bj] = *(const u32x4*)(px0 + (size_t)erow(r) * 1024 + bj * 32);
#pragma unroll
        for (int ai = 0; ai < 2; ++ai)
#pragma unroll
            for (int m = 0; m < 4; ++m) {
                const int r = ai * 4 + m;
                float q = 0.f;
#pragma unroll
                for (int bj = 0; bj < 2; ++bj) {
                    const u32x4 x = xw[r][bj];
                    f32x4 v0 = acc[ai][bj][m][0], v1 = acc[ai][bj][m][1];
                    v0[0] += bf_lo(x.x); v0[1] += bf_hi(x.x); v0[2] += bf_lo(x.y); v0[3] += bf_hi(x.y);
                    v1[0] += bf_lo(x.z); v1[1] += bf_hi(x.z); v1[2] += bf_lo(x.w); v1[3] += bf_hi(x.w);
                    q += ((v0[0] * v0[0] + v0[1] * v0[1]) + (v0[2] * v0[2] + v0[3] * v0[3])) + ((v1[0] * v1[0] + v1[1] * v1[1]) + (v1[2] * v1[2] + v1[3] * v1[3]));
                    u32x4 w; w.x = cvt_pk_bf16(v0[0], v0[1]); w.y = cvt_pk_bf16(v0[2], v0[3]); w.z = cvt_pk_bf16(v1[0], v1[1]); w.w = cvt_pk_bf16(v1[2], v1[3]);
                    *(u32x4*)(px0 + (size_t)erow(r) * 1024 + bj * 32) = w;
                }
                q += __shfl_xor(q, 16); q += __shfl_xor(q, 32);
                if (fq == 0) ss[(size_t)(row0 + erow(r)) * 16 + u.pn * 4 + wc] = q;
            }
    }
};
struct EpiSwiglu {
    static constexpr bool PERM = true, AFTER_DRAIN = false;
    bf16_t* H; const float* rowss;
    __device__ __forceinline__ void operator()(const f32x4 (&acc)[2][2][4][2], const Unit& u, int wr, int wc, int fr, int fq) const {
        const int row0 = u.pm * BM + wr * 64 + fr;
        f32x4 q[8];
        { const float* rq = rowss + (size_t)row0 * 16 + fq * 4;
#pragma unroll
          for (int r = 0; r < 8; ++r) q[r] = *(const f32x4*)(rq + erow(r) * 16); }
        float rsv[8];
#pragma unroll
        for (int r = 0; r < 8; ++r) rsv[r] = rstd_quarter(q[r]);
#pragma unroll
        for (int ai = 0; ai < 2; ++ai)
#pragma unroll
            for (int m = 0; m < 4; ++m) {
                const int r = ai * 4 + m, row = row0 + erow(r);
                const float rs = rsv[r];
                float o[8];
#pragma unroll
                for (int n = 0; n < 2; ++n)
#pragma unroll
                    for (int e = 0; e < 4; ++e) { const float g = acc[ai][0][m][n][e] * rs, uu = acc[ai][1][m][n][e] * rs; o[n * 4 + e] = g * sigmoidf_(g) * uu; }
                u32x4 w; w.x = cvt_pk_bf16(o[0], o[1]); w.y = cvt_pk_bf16(o[2], o[3]); w.z = cvt_pk_bf16(o[4], o[5]); w.w = cvt_pk_bf16(o[6], o[7]);
                *(u32x4*)(H + (size_t)row * 2816 + u.pn * HALF + wc * 32 + 8 * fq) = w;
            }
    }
};
template <class Epi, class Sched, bool ALIGN_EPI = false, bool SP2 = false>
__device__ __forceinline__ void gemm_phase(PG8_LAS unsigned char* lds, const Gemm g, const Sched& S, const Epi& E, int wave_in) {
    int tid_; asm volatile("v_mbcnt_lo_u32_b32 %0, -1, 0\n\tv_mbcnt_hi_u32_b32 %0, -1, %0" : "=v"(tid_)); tid_ += wave_in * 64;
    const int tid = tid_, wid = __builtin_amdgcn_readfirstlane(tid >> 6), lane = tid & 63, wr = wid >> 2, wc = wid & 3, fr = lane & 15, fq = lane >> 4;
    const int K = g.K, nt = K / BK;
    unsigned voffA[2], voffB[2];
#pragma unroll
    for (int i = 0; i < 2; ++i) { int R, C; stage_rc(tid * 16 + i * 8192, R, C); const int Rb = Epi::PERM ? ((R & ~31) + perm32(R & 31)) : R;
        voffA[i] = (unsigned)(R * g.lda + C) * 2u; voffB[i] = (unsigned)(Rb * g.ldb + C) * 2u; }
    const size_t kstep = (size_t)(BK * 2);
    const size_t hstepA = (size_t)HALF * g.lda * 2, hstepB = (size_t)HALF * g.ldb * 2;
    const size_t tstepA = 2 * hstepA, tstepB = 2 * hstepB;
    const unsigned ldsw = (unsigned)wid * 1024u;
    const int aoff = lds_byte(wr * 64 + fr, fq * 8), boff = lds_byte(wc * 32 + fr, fq * 8);
#define PG8_SA(b, h) (((b) * 2 + (h)) * HTB)
#define PG8_SB(b, h) ((4 + (b) * 2 + (h)) * HTB)
#define PG8_STAGE(bufoff, gbase, voff) do { _Pragma("unroll") for (int _i = 0; _i < 2; ++_i) \
        __builtin_amdgcn_global_load_lds((const unsigned*)((const char*)(gbase) + (voff)[_i]), (PG8_LAS unsigned*)(lds + (bufoff) + ldsw + _i * 8192), 16, 0, 0); } while (0)
#define PG8_LDA(dst, b, h) do { _Pragma("unroll") for (int m = 0; m < 4; ++m) _Pragma("unroll") for (int k = 0; k < 2; ++k) dst[m][k] = *(const PG8_LAS bf16x8*)(lds + PG8_SA(b, h) + aoff + m * 2048 + k * 1024); } while (0)
#define PG8_LDB(dst, b, h) do { _Pragma("unroll") for (int n = 0; n < 2; ++n) _Pragma("unroll") for (int k = 0; k < 2; ++k) dst[n][k] = *(const PG8_LAS bf16x8*)(lds + PG8_SB(b, h) + boff + n * 2048 + k * 1024); } while (0)
#define PG8_MMA(ai, bj, At, Bt) do { __builtin_amdgcn_s_setprio(1); _Pragma("unroll") for (int m = 0; m < 4; ++m) _Pragma("unroll") for (int n = 0; n < 2; ++n) _Pragma("unroll") for (int k = 0; k < 2; ++k) \
        acc[ai][bj][m][n] = __builtin_amdgcn_mfma_f32_16x16x32_bf16(Bt[n][k], At[m][k], acc[ai][bj][m][n], 0, 0, 0); __builtin_amdgcn_s_setprio(0); } while (0)
#define PG8_WAIT_V(n) asm volatile("s_waitcnt vmcnt(" #n ")" ::: "memory")
#define PG8_WAIT_L(n) asm volatile("s_waitcnt lgkmcnt(" #n ")" ::: "memory")
#define PG8_BAR __builtin_amdgcn_s_barrier()
#define PG8_SCHED __builtin_amdgcn_sched_barrier(0)
    Unit cur, nxt; int ui = 0;
    if (!S.next(0, cur)) return;
    f32x4 acc[2][2][4][2];
#pragma unroll
    for (int a = 0; a < 2; ++a)
#pragma unroll
        for (int b = 0; b < 2; ++b)
#pragma unroll
            for (int m = 0; m < 4; ++m)
#pragma unroll
                for (int n = 0; n < 2; ++n) acc[a][b][m][n] = (f32x4){0.f, 0.f, 0.f, 0.f};
    bf16x8 At[4][2], B0[2][2], B1[2][2];
    const long dA2 = (const char*)g.A2 - (const char*)g.A, dB2 = (const char*)g.Bt2 - (const char*)g.Bt;
    const char* cA = (const char*)g.A + (cur.z ? dA2 : 0) + (size_t)cur.pm * tstepA; const char* cB = (const char*)g.Bt + (cur.z ? dB2 : 0) + (size_t)cur.pn * tstepB;
    S.a_ready(cur);
    if constexpr (SP2) {
        PG8_STAGE(PG8_SB(0, 0), cB, voffB); PG8_STAGE(PG8_SB(0, 1), cB + hstepB, voffB); PG8_STAGE(PG8_SA(0, 0), cA, voffA); PG8_STAGE(PG8_SA(0, 1), cA + hstepA, voffA);
        if (wr == 1) PG8_BAR;
        PG8_WAIT_V(2); PG8_BAR;
        PG8_STAGE(PG8_SB(1, 0), cB + kstep, voffB); PG8_STAGE(PG8_SA(1, 0), cA + kstep, voffA); PG8_STAGE(PG8_SB(1, 1), cB + hstepB + kstep, voffB);
        PG8_WAIT_V(6); PG8_BAR;
    } else {
        PG8_STAGE(PG8_SB(0, 0), cB, voffB); PG8_STAGE(PG8_SA(0, 0), cA, voffA); PG8_STAGE(PG8_SB(0, 1), cB + hstepB, voffB); PG8_STAGE(PG8_SA(0, 1), cA + hstepA, voffA);
        if (wr == 1) PG8_BAR;
        PG8_WAIT_V(4); PG8_BAR;
        PG8_STAGE(PG8_SB(1, 0), cB + kstep, voffB); PG8_STAGE(PG8_SA(1, 0), cA + kstep, voffA); PG8_STAGE(PG8_SB(1, 1), cB + hstepB + kstep, voffB);
        PG8_WAIT_V(6); PG8_BAR;
    }
    for (;;) {
        const bool has_next = S.next(ui + 1, nxt);
        const char* nA = has_next ? (const char*)g.A + (nxt.z ? dA2 : 0) + (size_t)nxt.pm * tstepA : cA; const char* nB = has_next ? (const char*)g.Bt + (nxt.z ? dB2 : 0) + (size_t)nxt.pn * tstepB : cB;
        for (int t = 0; t < nt; t += 2) {
            const bool last = (t == nt - 2);
            const char* a1 = cA + (size_t)(t + 1) * kstep;
            const char* a2 = last ? nA : cA + (size_t)(t + 2) * kstep; const char* b2 = last ? nB : cB + (size_t)(t + 2) * kstep;
            const char* a3 = a2 + kstep; const char* b3 = b2 + kstep;
            if (last && has_next) S.a_ready(nxt);
            if constexpr (SP2) {
            PG8_LDB(B0, 0, 0); PG8_LDB(B1, 0, 1); PG8_SCHED; PG8_LDA(At, 0, 0); PG8_STAGE(PG8_SA(1, 1), a1 + hstepA, voffA);
            PG8_WAIT_V(8); PG8_WAIT_L(0); PG8_BAR; PG8_MMA(0, 0, At, B0); PG8_MMA(0, 1, At, B1); PG8_BAR; PG8_SCHED;
            PG8_LDA(At, 0, 1); PG8_STAGE(PG8_SB(0, 0), b2, voffB); PG8_STAGE(PG8_SB(0, 1), b2 + hstepB, voffB); PG8_STAGE(PG8_SA(0, 0), a2, voffA);
            PG8_WAIT_V(8); PG8_WAIT_L(0); PG8_BAR; PG8_MMA(1, 0, At, B0); PG8_MMA(1, 1, At, B1); PG8_BAR; PG8_SCHED;
            PG8_LDB(B0, 1, 0); PG8_LDB(B1, 1, 1); PG8_SCHED; PG8_LDA(At, 1, 0); PG8_STAGE(PG8_SA(0, 1), a2 + hstepA, voffA);
            PG8_WAIT_V(8); PG8_WAIT_L(0); PG8_BAR; PG8_MMA(0, 0, At, B0); PG8_MMA(0, 1, At, B1); PG8_BAR; PG8_SCHED;
            PG8_LDA(At, 1, 1); PG8_STAGE(PG8_SB(1, 0), b3, voffB); PG8_STAGE(PG8_SB(1, 1), b3 + hstepB, voffB); PG8_STAGE(PG8_SA(1, 0), a3, voffA);
            PG8_WAIT_V(8); PG8_WAIT_L(0); PG8_BAR; PG8_MMA(1, 0, At, B0); PG8_MMA(1, 1, At, B1); PG8_BAR; PG8_SCHED;
            } else {
            PG8_LDB(B0, 0, 0); PG8_SCHED; PG8_LDA(At, 0, 0); PG8_STAGE(PG8_SA(1, 1), a1 + hstepA, voffA);
            PG8_WAIT_L(8); PG8_BAR; PG8_WAIT_L(0); PG8_MMA(0, 0, At, B0); PG8_BAR; PG8_SCHED;
            PG8_LDB(B1, 0, 1); PG8_STAGE(PG8_SB(0, 0), b2, voffB);
            PG8_BAR; PG8_WAIT_L(0); PG8_MMA(0, 1, At, B1); PG8_BAR;
            PG8_LDA(At, 0, 1); PG8_STAGE(PG8_SA(0, 0), a2, voffA);
            PG8_BAR; PG8_WAIT_L(0); PG8_MMA(1, 0, At, B0); PG8_BAR; PG8_SCHED;
            PG8_STAGE(PG8_SB(0, 1), b2 + hstepB, voffB);
            PG8_WAIT_V(6); PG8_BAR; PG8_MMA(1, 1, At, B1); PG8_BAR;
            PG8_LDB(B0, 1, 0); PG8_SCHED; PG8_LDA(At, 1, 0); PG8_STAGE(PG8_SA(0, 1), a2 + hstepA, voffA);
            PG8_WAIT_L(8); PG8_BAR; PG8_WAIT_L(0); PG8_MMA(0, 0, At, B0); PG8_BAR; PG8_SCHED;
            PG8_LDB(B1, 1, 1); PG8_STAGE(PG8_SB(1, 0), b3, voffB);
            PG8_BAR; PG8_WAIT_L(0); PG8_MMA(0, 1, At, B1); PG8_BAR;
            PG8_LDA(At, 1, 1); PG8_STAGE(PG8_SA(1, 0), a3, voffA);
            PG8_BAR; PG8_WAIT_L(0); PG8_MMA(1, 0, At, B0); PG8_BAR; PG8_SCHED;
            PG8_STAGE(PG8_SB(1, 1), b3 + hstepB, voffB);
            PG8_WAIT_V(6); PG8_BAR; PG8_MMA(1, 1, At, B1); PG8_BAR;
            }
        }
        if constexpr (ALIGN_EPI) { if (wr == 0) PG8_BAR; }
        if constexpr (!Epi::AFTER_DRAIN) { E(acc, cur, wr, wc, fr, fq); S.done(cur); }
        if (!has_next) break;
#pragma unroll
        for (int a = 0; a < 2; ++a)
#pragma unroll
            for (int b = 0; b < 2; ++b)
#pragma unroll
                for (int m = 0; m < 4; ++m)
#pragma unroll
                    for (int n = 0; n < 2; ++n) acc[a][b][m][n] = (f32x4){0.f, 0.f, 0.f, 0.f};
        cur = nxt; cA = nA; cB = nB; ++ui;
        if constexpr (ALIGN_EPI) { if (wr == 1) PG8_BAR; }
    }
    PG8_WAIT_V(0);
    if constexpr (!ALIGN_EPI) { if (wr == 0) PG8_BAR; }
    PG8_BAR;
    if constexpr (Epi::AFTER_DRAIN) { E.fused(acc, cur, wr, wc, fr, fq, lds, wid, lane); S.done(cur); }
#undef PG8_SA
#undef PG8_SB
#undef PG8_STAGE
#undef PG8_LDA
#undef PG8_LDB
#undef PG8_MMA
#undef PG8_WAIT_V
#undef PG8_WAIT_L
#undef PG8_BAR
#undef PG8_SCHED
}
}

constexpr int NB = 16, SEQ = 2048, DM = 1024, MTOK = NB * SEQ, DEPTH = 2, DIN = 5472, DFF = 2816;
using pg8::PW;
constexpr int C_NQ = 0, C_KCMP = 512, C_VCMP = 640, C_KSLC = 768, C_VSLC = 896, C_KWIN = 1024, C_VWIN = 1152, C_DQ = 1280, C_DK = 1792, C_DV = 2304,
              C_IQ = 2816, C_IK = 3328, C_IW = 3392, C_NG = 3400, C_GN = 3584, C_GD = 4608;
constexpr int C_TMP = 0, C_MRG = 1024;
__host__ __device__ __forceinline__ int proj_src_col(int n) {
    if (n < 1280) return n;
    if (n < 2816) return n - 1280 + 1304;
    if (n < 3328) return n - 2816 + 2840;
    if (n < 3392) return n - 3328 + 3352;
    if (n < 3400) return n - 3392 + 3416;
    if (n < 3424) return n - 3400 + 1280;
    if (n < 3584) return -1;
    return n - 3584 + 3424;
}
constexpr size_t MiB = 1u << 20;
constexpr size_t WS_CTL = 0, CTL_ZERO_BYTES = 65536;
constexpr size_t WS_ROPE = 1 * MiB;
constexpr size_t WS_CB1 = WS_ROPE + 131072;
constexpr size_t WS_RSS = 2 * MiB;
constexpr size_t WS_KC = 4 * MiB;
constexpr size_t WS_KCB = 6 * MiB;
constexpr size_t WS_SELM = 7 * MiB;
constexpr size_t WS_DMASK = 8 * MiB;
constexpr size_t WS_WIN = 16 * MiB;
constexpr size_t SZ_WIN = (size_t)PW * DM * 2, SZ_WBR = (size_t)DM * 512 * 2, SZ_WOUT = (size_t)DM * DM * 2, SZ_WGU = (size_t)PW * DM * 2, SZ_WDN = (size_t)DM * DFF * 2;
constexpr size_t WS_WBN = WS_WIN + DEPTH * SZ_WIN, WS_WBD = WS_WBN + DEPTH * SZ_WBR, WS_WOUT = WS_WBD + DEPTH * SZ_WBR, WS_WGU = WS_WOUT + DEPTH * SZ_WOUT, WS_WDN = WS_WGU + DEPTH * SZ_WGU;
constexpr size_t WS_W1B = WS_WDN + DEPTH * SZ_WDN;
constexpr size_t WS_R1 = 88 * MiB;
constexpr size_t WS_P = 152 * MiB;
constexpr size_t WS_END = WS_P + (size_t)MTOK * PW * 2;
static_assert(WS_W1B + 2 * MiB <= WS_R1 && WS_END <= 512 * MiB, "d_ws map");
constexpr int CW_TMO = 0, CW_CODE = 1, CW_BAR = 4096;

constexpr int LDSCTL_OFF = 0, MISC_OFF = 320, POOL_OFF = 1024;
constexpr int LDS_BYTES = 147456, POOL_BYTES = LDS_BYTES - POOL_OFF;
constexpr int NWAVES = 8, NTHR = 512;
#define GAS __attribute__((address_space(1)))
#define LAS __attribute__((address_space(3)))
typedef unsigned short bf16;
typedef unsigned v4u __attribute__((ext_vector_type(4)));
typedef float f32x4 __attribute__((ext_vector_type(4)));
typedef short bf16x8 __attribute__((ext_vector_type(8)));
typedef GAS unsigned gu32;
typedef GAS unsigned long long gu64;
#define RLX_AGENT __ATOMIC_RELAXED, __HIP_MEMORY_SCOPE_AGENT
#define LDS_WAIT() asm volatile("s_waitcnt lgkmcnt(0)" ::: "memory")
#define VM_WAIT() asm volatile("s_waitcnt vmcnt(0)" ::: "memory")
__device__ __forceinline__ unsigned long long rt() { return __builtin_amdgcn_s_memrealtime(); }
__device__ __forceinline__ unsigned f2bf(float f) { unsigned u = __builtin_bit_cast(unsigned, f); return (u + 0x7fffu + ((u >> 16) & 1u)) >> 16; }
__device__ __forceinline__ unsigned pk2(float lo, float hi) { return f2bf(lo) | (f2bf(hi) << 16); }

#define XB_TMO      128
#define XB_XCNT(j)  (256  + 64 * (j))
#define XB_XSUB(j)  (1280 + 64 * (j))
#define XB_XGEN(j)  (2304 + 64 * (j))
#define XB_TOP      3328
#define XB_TOPGEN   3392
#define XCD_BAR_WORDS 3456
#define XB_SPIN_CAP (1u << 18)

__device__ __forceinline__ unsigned xb_ld(unsigned* p)              { return __hip_atomic_load(p, __ATOMIC_RELAXED, __HIP_MEMORY_SCOPE_AGENT); }
__device__ __forceinline__ unsigned xb_add(unsigned* p, unsigned v) { return __hip_atomic_fetch_add(p, v, __ATOMIC_RELAXED, __HIP_MEMORY_SCOPE_AGENT); }
__device__ __forceinline__ unsigned xb_xcc_id() { return (unsigned)__builtin_amdgcn_s_getreg((3 << 11) | 20) & 0xFu; }
#define XB_SPIN(cond, bar) do { unsigned _sp = 0; while (cond) { __builtin_amdgcn_s_sleep(1); \
    if ((++_sp & 255u) == 0u) { if (xb_ld(&(bar)[XB_TMO])) break; if (_sp > XB_SPIN_CAP) { atomicAdd(&(bar)[XB_TMO], 1u); break; } } } } while (0)

struct XcdBarrier {
    unsigned* bar; unsigned x;
    volatile LAS unsigned* st;
};

__device__ __forceinline__ XcdBarrier xcd_barrier_post(unsigned* bar, volatile LAS unsigned* st) {
    XcdBarrier b; b.bar = bar; b.x = xb_xcc_id(); b.st = st;
    if (threadIdx.x == 0) (void)xb_add(&bar[XB_XCNT(b.x)], 1u);
    return b;
}
__device__ __forceinline__ void xcd_barrier_complete(unsigned* bar, unsigned x, unsigned& nloc, unsigned& nx) {
    const unsigned G = gridDim.x * gridDim.y * gridDim.z;
    unsigned sum, cnt, mine, sp = 0u;
    for (;;) {
        sum = 0u; cnt = 0u; mine = 0u;
#pragma unroll
        for (unsigned j = 0; j < 16; ++j) { const unsigned c = xb_ld(&bar[XB_XCNT(j)]); sum += c; cnt += (c > 0u) ? 1u : 0u; mine = (j == x) ? c : mine; }
        if (sum == G) break;
        __builtin_amdgcn_s_sleep(1);
        if ((++sp & 255u) == 0u) { if (xb_ld(&bar[XB_TMO])) break; if (sp > XB_SPIN_CAP) { atomicAdd(&bar[XB_TMO], 1u); break; } }
    }
    nloc = mine > 0u ? mine : 1u; nx = cnt > 0u ? cnt : 1u;
}

__device__ __forceinline__ void xcd_barrier(const XcdBarrier& b) {
    asm volatile("s_waitcnt vmcnt(0)" ::: "memory");
    __syncthreads();
    if (threadIdx.x == 0) {
        unsigned* bar = b.bar;
        __builtin_amdgcn_s_waitcnt(0);
        unsigned nloc = b.st[0], nx = b.st[1];
        if (nloc == 0u) { xcd_barrier_complete(bar, b.x, nloc, nx); b.st[0] = nloc; b.st[1] = nx; }
        const unsigned old = xb_add(&bar[XB_XSUB(b.x)], 1u);
        const unsigned gen = old / nloc;
        if (old + 1u == (gen + 1u) * nloc) {
            __builtin_amdgcn_fence(__ATOMIC_RELEASE, "agent");
            asm volatile("s_waitcnt vmcnt(0)" ::: "memory");
            const unsigned og = xb_add(&bar[XB_TOP], 1u);
            const unsigned tg = og / nx;
            if (og + 1u == (tg + 1u) * nx) xb_add(&bar[XB_TOPGEN], 1u);
            else XB_SPIN(xb_ld(&bar[XB_TOPGEN]) == tg, bar);
            __builtin_amdgcn_fence(__ATOMIC_ACQUIRE, "agent");
            xb_add(&bar[XB_XGEN(b.x)], 1u);
            asm volatile("s_waitcnt vmcnt(0)" ::: "memory");
        } else {
            XB_SPIN(xb_ld(&bar[XB_XGEN(b.x)]) == gen, bar);
            __builtin_amdgcn_fence(__ATOMIC_ACQUIRE, "agent");
            asm volatile("s_waitcnt vmcnt(0)" ::: "memory");
        }
    }
    __syncthreads();
}
struct Args { const float* in[21]; float* out; unsigned char* ws; int ph_lo, ph_hi, li, pad; };
struct Ctx { LAS unsigned char* lds; int tid, lane, wave, G; };
typedef const __attribute__((address_space(4))) Args* KArgs;
__device__ __forceinline__ KArgs kargs() { KArgs p = (KArgs)__builtin_amdgcn_kernarg_segment_ptr(); asm volatile("" : "+s"(p)); return p; }
__device__ __forceinline__ int fresh_tid(const Ctx& C0) { int ln; asm volatile("v_mbcnt_lo_u32_b32 %0, -1, 0\n\tv_mbcnt_hi_u32_b32 %0, -1, %0" : "=v"(ln)); return C0.wave * 64 + ln; }
#define AIN(i) (kargs()->in[i])
#define AOUT (kargs()->out)
#define AWS (kargs()->ws)
__device__ __forceinline__ float bf2f(bf16 b) { return __uint_as_float((unsigned)b << 16); }
__device__ __forceinline__ float wave_sum(float v) {
#pragma unroll
    for (int o = 1; o < 64; o <<= 1) v += __shfl_xor(v, o);
    return v;
}
__device__ __forceinline__ float wave_max(float v) {
#pragma unroll
    for (int o = 1; o < 64; o <<= 1) v = fmaxf(v, __shfl_xor(v, o));
    return v;
}
__host__ __device__ __forceinline__ int mask_bitpos(int u) { return (u & 3) + 4 * (u >> 3) + 16 * ((u >> 2) & 1); }

__device__ __forceinline__ void p0_transpose_item(const float* srcp, int Ns, bf16* WT, int K, int k0, int n0, LAS float* scr, int lane, const float* gk = nullptr) {
    float tv[32];
#pragma unroll
    for (int i = 0; i < 32; ++i) { const int kk = 2 * i + (lane >> 5); tv[i] = srcp ? __builtin_nontemporal_load(srcp + (size_t)(k0 + kk) * Ns) : 0.f; }
#pragma unroll
    for (int i = 0; i < 32; ++i) { const int kk = 2 * i + (lane >> 5); scr[kk * 33 + (lane & 31)] = gk ? tv[i] * gk[k0 + kk] : tv[i]; }
    LDS_WAIT(); asm volatile("" ::: "memory");
    const int c = lane & 7;
#pragma unroll
    for (int j = 0; j < 4; ++j) { const int n = (lane >> 3) + 8 * j; const LAS float* s = scr + (8 * c) * 33 + n;
        v4u o; o.x = pk2(s[0 * 33], s[1 * 33]); o.y = pk2(s[2 * 33], s[3 * 33]); o.z = pk2(s[4 * 33], s[5 * 33]); o.w = pk2(s[6 * 33], s[7 * 33]);
        *(GAS v4u*)(WT + (size_t)(n0 + n) * K + k0 + 8 * c) = o; }
    LDS_WAIT(); asm volatile("" ::: "memory");
}
__device__ __forceinline__ void sincos_small(double r, double& s, double& c) {
    const double r2 = r * r; double ts = 1.0, tc = 1.0, ss = 1.0, cc = 1.0;
#pragma unroll
    for (int k = 1; k <= 14; ++k) { tc = -tc * r2 * (1.0 / (double)((2 * k - 1) * (2 * k))); ts = -ts * r2 * (1.0 / (double)((2 * k) * (2 * k + 1))); cc += tc; ss += ts; }
    s = r * ss; c = cc;
}
__device__ __forceinline__ void p0_prologue(Ctx& C0) {
    Ctx C = C0; C.tid = fresh_tid(C0); C.lane = C.tid & 63;
    LAS float* scr = (LAS float*)(C.lds + POOL_OFF + C.wave * 16384);
    const int gw = blockIdx.x * NWAVES + C.wave, NGW = C.G * NWAVES, lane = C.lane;
    constexpr int I_WIN = 16 * (PW / 32), I_WBR = 8 * 32, I_WOUT = 16 * 32, I_WGU = 16 * (PW / 32), I_WDN = 44 * 32, I_L = I_WIN + 2 * I_WBR + I_WOUT + I_WGU + I_WDN;
    for (int it = gw; it < DEPTH * I_L; it += NGW) {
        const int l = it / I_L; int r = it % I_L;
        if (r < I_WIN) { const int nblk = PW / 32, kb = r / nblk, nb = r % nblk, n = nb * 32 + (lane & 31), rho = n & 255,
                sc = proj_src_col((n & ~255) + 64 * ((rho >> 5) & 3) + 32 * (rho >> 7) + (rho & 31));
            p0_transpose_item(sc >= 0 ? AIN(2) + (size_t)l * DM * DIN + sc : nullptr, DIN, (bf16*)(AWS + WS_WIN + l * SZ_WIN), DM, kb * 64, nb * 32, scr, lane, AIN(1) + l * DM); continue; } r -= I_WIN;
        if (r < I_WBR) { const int kb = r / 32, nb = r % 32, n0_ = nb * 32 + (lane & 31), rho = n0_ & 255, n = (n0_ & ~255) + 64 * ((rho >> 5) & 3) + 32 * (rho >> 7) + (rho & 31);
            p0_transpose_item(AIN(13) + (size_t)l * 512 * DM + n, DM, (bf16*)(AWS + WS_WBN + l * SZ_WBR), 512, kb * 64, nb * 32, scr, lane); continue; } r -= I_WBR;
        if (r < I_WBR) { const int kb = r / 32, nb = r % 32, n0_ = nb * 32 + (lane & 31), rho = n0_ & 255, n = (n0_ & ~255) + 64 * ((rho >> 5) & 3) + 32 * (rho >> 7) + (rho & 31);
            p0_transpose_item(AIN(14) + (size_t)l * 512 * DM + n, DM, (bf16*)(AWS + WS_WBD + l * SZ_WBR), 512, kb * 64, nb * 32, scr, lane); continue; } r -= I_WBR;
        if (r < I_WOUT) { const int kb = r / 32, nb = r % 32, n0_ = nb * 32 + (lane & 31), rho = n0_ & 255, n = (n0_ & ~255) + 64 * ((rho >> 5) & 3) + 32 * (rho >> 7) + (rho & 31);
            p0_transpose_item(AIN(15) + (size_t)l * DM * DM + n, DM, (bf16*)(AWS + WS_WOUT + l * SZ_WOUT), DM, kb * 64, nb * 32, scr, lane); continue; } r -= I_WOUT;
        if (r < I_WGU) { const int nblk = PW / 32, kb = r / nblk, nb = r % nblk, n = nb * 32 + (lane & 31), j = n & 255, hcol = (n >> 8) * 128 + (j & 127);
            const float* src = (j < 128 ? AIN(17) : AIN(18)) + (size_t)l * DM * DFF + hcol;
            p0_transpose_item(src, DFF, (bf16*)(AWS + WS_WGU + l * SZ_WGU), DM, kb * 64, nb * 32, scr, lane, AIN(16) + l * DM); continue; } r -= I_WGU;
        { const int kb = r / 32, nb = r % 32, n0_ = nb * 32 + (lane & 31), rho = n0_ & 255, n = (n0_ & ~255) + 64 * ((rho >> 5) & 3) + 32 * (rho >> 7) + (rho & 31);
            p0_transpose_item(AIN(19) + (size_t)l * DFF * DM + n, DM, (bf16*)(AWS + WS_WDN + l * SZ_WDN), DFF, kb * 64, nb * 32, scr, lane); }
    }
    for (int it = gw; it < DEPTH * 2 * 32 * 4; it += NGW) {
        const int l = it / 256, r = it % 256, kv = r / 128, kb = (r % 128) / 4, nb = r % 4, n = nb * 32 + (lane & 31);
        p0_transpose_item(AIN(kv ? 9 : 4) + (size_t)l * 2048 * 128 + n, 128, (bf16*)(AWS + WS_W1B) + (size_t)(l * 2 + kv) * 128 * 2048, 2048, kb * 64, nb * 32, scr, lane);
    }
    {
        bf16* XG = (bf16*)(AWS + WS_R1); float* rss = (float*)(AWS + WS_RSS);
        const float* xin = AIN(0);
        for (int m0 = gw * 2; m0 < MTOK; m0 += NGW * 2) {
            f32x4 v[2][4];
#pragma unroll
            for (int rr = 0; rr < 2; ++rr)
#pragma unroll
                for (int j = 0; j < 4; ++j) v[rr][j] = __builtin_nontemporal_load((const GAS f32x4*)(xin + (size_t)(m0 + rr) * DM) + lane + 64 * j);
#pragma unroll
            for (int rr = 0; rr < 2; ++rr) { const int m = m0 + rr;
                GAS unsigned long long* o8 = (GAS unsigned long long*)(XG + (size_t)m * DM) + lane;
                float s = 0.f;
#pragma unroll
                for (int j = 0; j < 4; ++j) { const f32x4 vv = v[rr][j]; s += (vv.x * vv.x + vv.y * vv.y) + (vv.z * vv.z + vv.w * vv.w); const f32x4 y = vv;
                    o8[64 * j] = (unsigned long long)pk2(y.x, y.y) | ((unsigned long long)pk2(y.z, y.w) << 32); }
                s = wave_sum(s);
                if (lane < 16) rss[(size_t)m * 16 + lane] = (lane == 0) ? s : 0.f; }
        }
    }
    {
        float* rc = (float*)(AWS + WS_ROPE);
        const float invf[8] = {1.0f, 0.1939227432012558f, 0.03760603070259094f, 0.007292664609849453f, 0.0014142135623842478f, 0.00027424818836152554f, 5.3182957344688475e-05f, 1.0313385246263351e-05f};
        for (int i = blockIdx.x * NTHR + C.tid; i < 2048 * 8; i += C.G * NTHR) {
            const int pos = i >> 3, j = i & 7; float f = invf[0];
#pragma unroll
            for (int q = 1; q < 8; ++q) f = (j == q) ? invf[q] : f;
            const float ang = (float)pos * f; const double a = (double)ang;
            const double k = __builtin_rint(a * 0.15915494309189535); const double r = (a - k * 6.283185307179586) - k * 2.4492935982947064e-16;
            double s, c; sincos_small(r, s, c);
            rc[pos * 16 + j] = (float)c; rc[pos * 16 + 8 + j] = (float)s;
        }
    }
    for (int it = blockIdx.x; it < DEPTH * 2 * 64; it += C.G) {
        const int lkv = it >> 6, ks = it & 63, l = lkv >> 1, kv = lkv & 1; const float* pos = AIN(kv ? 8 : 3) + (size_t)l * 2048; const float* w1 = AIN(kv ? 9 : 4) + (size_t)l * 2048 * 128;
        LAS float* red = (LAS float*)(C.lds + POOL_OFF);
        __syncthreads();
        const int n = C.tid & 127, q = C.tid >> 7; float a = 0.f;
#pragma unroll
        for (int k = 32 * ks + 8 * q; k < 32 * ks + 8 * q + 8; ++k) a += pos[k] * w1[(size_t)k * 128 + n];
        red[C.tid] = a; __syncthreads();
        if (C.tid < 128) ((float*)(AWS + WS_CB1))[(lkv * 64 + ks) * 128 + n] = (red[n] + red[128 + n]) + (red[256 + n] + red[384 + n]);
        __syncthreads();
    }
}
__device__ __forceinline__ float gelu_tanh(float x) { const float u = 0.7978845608028654f * (x + 0.044715f * x * x * x); const float t = 1.0f - 2.0f / (__expf(2.0f * u) + 1.0f); return 0.5f * x * (1.0f + t); }
__device__ __forceinline__ void final_norm(Ctx& C0) {
    Ctx C = C0; C.tid = fresh_tid(C0); C.lane = C.tid & 63; __syncthreads();
    const float* gn = AIN(20); const int lane = C.lane, wave = C.tid >> 6; const float* rss = (const float*)(AWS + WS_RSS); const bf16* X = (const bf16*)(AWS + WS_R1);
    f32x4 g[4];
#pragma unroll
    for (int j = 0; j < 4; ++j) g[j] = ((const f32x4*)gn)[lane + 64 * j];
    for (int m = blockIdx.x * NWAVES + wave; m < MTOK; m += C.G * NWAVES) {
        GAS f32x4* orow = (GAS f32x4*)(AOUT + (size_t)m * DM) + lane;
        const unsigned long long* xr = (const unsigned long long*)(X + (size_t)m * DM) + lane;
        const float rs = pg8::row_rstd(rss, m);
#pragma unroll
        for (int j = 0; j < 4; ++j) { const unsigned long long w = __builtin_nontemporal_load(xr + 64 * j); const unsigned wl = (unsigned)w, wh = (unsigned)(w >> 32);
            const f32x4 x = {pg8::bf_lo(wl), pg8::bf_hi(wl), pg8::bf_lo(wh), pg8::bf_hi(wh)};
            __builtin_nontemporal_store(x * rs * g[j], orow + 64 * j); }
    }
}
namespace fa {
typedef float f32x16 __attribute__((ext_vector_type(16)));
typedef short s16x4 __attribute__((ext_vector_type(4)));
typedef short v4i16_t __attribute__((ext_vector_type(4)));
typedef short bf16x8 __attribute__((ext_vector_type(8)));
typedef unsigned u32x4 __attribute__((ext_vector_type(4)));
typedef float f32x2_t __attribute__((ext_vector_type(2))); typedef __bf16 bf16x2_t __attribute__((ext_vector_type(2)));
constexpr int SLOTB = 8192, NSLOT = 3;
constexpr int L_K = 0, L_V = NSLOT * SLOTB, L_WS = 2 * NSLOT * SLOTB, L_OST = L_WS + 8 * 256, L_END = L_OST + 8 * 4096;
constexpr float THR = 8.0f, BIGSUM = 1.0e30f;
struct W { int lane, r32, hi, wid; LAS unsigned char* shm; };
__device__ __forceinline__ int crow(int r, int hi) { return (r & 3) + 8 * (r >> 2) + 4 * hi; }
__device__ __forceinline__ unsigned cvtpk(float lo, float hi) { f32x2_t v = {lo, hi}; bf16x2_t b = __builtin_convertvector(v, bf16x2_t); return __builtin_bit_cast(unsigned, b); }
__device__ __forceinline__ float max3f(float a, float b, float c) { return __builtin_fmaxf(__builtin_fmaxf(a, b), c); }
#define FA_WAIT_BAR(N) asm volatile("s_waitcnt vmcnt(" #N ") lgkmcnt(0)\n\ts_barrier" ::: "memory")
__device__ __forceinline__ void glds16(const void* gsrc, unsigned lds_dst) { unsigned keep;
    asm volatile("s_mov_b32 %0, m0\n\ts_mov_b32 m0, %2\n\ts_nop 0\n\tglobal_load_lds_dwordx4 %1, off\n\ts_mov_b32 m0, %0" : "=&s"(keep) : "v"(gsrc), "s"(lds_dst) : "memory"); }
__device__ __forceinline__ void dma_tile(const W& w, const bf16* Kb, const bf16* Vb, int pitch, int tile, int slot) {
    const bf16* ks = Kb + (size_t)(64 * tile + w.lane) * pitch + w.wid * 8;
    const bf16* vs = Vb + (size_t)(64 * tile + 16 * (w.wid & 3) + (w.lane >> 2)) * pitch + (w.wid >> 2) * 32 + (w.lane & 3) * 8;
    const unsigned l0 = (unsigned)(uintptr_t)(w.shm) + slot * SLOTB + w.wid * 1024;
    glds16(ks, (unsigned)__builtin_amdgcn_readfirstlane(l0 + L_K)); glds16(vs, (unsigned)__builtin_amdgcn_readfirstlane(l0 + L_V));
}
__device__ __forceinline__ void qkt(f32x16& p0, f32x16& p1, const LAS unsigned char* Kslot, const bf16x8 (&qr)[4], int r32, int hi) {
    const f32x16 zero = f32x16{};
    const LAS unsigned char* kb = Kslot + hi * 1024 + r32 * 16;
#pragma unroll
    for (int dh = 0; dh < 2; ++dh) {
        bf16x8 b0[2], b1[2];
#pragma unroll
        for (int d = 0; d < 2; ++d) { b0[d] = *(const LAS bf16x8*)(kb + (2 * dh + d) * 2048); b1[d] = *(const LAS bf16x8*)(kb + (2 * dh + d) * 2048 + 512); }
        __builtin_amdgcn_sched_barrier(0);
#pragma unroll
        for (int d = 0; d < 2; ++d) { const int d0 = 2 * dh + d;
            if (d0 == 0) { p0 = __builtin_amdgcn_mfma_f32_32x32x16_bf16(b0[d], qr[0], zero, 0, 0, 0); p1 = __builtin_amdgcn_mfma_f32_32x32x16_bf16(b1[d], qr[0], zero, 0, 0, 0); }
            else { p0 = __builtin_amdgcn_mfma_f32_32x32x16_bf16(b0[d], qr[d0], p0, 0, 0, 0); p1 = __builtin_amdgcn_mfma_f32_32x32x16_bf16(b1[d], qr[d0], p1, 0, 0, 0); } }
    }
}
__device__ __forceinline__ s16x4 vtr(const LAS unsigned char* p) { return __builtin_bit_cast(s16x4, __builtin_amdgcn_ds_read_tr16_b64_v4i16((LAS v4i16_t*)p)); }
template <bool WITH_L = true> __device__ __forceinline__ void pv(f32x16 (&o)[2], f32x16& lacc, const LAS unsigned char* vp, const u32x4 (&pw)[4]) {
    const bf16x8 ones = {16256, 16256, 16256, 16256, 16256, 16256, 16256, 16256};
#pragma unroll
    for (int d0 = 0; d0 < 2; ++d0) {
        s16x4 lo[4], hi[4];
#pragma unroll
        for (int ks = 0; ks < 4; ++ks) { lo[ks] = vtr(vp + d0 * 4096 + ks * 1024); hi[ks] = vtr(vp + d0 * 4096 + ks * 1024 + 512); }
        __builtin_amdgcn_sched_barrier(0);
        if (WITH_L && d0 == 0) {
#pragma unroll
            for (int ks = 0; ks < 4; ++ks) lacc = __builtin_amdgcn_mfma_f32_32x32x16_bf16(__builtin_bit_cast(bf16x8, pw[ks]), ones, lacc, 0, 0, 0);
            __builtin_amdgcn_sched_barrier(0);
        }
#pragma unroll
        for (int ks = 0; ks < 4; ++ks) { const bf16x8 vf = {lo[ks][0], lo[ks][1], lo[ks][2], lo[ks][3], hi[ks][0], hi[ks][1], hi[ks][2], hi[ks][3]};
            o[d0] = __builtin_amdgcn_mfma_f32_32x32x16_bf16(__builtin_bit_cast(bf16x8, pw[ks]), vf, o[d0], 0, 0, 0); }
    }
}
__device__ __forceinline__ void pv(f32x16 (&o)[2], const LAS unsigned char* vp, const u32x4 (&pw)[4]) { f32x16 none; pv<false>(o, none, vp, pw); }
__device__ __forceinline__ float half_swap(float v) { const auto rr = __builtin_amdgcn_permlane32_swap(__float_as_uint(v), __float_as_uint(v), false, false); return __uint_as_float(rr[0] == __float_as_uint(v) ? rr[1] : rr[0]); }
__device__ __forceinline__ float rowmax(const f32x16& p0, const f32x16& p1) {
    float a = max3f(p0[0], p0[1], p1[0]), b = max3f(p0[2], p0[3], p1[1]); a = max3f(a, p1[2], p1[3]);
#pragma unroll
    for (int r = 4; r < 16; r += 4) { a = max3f(a, p0[r], p0[r + 1]); b = max3f(b, p0[r + 2], p0[r + 3]); a = max3f(a, p1[r], p1[r + 1]); b = max3f(b, p1[r + 2], p1[r + 3]); }
    const float m = __builtin_fmaxf(a, b);
    const auto rr = __builtin_amdgcn_permlane32_swap(__float_as_uint(m), __float_as_uint(m), false, false);
    return __builtin_fmaxf(__uint_as_float(rr[0]), __uint_as_float(rr[1]));
}
struct St { f32x16 o[2], lacc; float mref; bool moved; };
__device__ __forceinline__ void st_init(St& s) { s.o[0] = f32x16{}; s.o[1] = f32x16{}; s.lacc = f32x16{}; s.mref = 0.f; s.moved = false; }
template <class MaskF> __device__ __forceinline__ void tile_step(const W& w, int slot, const bf16x8 (&qr)[4], MaskF& MF, St& s, bool safe) {
    f32x16 p0, p1;
    qkt(p0, p1, w.shm + L_K + slot * SLOTB, qr, w.r32, w.hi);
    MF.pre(p0, p1);
    if (__builtin_expect(safe, 0)) {
        if (s.moved) {
#pragma unroll
            for (int r = 0; r < 16; ++r) { p0[r] -= s.mref; p1[r] -= s.mref; } }
        MF.pre_slow(p0, p1);
        const float rm = rowmax(p0, p1);
        if (__any(rm > THR)) {
            const float dl = __builtin_fmaxf(rm, 0.f); s.mref += dl; s.moved = true;
#pragma unroll
            for (int r = 0; r < 16; ++r) { p0[r] -= dl; p1[r] -= dl; }
            const float f = __builtin_amdgcn_exp2f(-dl);
            LAS float* wsf = (LAS float*)(w.shm + L_WS) + w.wid * 64;
            if (w.hi == 0) wsf[w.r32] = f;
            asm volatile("s_waitcnt lgkmcnt(0)" ::: "memory");
#pragma unroll
            for (int r = 0; r < 16; ++r) { const float fr = wsf[crow(r, w.hi)]; s.o[0][r] *= fr; s.o[1][r] *= fr; s.lacc[r] *= fr; }
        }
    }
#pragma unroll
    for (int r = 0; r < 16; ++r) { p0[r] = __builtin_amdgcn_exp2f(p0[r]); p1[r] = __builtin_amdgcn_exp2f(p1[r]); }
    MF.post(p0, p1);
    u32x4 pw[4];
#pragma unroll
    for (int k = 0; k < 4; ++k) { pw[0][k] = cvtpk(p0[2 * k], p0[2 * k + 1]); pw[1][k] = cvtpk(p0[8 + 2 * k], p0[9 + 2 * k]); pw[2][k] = cvtpk(p1[2 * k], p1[2 * k + 1]); pw[3][k] = cvtpk(p1[8 + 2 * k], p1[9 + 2 * k]); }
    MF.postw(pw);
    const LAS unsigned char* vp = w.shm + L_V + slot * SLOTB + ((w.lane >> 4) & 1) * 32 + (w.lane & 3) * 8 + (4 * w.hi + ((w.lane & 15) >> 2)) * 64;
    pv(s.o, s.lacc, vp, pw);
}
__device__ __forceinline__ bool branch_overflowed(const W& w, const St& s, int epoch) {
    volatile LAS int* flag = (volatile LAS int*)(w.shm - POOL_OFF + LDSCTL_OFF);
    float t = 0.f;
#pragma unroll
    for (int r = 0; r < 16; ++r) t += s.lacc[r];
    if (__builtin_expect(__any(!(t < BIGSUM)), 0)) { if (w.lane == 0) *flag = epoch; }
    asm volatile("s_waitcnt lgkmcnt(0)\n\ts_barrier" ::: "memory");
    return __builtin_amdgcn_readfirstlane(*flag) == epoch;
}
template <class TS, class MaskF> __device__ __forceinline__ bool run_branch(const W& w_in, const bf16* Kb, const bf16* Vb, int pitch, TS ts, bf16x8 (&qr)[4], MaskF& MF, St& s, bool safe, int epoch) {
    const W& w = w_in;
    const int n = ts.n;
    asm volatile("s_waitcnt vmcnt(0)" : "+v"(qr[0]), "+v"(qr[1]), "+v"(qr[2]), "+v"(qr[3]) :: "memory");
    int t0 = 0, t1 = 0, t2 = 0;
    if (n > 0) { t0 = ts.next(); MF.issue(t0); dma_tile(w, Kb, Vb, pitch, t0, 0); }
    if (n > 1) { t1 = ts.next(); dma_tile(w, Kb, Vb, pitch, t1, 1); MF.template settle<4>(); } else { MF.template settle<2>(); }
    int slot = 0;
#pragma nounroll
    for (int k = 0; k < n; ++k) {
        if (k + 1 < n) { FA_WAIT_BAR(2); } else { FA_WAIT_BAR(0); }
        MF.advance(t0);
        if (k + 1 < n) MF.issue(t1);
        if (k + 2 < n) { t2 = ts.next(); int s2 = slot + 2; s2 = s2 >= NSLOT ? s2 - NSLOT : s2; dma_tile(w, Kb, Vb, pitch, t2, s2); }
        if (MF.active(t0)) tile_step(w, slot, qr, MF, s, safe);
        if (k + 2 < n) { MF.template settle<2>(); } else { MF.template settle<0>(); }
        slot = (slot == NSLOT - 1) ? 0 : slot + 1; t0 = t1; t1 = t2;
    }
    return branch_overflowed(w, s, epoch);
}
__device__ __forceinline__ void finish_branch(const W& w, St& s, float gate, f32x16 (&oacc)[2]) {
    LAS float* wsf = (LAS float*)(w.shm + L_WS) + w.wid * 64;
    if (w.hi == 0) wsf[32 + w.r32] = gate;
    asm volatile("s_waitcnt lgkmcnt(0)" ::: "memory");
#pragma unroll
    for (int r = 0; r < 16; ++r) { const float l = s.lacc[r]; const float sc = (l > 0.f) ? wsf[32 + crow(r, w.hi)] * __builtin_amdgcn_rcpf(l) : 0.f; oacc[0][r] += s.o[0][r] * sc; oacc[1][r] += s.o[1][r] * sc; }
    asm volatile("s_waitcnt lgkmcnt(0)" ::: "memory");
}
__device__ __forceinline__ void store_o(const W& w_in, const f32x16 (&oacc)[2], bf16* Ow, int opitch) {
    const W& w = w_in;
    LAS bf16* stg = (LAS bf16*)(w.shm + L_OST) + w.wid * 2048;
#pragma unroll
    for (int r = 0; r < 16; ++r) { const int orow = crow(r, w.hi);
#pragma unroll
        for (int d0 = 0; d0 < 2; ++d0) stg[orow * 64 + d0 * 32 + w.r32] = (bf16)(cvtpk(oacc[d0][r], 0.f) & 0xffffu); }
    asm volatile("s_waitcnt lgkmcnt(0)" ::: "memory");
#pragma unroll
    for (int i = 0; i < 4; ++i) { const int row = i * 8 + (w.lane >> 3), ch = w.lane & 7; const u32x4 v = *(const LAS u32x4*)(stg + row * 64 + ch * 8); *(u32x4*)(Ow + (size_t)row * opitch + ch * 8) = v; }
    asm volatile("s_waitcnt lgkmcnt(0)" ::: "memory");
}
struct SeqRange { int n, t; __device__ __forceinline__ int next() { return t++; } };
struct SeqBits { int n; unsigned rem; __device__ __forceinline__ int next() { const int t = __builtin_ctz(rem); rem &= rem - 1u; return t; } };
}

constexpr int L_MK = fa::L_END, L_MK_SLOT = 2048, DSA_LDS_END = L_MK + fa::NSLOT * L_MK_SLOT;
struct DsaMask {
    const LAS unsigned char* mlds;
    int hi, last_tile; unsigned w0, w1;
    __device__ __forceinline__ bool active(int t) const { return t <= last_tile; }
    __device__ __forceinline__ void advance_slot(int slot) { w0 = *(const LAS unsigned*)(mlds + slot * L_MK_SLOT) >> (16 * hi); w1 = *(const LAS unsigned*)(mlds + slot * L_MK_SLOT + 1024) >> (16 * hi); }
    __device__ __forceinline__ void pre(fa::f32x16&, fa::f32x16&) const {}
    __device__ __forceinline__ void pre_slow(fa::f32x16& p0, fa::f32x16& p1) const {
#pragma unroll
        for (int r = 0; r < 16; ++r) {
            if (!((w0 >> r) & 1u)) p0[r] = -INFINITY;
            if (!((w1 >> r) & 1u)) p1[r] = -INFINITY; }
    }
    __device__ __forceinline__ void postw(fa::u32x4 (&)[4]) const {}
    __device__ __forceinline__ void post(fa::f32x16& p0, fa::f32x16& p1) const {
#pragma unroll
        for (int r = 0; r < 16; ++r) {
            unsigned m0, m1;
            asm("v_bfe_i32 %0, %1, %2, 1" : "=v"(m0) : "v"(w0), "n"(r));
            asm("v_bfe_i32 %0, %1, %2, 1" : "=v"(m1) : "v"(w1), "n"(r));
            p0[r] = __uint_as_float(__float_as_uint(p0[r]) & m0);
            p1[r] = __uint_as_float(__float_as_uint(p1[r]) & m1); }
    }
};
__device__ __forceinline__ void dsa_dma_tile(const fa::W& w, const bf16* Kb, const bf16* Vb, const unsigned* mk, int tile, int slot) {
    fa::dma_tile(w, Kb, Vb, PW, tile, slot);
    if (w.wid < 2) fa::glds16(mk + (size_t)(2 * tile + w.wid) * SEQ + 4 * w.lane, (unsigned)__builtin_amdgcn_readfirstlane((unsigned)(uintptr_t)(w.shm) + L_MK + slot * L_MK_SLOT + w.wid * 1024));
}
#define DSA_WAIT_BAR(wid_, N2, N3) do { if ((wid_) < 2) { FA_WAIT_BAR(N3); } else { FA_WAIT_BAR(N2); } } while (0)
__device__ __forceinline__ bool run_branch_dsa(const fa::W& w, const bf16* Kb, const bf16* Vb, const unsigned* mk, int n, fa::bf16x8 (&qr)[4], DsaMask& MF, fa::St& s, bool safe, int epoch) {
    asm volatile("s_waitcnt vmcnt(0)" : "+v"(qr[0]), "+v"(qr[1]), "+v"(qr[2]), "+v"(qr[3]) :: "memory");
    dsa_dma_tile(w, Kb, Vb, mk, 0, 0);
    if (n > 1) dsa_dma_tile(w, Kb, Vb, mk, 1, 1);
    int slot = 0;
#pragma nounroll
    for (int k = 0; k < n; ++k) {
        if (k + 1 < n) { DSA_WAIT_BAR(w.wid, 2, 3); } else { FA_WAIT_BAR(0); }
        MF.advance_slot(slot);
        if (k + 2 < n) { int s2 = slot + 2; s2 = s2 >= fa::NSLOT ? s2 - fa::NSLOT : s2; dsa_dma_tile(w, Kb, Vb, mk, k + 2, s2); }
        if (MF.active(k)) fa::tile_step(w, slot, qr, MF, s, safe);
        slot = (slot == fa::NSLOT - 1) ? 0 : slot + 1;
    }
    return fa::branch_overflowed(w, s, epoch);
}
__device__ __forceinline__ void dsa_mfma(Ctx& C0) {
    Ctx C = C0; C.tid = fresh_tid(C0); C.lane = C.tid & 63; if (C.tid == 0) *(volatile LAS int*)(C.lds + LDSCTL_OFF) = 0; __syncthreads();
    int ep = 0;
    fa::W w; w.lane = C.lane; w.r32 = C.lane & 31; w.hi = C.lane >> 5; w.wid = C.wave; w.shm = C.lds + POOL_OFF;
    const bf16* P = (const bf16*)(AWS + WS_P); bf16* O = (bf16*)AOUT;        const unsigned* DMK = (const unsigned*)(AWS + WS_DMASK);
    const int G = C.G, bx = blockIdx.x, vcu = (G % 8 == 0) ? (bx % 8) * (G / 8) + bx / 8 : bx;
    for (int sl = vcu; sl < 256; sl += G) {
        const int bh = sl >> 1, sub = sl & 1, b = bh >> 3, h = bh & 7;
        for (int i = 0; i < 4; ++i) {
            const int qb = sub == 0 ? (i == 0 ? 7 : i == 1 ? 0 : i == 2 ? 4 : 3) : (i == 0 ? 6 : i == 1 ? 1 : i == 2 ? 5 : 2);
            { int tidu = fresh_tid(C0); w.lane = tidu & 63; w.r32 = w.lane & 31; w.hi = w.lane >> 5; w.wid = __builtin_amdgcn_readfirstlane(tidu >> 6); }
            const int q0 = qb * 256, tq = q0 + 32 * w.wid + w.r32;
            const bf16* Pb = P + (size_t)b * SEQ * PW;
            const bf16* Qrow = Pb + (size_t)tq * PW + C_DQ + h * 64;
            fa::bf16x8 qr[4];
#pragma unroll
            for (int d0 = 0; d0 < 4; ++d0) qr[d0] = *(const fa::bf16x8*)(Qrow + d0 * 16 + w.hi * 8);
            fa::St st;
#pragma nounroll
            for (int pass = 0; pass < 2; ++pass) {
                DsaMask MF; MF.mlds = w.shm + L_MK + (32 * w.wid + w.r32) * 4; MF.hi = w.hi; MF.last_tile = (q0 + 32 * w.wid + 31) >> 6; MF.w0 = MF.w1 = 0u;
                fa::st_init(st); ++ep;
                if (!run_branch_dsa(w, Pb + C_DK + h * 64, Pb + C_DV + h * 64, DMK + (size_t)b * 64 * SEQ + q0, (q0 + 256) / 64, qr, MF, st, pass != 0, ep)) break;
            }
            fa::f32x16 oacc[2]; oacc[0] = fa::f32x16{}; oacc[1] = fa::f32x16{};
            fa::finish_branch(w, st, 1.0f, oacc);
            fa::store_o(w, oacc, O + (size_t)(b * SEQ + q0 + 32 * w.wid) * 1024 + 512 + h * 64, 1024);
        }
    }
}
struct NsaSlcMask {
    unsigned rowsel, wmask; int diag, tq, hi; unsigned cursel;
    __device__ __forceinline__ bool active(int t) const { return (wmask >> t) & 1u; }
    __device__ __forceinline__ void issue(int) {}
    template <int N> __device__ __forceinline__ void settle() {}
    int curt;
    __device__ __forceinline__ void advance(int t) { curt = t; cursel = ((rowsel >> t) & 1u) ? 0xffffffffu : 0u; }
    __device__ __forceinline__ void pre(fa::f32x16& p0, fa::f32x16& p1) const {
        if (curt == diag) {
            const int lim = tq - 64 * diag - 4 * hi;
#pragma unroll
            for (int r = 0; r < 16; ++r) { const int ko = (r & 3) + 8 * (r >> 2); if (ko > lim) p0[r] = -INFINITY; if (ko + 32 > lim) p1[r] = -INFINITY; }
        }
    }
    __device__ __forceinline__ void pre_slow(fa::f32x16& p0, fa::f32x16& p1) const {
        if (!cursel) {
#pragma unroll
            for (int r = 0; r < 16; ++r) { p0[r] = -INFINITY; p1[r] = -INFINITY; } }
    }
    __device__ __forceinline__ void post(fa::f32x16&, fa::f32x16&) const {}
    __device__ __forceinline__ void postw(fa::u32x4 (&pw)[4]) const {
#pragma unroll
        for (int i = 0; i < 4; ++i) { pw[i][0] &= cursel; pw[i][1] &= cursel; pw[i][2] &= cursel; pw[i][3] &= cursel; }
    }
};
struct NsaWinMask {
    int tq, hi, tq0, curt;
    __device__ __forceinline__ bool active(int t) const { return 64 * t + 63 >= tq0 - 511 && 64 * t <= tq0 + 31; }
    __device__ __forceinline__ void issue(int) {}
    template <int N> __device__ __forceinline__ void settle() {}
    __device__ __forceinline__ void advance(int t) { curt = t; }
    __device__ __forceinline__ void pre(fa::f32x16& p0, fa::f32x16& p1) const {
        const int k0 = 64 * curt;
        if (k0 < tq0 - 480 || k0 + 63 > tq0) {
            const int hiL = tq - k0 - 4 * hi, loL = hiL - 511;
#pragma unroll
            for (int r = 0; r < 16; ++r) { const int ko = (r & 3) + 8 * (r >> 2); if (ko > hiL || ko < loL) p0[r] = -INFINITY; if (ko + 32 > hiL || ko + 32 < loL) p1[r] = -INFINITY; }
        }
    }
    __device__ __forceinline__ void pre_slow(fa::f32x16&, fa::f32x16&) const {}
    __device__ __forceinline__ void post(fa::f32x16&, fa::f32x16&) const {}
    __device__ __forceinline__ void postw(fa::u32x4 (&)[4]) const {}
};
template <int MODE> __device__ __forceinline__ void nsa_mfma(Ctx& C0) {
    Ctx C = C0; C.tid = fresh_tid(C0); C.lane = C.tid & 63; if (C.tid == 0) *(volatile LAS int*)(C.lds + LDSCTL_OFF) = 0; __syncthreads();
    int ep = 0;
    using namespace fa;
    W w; w.lane = C.lane; w.r32 = C.lane & 31; w.hi = C.lane >> 5; w.wid = C.wave; w.shm = C.lds + POOL_OFF;
    LAS float* impbuf = (LAS float*)(w.shm + L_END);
    LAS float* impsum = impbuf + 4 * 2 * 32 * 33;
    LAS unsigned* selm = (LAS unsigned*)(impsum + 64 * 33);
    const bf16* P = (const bf16*)(AWS + WS_P); bf16* O = (bf16*)AOUT;
    const bf16* KCB = (const bf16*)(AWS + WS_KCB);
    const int G = C.G, bx = blockIdx.x, vcu = (G % 8 == 0) ? (bx % 8) * (G / 8) + bx / 8 : bx;
    for (int sl = vcu; sl < 256; sl += G) {
        const int bg = sl >> 3, b = bg >> 1, g = bg & 1, s8 = sl & 7;
        for (int ui = 0; ui < 4; ++ui) {
            const int cur = (ui == 0) ? 31 - s8 : (ui == 1) ? s8 : (ui == 2) ? 16 + s8 : 15 - s8;
            int tidu = fresh_tid(C0);
            C.tid = tidu; C.lane = tidu & 63; C.wave = __builtin_amdgcn_readfirstlane(tidu >> 6);
            w.lane = C.lane; w.r32 = C.lane & 31; w.hi = C.lane >> 5; w.wid = C.wave;
            const int r = w.wid & 3, th = w.wid >> 2;
            const int q0 = 64 * cur, tq0 = q0 + 32 * th, tq = tq0 + w.r32, head = 4 * g + r;
            const bf16* Pb = P + (size_t)b * SEQ * PW; const bf16* Prow = Pb + (size_t)tq * PW;
            bf16x8 qr[4];
#pragma unroll
            for (int d0 = 0; d0 < 4; ++d0) qr[d0] = *(const bf16x8*)(Prow + C_NQ + head * 64 + d0 * 16 + w.hi * 8);
            const float g_c = bf2f(Prow[C_NG + 0 * 8 + head]), g_s = bf2f(Prow[C_NG + 1 * 8 + head]), g_w = bf2f(Prow[C_NG + 2 * 8 + head]);
            if (C.tid < 3) selm[64 + C.tid] = 0u;
            f32x16 oacc[2];
            {
                const bf16* kc = KCB + (size_t)((0 * NB + b) * 2 + g) * 128 * 64; const bf16* vc = KCB + (size_t)((1 * NB + b) * 2 + g) * 128 * 64;
                const bool two = (q0 >= 1024);
                asm volatile("s_waitcnt vmcnt(0)" : "+v"(qr[0]), "+v"(qr[1]), "+v"(qr[2]), "+v"(qr[3]) :: "memory");
                dma_tile(w, kc, vc, 64, 0, 0); if (two) dma_tile(w, kc, vc, 64, 1, 1);
                FA_WAIT_BAR(0);
                f32x16 p[4];
                qkt(p[0], p[1], w.shm + L_K, qr, w.r32, w.hi);
                if (two) qkt(p[2], p[3], w.shm + L_K + SLOTB, qr, w.r32, w.hi);
                else {
#pragma unroll
                    for (int i = 0; i < 16; ++i) { p[2][i] = -INFINITY; p[3][i] = -INFINITY; } }
                const int lim = (tq >= 31 ? ((tq - 31) >> 4) : -1) - 4 * w.hi;
                float m = -INFINITY;
#pragma unroll
                for (int T = 0; T < 4; ++T)
#pragma unroll
                    for (int i = 0; i < 16; ++i) { const int c = 32 * T + (i & 3) + 8 * (i >> 2); if (c > lim) p[T][i] = -INFINITY; m = __builtin_fmaxf(m, p[T][i]); }
                { const auto rr = __builtin_amdgcn_permlane32_swap(__float_as_uint(m), __float_as_uint(m), false, false); m = __builtin_fmaxf(__uint_as_float(rr[0]), __uint_as_float(rr[1])); }
                const float msub = (m == -INFINITY) ? 0.f : m; float l = 0.f;
#pragma unroll
                for (int T = 0; T < 4; ++T)
#pragma unroll
                    for (int i = 0; i < 16; ++i) { p[T][i] = __builtin_amdgcn_exp2f(p[T][i] - msub); l += p[T][i]; }
                { const auto rr = __builtin_amdgcn_permlane32_swap(__float_as_uint(l), __float_as_uint(l), false, false); l = __uint_as_float(rr[0]) + __uint_as_float(rr[1]); }
                const float inv = (l > 0.f) ? 1.0f / l : 0.f;
#pragma unroll
                for (int T = 0; T < 4; ++T)
#pragma unroll
                    for (int i = 0; i < 16; ++i) p[T][i] *= inv;
                if (cur >= 16) {
                    LAS float* ib = impbuf + ((r * 2 + th) * 32 + w.r32) * 33;
                    float prv = 0.f;
#pragma unroll
                    for (int T = 0; T < 4; ++T)
#pragma unroll
                        for (int a = 0; a < 4; ++a) {
                            const float car = 0.5f * p[T][4 * a + 3], part = (p[T][4 * a] + p[T][4 * a + 1]) + (p[T][4 * a + 2] + car);
                            const auto rr = __builtin_amdgcn_permlane32_swap(__float_as_uint(car), __float_as_uint(car), false, false);
                            const float oth = (w.hi == 0) ? __uint_as_float(rr[1]) : __uint_as_float(rr[0]);
                            ib[8 * T + 2 * a + w.hi] = part + (w.hi ? oth : prv); prv = oth; }
                }
                {
                    u32x4 pwA[4], pwB[4];
#pragma unroll
                    for (int k = 0; k < 4; ++k) { pwA[0][k] = cvtpk(p[0][2 * k], p[0][2 * k + 1]); pwA[1][k] = cvtpk(p[0][8 + 2 * k], p[0][9 + 2 * k]); pwA[2][k] = cvtpk(p[1][2 * k], p[1][2 * k + 1]); pwA[3][k] = cvtpk(p[1][8 + 2 * k], p[1][9 + 2 * k]);
                        pwB[0][k] = cvtpk(p[2][2 * k], p[2][2 * k + 1]); pwB[1][k] = cvtpk(p[2][8 + 2 * k], p[2][9 + 2 * k]); pwB[2][k] = cvtpk(p[3][2 * k], p[3][2 * k + 1]); pwB[3][k] = cvtpk(p[3][8 + 2 * k], p[3][9 + 2 * k]); }
                    asm volatile("" : "+v"(pwA[0]), "+v"(pwA[1]), "+v"(pwA[2]), "+v"(pwA[3]), "+v"(pwB[0]), "+v"(pwB[1]), "+v"(pwB[2]), "+v"(pwB[3]));
                    f32x16 oc[2]; oc[0] = f32x16{}; oc[1] = f32x16{};
                    const LAS unsigned char* vp = w.shm + L_V + ((w.lane >> 4) & 1) * 32 + (w.lane & 3) * 8 + (4 * w.hi + ((w.lane & 15) >> 2)) * 64;
                    pv(oc, vp, pwA);
                    if (two) pv(oc, vp + SLOTB, pwB);
                    LAS float* wsf = (LAS float*)(w.shm + L_WS) + w.wid * 64;
                    if (w.hi == 0) wsf[32 + w.r32] = g_c;
                    asm volatile("s_waitcnt lgkmcnt(0)" ::: "memory");
#pragma unroll
                    for (int i = 0; i < 16; ++i) { const float scl = wsf[32 + crow(i, w.hi)]; oacc[0][i] = oc[0][i] * scl; oacc[1][i] = oc[1][i] * scl; }
                }
                asm volatile("s_waitcnt lgkmcnt(0)\n\ts_barrier" ::: "memory");
            }
            unsigned rowsel, umask, wmask;
#ifndef NSA_NO_RANK
            if (cur >= 16) {
                for (int e = C.tid; e < 64 * 32; e += NTHR) { const int tk = e >> 5, j = e & 31; float a = 0.f;
#pragma unroll
                    for (int rr2 = 0; rr2 < 4; ++rr2) a += impbuf[((rr2 * 2 + (tk >> 5)) * 32 + (tk & 31)) * 33 + j];
                    impsum[tk * 33 + j] = a; }
                asm volatile("s_waitcnt lgkmcnt(0)\n\ts_barrier" ::: "memory");
                const int tk = C.tid >> 3, jg = C.tid & 7; float sv[32];
#pragma unroll
                for (int j = 0; j < 32; ++j) { const float im = impsum[tk * 33 + j]; sv[j] = (j > cur) ? -INFINITY : ((j == 0 || j == cur || j == cur - 1) ? 1e4f : im); }
                unsigned bits = 0u;
#pragma unroll
                for (int q = 0; q < 4; ++q) { const int j = 4 * jg + q; float mine = sv[0];
#pragma unroll
                    for (int i = 1; i < 32; ++i) mine = (i == j) ? sv[i] : mine;
                    int rank = 0;
#pragma unroll
                    for (int i = 0; i < 32; ++i) rank += (sv[i] > mine || (sv[i] == mine && i < j)) ? 1 : 0;
                    if (rank < 16 && j <= cur) bits |= 1u << j; }
                bits |= __shfl_xor(bits, 1); bits |= __shfl_xor(bits, 2); bits |= __shfl_xor(bits, 4);
                if (jg == 0) { selm[tk] = bits; __hip_atomic_fetch_or(&selm[64], bits, __ATOMIC_RELAXED, __HIP_MEMORY_SCOPE_WORKGROUP); __hip_atomic_fetch_or(&selm[65 + (tk >> 5)], bits, __ATOMIC_RELAXED, __HIP_MEMORY_SCOPE_WORKGROUP); }
                asm volatile("s_waitcnt lgkmcnt(0)\n\ts_barrier" ::: "memory");
                rowsel = selm[32 * th + w.r32]; umask = selm[64]; wmask = selm[65 + th];
            } else
#endif
            { rowsel = umask = wmask = (cur == 31) ? 0xffffffffu : ((1u << (cur + 1)) - 1u); }
            umask = (unsigned)__builtin_amdgcn_readfirstlane((int)umask); wmask = (unsigned)__builtin_amdgcn_readfirstlane((int)wmask);
#ifndef NSA_NO_SLC
            if (MODE == 0 || MODE >= 2) {
                St st;
#pragma nounroll
                for (int pass = 0; pass < 2; ++pass) {
                    NsaSlcMask MF; MF.rowsel = rowsel; MF.wmask = wmask; MF.diag = cur; MF.tq = tq; MF.hi = w.hi; MF.cursel = 0u; MF.curt = 0;
                    st_init(st); ++ep;
                    SeqBits ts{__builtin_popcount(umask), umask};
                    if (!run_branch(w, Pb + C_KSLC + g * 64, Pb + C_VSLC + g * 64, PW, ts, qr, MF, st, pass != 0, ep)) break;
                }
                finish_branch(w, st, g_s, oacc);
            }
#endif
#ifndef NSA_NO_WIN
            if (MODE == 0 || MODE >= 3) {
                St st;
                const int tlo = cur >= 8 ? cur - 8 : 0;
#pragma nounroll
                for (int pass = 0; pass < 2; ++pass) {
                    NsaWinMask MF; MF.tq = tq; MF.hi = w.hi; MF.tq0 = tq0; MF.curt = 0;
                    st_init(st); ++ep;
                    SeqRange ts{cur - tlo + 1, tlo};
                    if (!run_branch(w, Pb + C_KWIN + g * 64, Pb + C_VWIN + g * 64, PW, ts, qr, MF, st, pass != 0, ep)) break;
                }
                finish_branch(w, st, g_w, oacc);
            }
#endif
            if (MODE == 0) store_o(w, oacc, O + (size_t)(b * SEQ + tq0) * 1024 + head * 64, 1024); else asm volatile("" :: "v"(oacc[0]), "v"(oacc[1]));
            asm volatile("s_waitcnt lgkmcnt(0)\n\ts_barrier" ::: "memory");
        }
    }
}
__device__ __forceinline__ unsigned fkey32(float f) { const unsigned u = __float_as_uint(f + 0.0f); return (f == -INFINITY) ? 0u : ((u & 0x80000000u) ? ~u : (u | 0x80000000u)); }
__device__ __forceinline__ int wave_sum_i32(int v) {
    v += __builtin_amdgcn_update_dpp(0, v, 0xB1, 0xF, 0xF, true);
    v += __builtin_amdgcn_update_dpp(0, v, 0x4E, 0xF, 0xF, true);
    v += __builtin_amdgcn_update_dpp(0, v, 0x141, 0xF, 0xF, true);
    v += __builtin_amdgcn_update_dpp(0, v, 0x140, 0xF, 0xF, true);
    return __builtin_amdgcn_readlane(v, 0) + __builtin_amdgcn_readlane(v, 16) + __builtin_amdgcn_readlane(v, 32) + __builtin_amdgcn_readlane(v, 48);
}
__device__ __forceinline__ float wave_max_dpp(float v) {
#define WMD_STEP(CTRL) v = __builtin_fmaxf(v, __int_as_float(__builtin_amdgcn_update_dpp(__float_as_int(v), __float_as_int(v), CTRL, 0xF, 0xF, false)))
    WMD_STEP(0xB1); WMD_STEP(0x4E); WMD_STEP(0x141); WMD_STEP(0x140);
#undef WMD_STEP
    const float a = __int_as_float(__builtin_amdgcn_readlane(__float_as_int(v), 0)), b = __int_as_float(__builtin_amdgcn_readlane(__float_as_int(v), 16));
    const float c = __int_as_float(__builtin_amdgcn_readlane(__float_as_int(v), 32)), d = __int_as_float(__builtin_amdgcn_readlane(__float_as_int(v), 48));
    return __builtin_fmaxf(__builtin_fmaxf(a, b), __builtin_fmaxf(c, d));
}
__device__ __forceinline__ unsigned wave_excl_prefix(unsigned v, int lane) {
    unsigned x = v;
#pragma unroll
    for (int o = 1; o < 64; o <<= 1) { const unsigned y = __shfl_up(x, o); x += (lane >= o) ? y : 0u; }
    return x - v;
}
template <int MODE> __device__ __forceinline__ void idx_mfma(Ctx& C0) {
    Ctx C = C0; C.tid = fresh_tid(C0); C.lane = C.tid & 63; __syncthreads();
    typedef float f32x4_t __attribute__((ext_vector_type(4)));
    typedef short bf16x8 __attribute__((ext_vector_type(8)));
    constexpr int RS = 2113;
    LAS unsigned char* shm = C.lds + POOL_OFF;
    LAS unsigned char* qlds = shm;
    LAS float* scr = (LAS float*)shm;
    const bf16* P = (const bf16*)(AWS + WS_P); unsigned* DMK = (unsigned*)(AWS + WS_DMASK);
    const int G = C.G, bx = blockIdx.x, vcu = (G % 8 == 0) ? (bx % 8) * (G / 8) + bx / 8 : bx;
    for (int sl = vcu; sl < 256; sl += G) {
        const int b = sl >> 4, s16 = sl & 15;
#pragma nounroll
        for (int ui = 0; ui < 8; ++ui) {
            int tidu = fresh_tid(C0);
            const int tid = tidu, lane = tid & 63, tok = lane & 15, g = lane >> 4, wid = __builtin_amdgcn_readfirstlane(tid >> 6);
            const int q16 = ((ui & 1) ? (ui >> 1) * 32 + 31 - s16 : (ui >> 1) * 32 + s16);
            const int t = 16 * q16 + tok, nkt = (q16 >> 1) + 1;
            const bf16* Pb = P + (size_t)b * SEQ * PW;
#pragma unroll
            for (int k = 0; k < 2; ++k) { const int id = tid + 512 * k, tk = id >> 6, pc = id & 63;
                const v4u v = *(const v4u*)(Pb + (size_t)(16 * q16 + tk) * PW + C_IQ + pc * 8);
                *(LAS v4u*)(qlds + (pc * 16 + tk) * 16) = v; }
            const v4u wvp = *(const v4u*)(Pb + (size_t)t * PW + C_IW);
            asm volatile("s_waitcnt vmcnt(0) lgkmcnt(0)\n\ts_barrier" ::: "memory");
            float sv[8][8];
            bf16x8 qf[8][2];
#pragma unroll
            for (int h = 0; h < 8; ++h) { qf[h][0] = *(const LAS bf16x8*)(qlds + (g * 16 + tok) * 16 + (h * 8) * 256); qf[h][1] = *(const LAS bf16x8*)(qlds + (g * 16 + tok) * 16 + (h * 8 + 4) * 256); }
            bf16x8 ka0, ka1, kn0, kn1;
#define IDX_LOADK(d0, d1, kt_, s_) do { const bf16* krow_ = Pb + (size_t)(32 * (kt_) + 16 * (s_) + tok) * PW + C_IK + 8 * g; d0 = *(const bf16x8*)(krow_); d1 = *(const bf16x8*)(krow_ + 32); } while (0)
            if (wid < nkt) IDX_LOADK(ka0, ka1, wid, 0);
#pragma unroll
            for (int st = 0; st < 16; ++st) {
                const int j = st >> 1, s = st & 1, kt = wid + 8 * j;
                if (st + 1 < 16) { const int kt2 = wid + 8 * ((st + 1) >> 1); if (kt2 < nkt) IDX_LOADK(kn0, kn1, kt2, (st + 1) & 1); }
                if (kt < nkt) {
                    f32x4_t sc = {0.f, 0.f, 0.f, 0.f};
#pragma unroll
                    for (int h = 0; h < 8; ++h) {
                        f32x4_t acc = {0.f, 0.f, 0.f, 0.f};
                        acc = __builtin_amdgcn_mfma_f32_16x16x32_bf16(ka0, qf[h][0], acc, 0, 0, 0);
                        acc = __builtin_amdgcn_mfma_f32_16x16x32_bf16(ka1, qf[h][1], acc, 0, 0, 0);
                        const unsigned wpk = (h < 2) ? wvp.x : (h < 4) ? wvp.y : (h < 6) ? wvp.z : wvp.w; const float wh = (h & 1) ? pg8::bf_hi(wpk) : pg8::bf_lo(wpk);
#pragma unroll
                        for (int r = 0; r < 4; ++r) sc[r] = __builtin_fmaf(wh, __builtin_fmaxf(acc[r], 0.f), sc[r]);
                    }
                    const int kpos = 32 * kt + 16 * s + 4 * g;
#pragma unroll
                    for (int r = 0; r < 4; ++r) sv[j][4 * s + r] = (kpos + r <= t) ? sc[r] + 0.0f : -INFINITY;
                } else {
#pragma unroll
                    for (int r = 0; r < 4; ++r) sv[j][4 * s + r] = -INFINITY;
                }
                ka0 = kn0; ka1 = kn1;
            }
#undef IDX_LOADK
            if (q16 < 16) {
#pragma unroll
                for (int j = 0; j < 8; ++j) { const int kt = wid + 8 * j; unsigned bits = 0u;
#pragma unroll
                    for (int i = 0; i < 8; ++i) bits |= (sv[j][i] != -INFINITY) ? (1u << ((i & 3) + 8 * (i >> 2) + 4 * (g >> 1) + 16 * (g & 1))) : 0u;
                    bits |= __shfl_xor(bits, 16); bits |= __shfl_xor(bits, 32);
                    if (MODE == 0) { if (g == 0) DMK[(size_t)(b * 64 + kt) * SEQ + t] = bits; } else { asm volatile("" :: "v"(bits)); } }
                asm volatile("s_waitcnt lgkmcnt(0)\n\ts_barrier" ::: "memory");
                continue;
            }
            if (MODE == 1) { asm volatile("" :: "v"(sv[0][0]), "v"(sv[7][7])); asm volatile("s_waitcnt lgkmcnt(0)\n\ts_barrier" ::: "memory"); continue; }
            asm volatile("s_waitcnt lgkmcnt(0)\n\ts_barrier" ::: "memory");
#pragma unroll
            for (int j = 0; j < 8; ++j)
#pragma unroll
                for (int i = 0; i < 8; ++i) scr[tok * RS + 33 * (wid + 8 * j) + 16 * (i >> 2) + 4 * g + (i & 3)] = sv[j][i];
            asm volatile("s_waitcnt lgkmcnt(0)\n\ts_barrier" ::: "memory");
#pragma nounroll
            for (int tt = 0; tt < 2; ++tt) {
                const int tau = wid + 8 * tt, tq = 16 * q16 + tau;
                float v[32];
#pragma unroll
                for (int u = 0; u < 32; ++u) v[u] = scr[tau * RS + 33 * lane + u];
#define IDX_CNT(PRED, OUT) do { int c_ = 0; _Pragma("unroll") for (int u = 0; u < 32; ++u) { const float fx = v[u]; c_ += (PRED) ? 1 : 0; } OUT = wave_sum_i32(c_); } while (0)
                float mx = -INFINITY, mn = INFINITY;
#pragma unroll
                for (int u = 0; u < 32; ++u) { mx = __builtin_fmaxf(mx, v[u]); mn = (v[u] == -INFINITY) ? mn : __builtin_fminf(mn, v[u]); }
                mx = wave_max_dpp(mx); mn = -wave_max_dpp(-mn);
#define IDX_CNTLT(PIV, OUT) do { const float pb_ = (PIV) * 1.2676506002282294e30f; float a0_ = 0.f, a1_ = 0.f; \
                    _Pragma("unroll") for (int u = 0; u < 32; u += 2) { a0_ += __builtin_amdgcn_fmed3f(__builtin_fmaf(v[u], -1.2676506002282294e30f, pb_), 0.f, 1.f); a1_ += __builtin_amdgcn_fmed3f(__builtin_fmaf(v[u + 1], -1.2676506002282294e30f, pb_), 0.f, 1.f); } \
                    OUT = wave_sum_i32((int)(a0_ + a1_)); } while (0)
                int cp, c0;
                {
                    float ap = 0.f, an = 0.f;
#pragma unroll
                    for (int u = 0; u < 32; ++u) { ap += __builtin_amdgcn_fmed3f(v[u] * 1.2676506002282294e30f, 0.f, 1.f); an += __builtin_amdgcn_fmed3f(v[u] * -1.2676506002282294e30f, 0.f, 1.f); }
                    cp = wave_sum_i32((int)ap); c0 = 2048 - wave_sum_i32((int)an);
                    if (cp == 256) { int ce; IDX_CNT(fx > 0.f, ce); cp = ce; }
                }
                float thr = 0.f, tv = 0.f; int need = 0; bool tie = false, done = false, strict = false;
                float lo, hi_, clo, chi, wprev = INFINITY;
                if (cp >= 256) { lo = 0.f; hi_ = mx; clo = (float)cp; chi = 1.f; if (cp == 256) { done = true; strict = true; thr = 0.f; } }
                else if (c0 < 256) { lo = mn; hi_ = 0.f; clo = (float)(tq + 1); chi = (float)c0; }
                else { lo = hi_ = clo = chi = 0.f; tie = true; tv = 0.f; need = 256 - cp; done = true; }
#pragma nounroll
                for (int rd = 0; rd < 64 && !done; ++rd) {
                    const float wdt = hi_ - lo, fi = __builtin_fminf(__builtin_fmaxf((clo - 256.5f) / (clo - chi), 0.02f), 0.98f);
                    const float frac = ((rd & 1) && wdt > 0.5f * wprev) ? 0.5f : fi;
                    if (!(rd & 1)) wprev = wdt;
                    const float mid = lo + wdt * frac;
                    if (!(mid > lo) || !(mid < hi_)) {
                        int cg; IDX_CNT(fx >= hi_, cg); tie = true; done = true; need = 256 - cg;
                        float below = -INFINITY;
#pragma unroll
                        for (int u = 0; u < 32; ++u) below = (v[u] < hi_) ? __builtin_fmaxf(below, v[u]) : below;
                        tv = wave_max_dpp(below);
                        break; }
                    int c; { int clt; IDX_CNTLT(mid, clt); c = 2048 - clt; }
                    if (c == 256) { int ce; IDX_CNT(fx >= mid, ce); c = ce; }
                    if (c == 256) { done = true; thr = mid; } else if (c > 256) { lo = mid; clo = (float)c; } else { hi_ = mid; chi = (float)c; }
                }
                bool redo = !done;
                if (tie && !redo) { int cgt, ceq; IDX_CNT(fx > tv, cgt); IDX_CNT(fx == tv, ceq); need = 256 - cgt; redo = (need < 1 || need > ceq); }
                if (__builtin_expect(redo, 0)) {
                    unsigned T = 0u;
#pragma nounroll
                    for (int bit = 31; bit >= 0; --bit) { const unsigned cand = T | (1u << bit); int c; IDX_CNT(fkey32(fx) >= cand, c); if (c >= 256) T = cand; }
                    tv = __uint_as_float((T & 0x80000000u) ? (T ^ 0x80000000u) : ~T); tie = true; strict = false;
                    int cgt; IDX_CNT(fx > tv, cgt); need = 256 - cgt;
                }
                unsigned word = 0u;
                if (!tie) {
#pragma unroll
                    for (int u = 0; u < 32; ++u) word |= ((strict ? v[u] > thr : v[u] >= thr)) ? (1u << ((u & 3) + 4 * (u >> 3) + 16 * ((u >> 2) & 1))) : 0u;
                } else {
                    unsigned nt = 0u;
#pragma unroll
                    for (int u = 0; u < 32; ++u) nt += (v[u] == tv) ? 1u : 0u;
                    unsigned rank = wave_excl_prefix(nt, lane);
#pragma unroll
                    for (int u = 0; u < 32; ++u) { const bool eq = (v[u] == tv); const bool sel = (v[u] > tv) || (eq && (int)rank < need); rank += eq ? 1u : 0u;
                        word |= sel ? (1u << ((u & 3) + 4 * (u >> 3) + 16 * ((u >> 2) & 1))) : 0u; }
                }
                DMK[(size_t)(b * 64 + lane) * SEQ + tq] = word;
#undef IDX_CNT
#undef IDX_CNTLT
            }
            asm volatile("s_waitcnt lgkmcnt(0)\n\ts_barrier" ::: "memory");
        }
    }
}
__device__ __forceinline__ void compress_mfma(Ctx& C0, int l) {
    Ctx C = C0; C.tid = fresh_tid(C0); C.lane = C.tid & 63; __syncthreads();
    typedef float f32x16 __attribute__((ext_vector_type(16)));
    typedef short bf16x8 __attribute__((ext_vector_type(8)));
    LAS float* hidp = (LAS float*)(C.lds + POOL_OFF);
    LAS float* hid = hidp + 2 * 32 * 132;
    const bf16* P = (const bf16*)(AWS + WS_P);
    const int lane = C.lane, r32 = lane & 31, hi = lane >> 5, wid = C.wave, nb = wid & 3, kh = wid >> 2;
    for (int u = blockIdx.x; u < 256; u += C.G) {
        const int kv = u >> 7, b = (u >> 3) & 15, g = (u >> 2) & 1, mb = u & 3, c0 = 32 * mb;
        const int crow_ = (c0 + r32 < 127) ? c0 + r32 : 126;
        const bf16* arow = P + (size_t)(b * SEQ + 16 * crow_) * PW + (kv ? C_VCMP : C_KCMP) + g * 64 + 8 * hi;
        const bf16* brow = (const bf16*)(AWS + WS_W1B) + ((size_t)(l * 2 + kv) * 128 + 32 * nb + r32) * 2048 + 1024 * kh + 8 * hi;
        f32x16 acc = f32x16{};
#pragma unroll 8
        for (int kk = 0; kk < 64; ++kk) {
            const int k = 1024 * kh + 16 * kk;
            const bf16x8 a = *(const bf16x8*)(arow + (size_t)(k >> 6) * PW + (k & 63));
            const bf16x8 bq = *(const bf16x8*)(brow + 16 * kk);
            acc = __builtin_amdgcn_mfma_f32_32x32x16_bf16(a, bq, acc, 0, 0, 0);
        }
        __syncthreads();
#pragma unroll
        for (int i = 0; i < 16; ++i) hidp[(kh * 32 + (i & 3) + 8 * (i >> 2) + 4 * hi) * 132 + 32 * nb + r32] = acc[i];
        __syncthreads();
        LAS float* cb1 = hid + 32 * 132;
        if (C.tid < 128) { const float* cp = (const float*)(AWS + WS_CB1) + (size_t)(l * 2 + kv) * 64 * 128 + C.tid; float a = AIN(kv ? 10 : 5)[l * 128 + C.tid];
            for (int ks = 0; ks < 64; ++ks) a += cp[ks * 128];
            cb1[C.tid] = a; }
        __syncthreads();
        for (int e = C.tid; e < 32 * 128; e += NTHR) { const int c = e >> 7, n = e & 127; hid[c * 132 + n] = gelu_tanh(hidp[c * 132 + n] + hidp[(32 + c) * 132 + n] + cb1[n]); }
        __syncthreads();
        {
            const float* w2 = AIN(kv ? 11 : 6) + (size_t)l * 128 * 64; const float* b2 = AIN(kv ? 12 : 7) + l * 64;
            const int c = C.tid >> 4, d4 = (C.tid & 15) * 4;
            f32x4 a = *(const f32x4*)(b2 + d4);
            for (int n = 0; n < 128; ++n) a += hid[c * 132 + n] * *(const f32x4*)(w2 + n * 64 + d4);
            if (c0 + c >= 127) a = (f32x4){0.f, 0.f, 0.f, 0.f};
            const size_t o = ((size_t)((kv * NB + b) * 2 + g) * 128 + c0 + c) * 64 + d4;
            *(f32x4*)((float*)(AWS + WS_KC) + o) = a;
            *(unsigned long long*)((bf16*)(AWS + WS_KCB) + o) = (unsigned long long)pk2(a.x, a.y) | ((unsigned long long)pk2(a.z, a.w) << 32);
        }
    }
    __syncthreads();
}
#ifndef MK_N_LAUNCHES
#define MK_N_LAUNCHES 1
#endif
constexpr int NPH = 18;
constexpr int N_LAUNCHES = MK_N_LAUNCHES;
#define GRID_BAR() do { if (N_LAUNCHES == 1) { XcdBarrier bar_; bar_.bar = (unsigned*)((gu32*)(AWS + WS_CTL) + CW_BAR); bar_.x = xb_xcc_id(); bar_.st = (volatile LAS unsigned*)(C.lds + MISC_OFF) + 8; xcd_barrier(bar_); } } while (0)
#define lo (kargs()->ph_lo)
#define hi (kargs()->ph_hi)
#ifndef REP_PHASE
#define REP_PHASE -1
#endif
#ifndef PH_EN
#define PH_EN 0xFFFFFFFFu
#endif
#define IN(k) (((PH_EN >> ((k) > 8 ? ((k) - 8 > 8 ? 17 : (k) - 8) : (k))) & 1u) && lo <= (k) && (k) < hi)
#define BOTH(k) (IN(k) && IN((k) + 1))
#define RING (C.lds + POOL_OFF)
#define XG_ ((bf16*)(AWS + WS_R1))
#define OB_ ((bf16*)AOUT)
#define P_ ((bf16*)(AWS + WS_P))
#define H_ ((bf16*)(AWS + WS_P))
#define RSS_ ((float*)(AWS + WS_RSS))
#define RCOS_ ((const float*)(AWS + WS_ROPE))

template <int l> __device__ __forceinline__ void layer_phases(Ctx& C) {
        const int pb = 1 + 8 * l;
        if (IN(pb)) {
            pg8::Gemm g{XG_, (const bf16*)(AWS + WS_WIN + l * SZ_WIN), MTOK, PW, DM, DM, DM, nullptr, nullptr}; pg8::StaticOrder S; S.init(MTOK, PW, C.G, (int)blockIdx.x);
            pg8::EpiProj E{P_, RSS_, RCOS_};
            pg8::gemm_phase<pg8::EpiProj, pg8::StaticOrder, true, true>(RING, g, S, E, C.wave);
            if (REP_PHASE == 1) pg8::gemm_phase<pg8::EpiProj, pg8::StaticOrder, true, true>(RING, g, S, E, C.wave);
            if (BOTH(pb)) GRID_BAR();
        }
        if (IN(pb + 1)) { compress_mfma(C, l); if (REP_PHASE == 2) compress_mfma(C, l); idx_mfma<0>(C); if (REP_PHASE == 3) idx_mfma<0>(C); if (REP_PHASE == 31) idx_mfma<1>(C); if (BOTH(pb + 1)) GRID_BAR(); }
        if (IN(pb + 2)) { nsa_mfma<0>(C); if (REP_PHASE == 4) nsa_mfma<0>(C); if (REP_PHASE == 41) nsa_mfma<1>(C); if (REP_PHASE == 42) nsa_mfma<2>(C); dsa_mfma(C); if (REP_PHASE == 5) dsa_mfma(C); if (BOTH(pb + 2)) GRID_BAR(); }
        if (IN(pb + 3)) {
            pg8::Gemm g{OB_, (const bf16*)(AWS + WS_WBN + l * SZ_WBR), MTOK, DM, 512, DM, 512, OB_ + 512, (const bf16*)(AWS + WS_WBD + l * SZ_WBR)}; pg8::DualOrder S; S.init(MTOK, DM, C.G, (int)blockIdx.x);
            pg8::EpiBranch2 E{P_, C_GN, C_GD, C_TMP, C_MRG};
            pg8::gemm_phase<pg8::EpiBranch2, pg8::DualOrder, true, true>(RING, g, S, E, C.wave);
            if (BOTH(pb + 3)) GRID_BAR();
        }
        if (IN(pb + 4)) { }
        if (IN(pb + 5)) {
            pg8::Gemm g{P_ + C_MRG, (const bf16*)(AWS + WS_WOUT + l * SZ_WOUT), MTOK, DM, DM, PW, DM, nullptr, nullptr}; pg8::StaticOrder S; S.init(MTOK, DM, C.G, (int)blockIdx.x);
            pg8::EpiResid E{XG_, RSS_};
            pg8::gemm_phase<pg8::EpiResid, pg8::StaticOrder, true, true>(RING, g, S, E, C.wave);
            if (BOTH(pb + 5)) GRID_BAR();
        }
        if (IN(pb + 6)) {
            pg8::Gemm g{XG_, (const bf16*)(AWS + WS_WGU + l * SZ_WGU), MTOK, PW, DM, DM, DM, nullptr, nullptr}; pg8::StaticOrder S; S.init(MTOK, PW, C.G, (int)blockIdx.x);
            pg8::EpiSwiglu E{H_, RSS_};
            pg8::gemm_phase<pg8::EpiSwiglu, pg8::StaticOrder, true, true>(RING, g, S, E, C.wave);
            if (REP_PHASE == 7) pg8::gemm_phase<pg8::EpiSwiglu, pg8::StaticOrder, true, true>(RING, g, S, E, C.wave);
            if (BOTH(pb + 6)) GRID_BAR();
        }
        if (IN(pb + 7)) {
            pg8::Gemm g{H_, (const bf16*)(AWS + WS_WDN + l * SZ_WDN), MTOK, DM, DFF, DFF, DFF, nullptr, nullptr}; pg8::StaticOrder S; S.init(MTOK, DM, C.G, (int)blockIdx.x);
            pg8::EpiResid E{XG_, RSS_};
            pg8::gemm_phase<pg8::EpiResid, pg8::StaticOrder, true, true>(RING, g, S, E, C.wave);
            if (BOTH(pb + 7)) GRID_BAR();
        }
}
__global__ void __launch_bounds__(NTHR, 2) hybrid_fwd(Args args) {
    extern __shared__ __attribute__((aligned(16))) unsigned char lds_raw[];
    Ctx C;
    C.lds = (LAS unsigned char*)lds_raw; C.tid = threadIdx.x; C.lane = 0; C.wave = __builtin_amdgcn_readfirstlane((int)threadIdx.x >> 6); C.G = gridDim.x;
    for (int u = C.tid; u < POOL_OFF / 4; u += NTHR) ((LAS unsigned*)(C.lds + LDSCTL_OFF))[u] = 0u;
    __syncthreads();
    if (N_LAUNCHES == 1) (void)xcd_barrier_post((unsigned*)((gu32*)(AWS + WS_CTL) + CW_BAR), (volatile LAS unsigned*)(C.lds + MISC_OFF) + 8);
    if (IN(0)) { p0_prologue(C); if (REP_PHASE == 0) p0_prologue(C); if (BOTH(0)) GRID_BAR(); }
    layer_phases<0>(C);
    layer_phases<1>(C);
    if (IN(17)) final_norm(C);
#ifdef IDX_DIAG
    if (IN(17)) { __syncthreads(); const unsigned nfb = __hip_atomic_load((unsigned*)(AWS + WS_CTL) + 2048, __ATOMIC_RELAXED, __HIP_MEMORY_SCOPE_AGENT); if (nfb > IDX_DIAG && blockIdx.x == 0) { AOUT[C.tid] = __builtin_nanf(""); } }
#endif
#undef IN
#undef BOTH
#undef lo
#undef hi
}

extern "C" void kernel_launch(void* const* d_in, const int* in_sizes, int n_in, void* d_out, int out_size, void* d_ws, size_t ws_size, hipStream_t stream) {
    static int grid = 0;
    if (grid == 0) {
        if (n_in != 21 || out_size != MTOK * DM || ws_size < WS_END) { fprintf(stderr, "kernel_launch: unexpected shapes (n_in %d out %d ws %zu)\n", n_in, out_size, ws_size); grid = -1; return; }
        int dev = 0, cus = 0, per_cu = 0;
        if (hipGetDevice(&dev) != hipSuccess || hipDeviceGetAttribute(&cus, hipDeviceAttributeMultiprocessorCount, dev) != hipSuccess) { grid = -1; return; }
        if (hipFuncSetAttribute((const void*)hybrid_fwd, hipFuncAttributeMaxDynamicSharedMemorySize, LDS_BYTES) != hipSuccess) { fprintf(stderr, "kernel_launch: hipFuncSetAttribute failed\n"); grid = -1; return; }
        if (hipOccupancyMaxActiveBlocksPerMultiprocessor(&per_cu, (const void*)hybrid_fwd, NTHR, LDS_BYTES) != hipSuccess || per_cu < 1) fprintf(stderr, "kernel_launch: occupancy query reports %d\n", per_cu);
        (void)hipGetLastError();
        grid = cus;
    }
    if (grid < 0) return;
    (void)hipMemsetAsync((char*)d_ws + WS_CTL, 0, CTL_ZERO_BYTES, stream);
    Args a{};
    for (int i = 0; i < 21; ++i) a.in[i] = (const float*)d_in[i];
    a.out = (float*)d_out; a.ws = (unsigned char*)d_ws;
    for (int li = 0; li < N_LAUNCHES; ++li) {
        a.ph_lo = (N_LAUNCHES == 1) ? 0 : li; a.ph_hi = (N_LAUNCHES == 1) ? NPH : li + 1; a.li = li;
        hipLaunchKernelGGL(hybrid_fwd, dim3(grid), dim3(NTHR), LDS_BYTES, stream, a);
    }
}
```

```cpp
#include <hip/hip_runtime.h>
#include <cstdio>
#include <cstdint>
namespace pg8 {
#define PG8_LAS __attribute__((address_space(3)))
typedef unsigned short bf16_t;
typedef short bf16x8 __attribute__((ext_vector_type(8)));
typedef float f32x4 __attribute__((ext_vector_type(4)));
typedef unsigned u32x4 __attribute__((ext_vector_type(4)));
constexpr int BM = 256, BK = 64, HALF = 128, HTB = HALF * BK * 2  , STAGE_BYTES = 8 * HTB, NXCD = 8, WGM = 8;

__host__ __device__ __forceinline__ int lds_byte(int r, int c) { const int st = (r >> 4) * 2 + (c >> 5), rr = r & 15, cc = c & 31, ob = rr * 64 + cc * 2; return st * 1024 + (ob ^ (((ob >> 9) & 1) << 5)); }
__host__ __device__ __forceinline__ void stage_rc(int b, int& R, int& C) { const int st = b / 1024, sb = b % 1024, swz = sb ^ (((sb >> 9) & 1) << 5); R = (st >> 1) * 16 + swz / 64; C = (st & 1) * 32 + (swz % 64) / 2; }
__host__ __device__ __forceinline__ int perm32(int rho) { const int n = rho >> 4, i = rho & 15; return 8 * (i >> 2) + 4 * n + (i & 3); }

struct Unit { int pm, pn, z; };
struct Gemm { const bf16_t* A; const bf16_t* Bt; int M, N, K, lda, ldb; const bf16_t* A2; const bf16_t* Bt2; };

struct StaticOrder {
    int nM, nN, nwg, G, c;
    __host__ __device__ void init(int M, int N, int G_, int c_) { nM = M / BM; nN = N / BM; nwg = nM * nN; G = G_; c = c_; }
    __host__ __device__ bool next(int i, Unit& u) const {
        const long L = (long)i * G + c; if (L >= nwg) return false;
        int wgid = (int)L; { const int q = nwg / NXCD, r = nwg % NXCD, xcd = wgid % NXCD, off = wgid / NXCD; wgid = (xcd < r ? xcd * (q + 1) : r * (q + 1) + (xcd - r) * q) + off; }
        const int nig = WGM * nN, gid = wgid / nig, fm = gid * WGM, gsz = (nM - fm) < WGM ? (nM - fm) : WGM;
        u.pm = fm + ((wgid % nig) % gsz); u.pn = (wgid % nig) / gsz; u.z = 0; return true;
    }
    __device__ __forceinline__ void a_ready(const Unit&) const {}
    __device__ __forceinline__ void done(const Unit&) const {}
};
struct DualOrder {
    StaticOrder S;
    __host__ __device__ void init(int M, int N, int G_, int c_) { S.init(M, N, G_, c_); }
    __host__ __device__ bool next(int i, Unit& u) const { if (!S.next(i >> 1, u)) return false; u.z = i & 1; return true; }
    __device__ __forceinline__ void a_ready(const Unit&) const {}
    __device__ __forceinline__ void done(const Unit&) const {}
};

__device__ __forceinline__ unsigned cvt_pk_bf16(float lo, float hi) { unsigned r; asm volatile("v_cvt_pk_bf16_f32 %0, %1, %2" : "=v"(r) : "v"(lo), "v"(hi)); return r; }
__device__ __forceinline__ float bf_lo(unsigned w) { return __uint_as_float(w << 16); }
__device__ __forceinline__ float bf_hi(unsigned w) { return __uint_as_float(w & 0xffff0000u); }
__device__ __forceinline__ float sigmoidf_(float x) { return __builtin_amdgcn_rcpf(1.0f + __builtin_amdgcn_exp2f(x * -1.4426950408889634f)); }
constexpr int PW = 5632;
constexpr float RMS_EPS = 1e-6f;
__device__ __forceinline__ float row_rstd(const float* rowss, int row) {
    const f32x4* p = (const f32x4*)(rowss + (size_t)row * 16);
    const f32x4 a = p[0], b = p[1], c = p[2], d = p[3];
    const float s = ((a[0] + a[1]) + (a[2] + a[3])) + ((b[0] + b[1]) + (b[2] + b[3])) + ((c[0] + c[1]) + (c[2] + c[3])) + ((d[0] + d[1]) + (d[2] + d[3]));
    float eps; asm volatile("s_mov_b32 %0, 0x358637bd" : "=s"(eps));
    return __builtin_amdgcn_rsqf(s * (1.0f / 1024.0f) + eps);
}
__device__ __forceinline__ int erow(int r) { return (r >> 2) * HALF + (r & 3) * 16; }
__device__ __forceinline__ float rstd_quarter(const f32x4 a) {
    float s = (a[0] + a[1]) + (a[2] + a[3]);
    s += __shfl_xor(s, 16); s += __shfl_xor(s, 32);
    float eps; asm volatile("s_mov_b32 %0, 0x358637bd" : "=s"(eps));
    return __builtin_amdgcn_rsqf(s * (1.0f / 1024.0f) + eps);
}
struct EpiProj {
    static constexpr bool PERM = true, AFTER_DRAIN = false;
    bf16_t* P; const float* rowss; const float* rtab;
    __device__ __forceinline__ void operator()(const f32x4 (&acc)[2][2][4][2], const Unit& u, int wr, int wc, int fr, int fq) const {
        const int pn = u.pn;
        const bool rope_head = (pn <= 1) || (pn >= 5 && pn <= 8) || (pn == 11) || (pn == 12) || ((pn >= 2 && pn <= 4) && wc < 2) || (pn == 13 && wc == 0);
        const int row0 = u.pm * BM + wr * 64 + fr;
        f32x4 q[8], tq[8];
        { const float* rq = rowss + (size_t)row0 * 16 + fq * 4;
#pragma unroll
          for (int r = 0; r < 8; ++r) q[r] = *(const f32x4*)(rq + erow(r) * 16); }
        if (rope_head) {
            const float* tb = rtab + (size_t)(row0 & 2047) * 16 + fq * 4;
#pragma unroll
            for (int r = 0; r < 8; ++r) tq[r] = *(const f32x4*)(tb + erow(r) * 16);
        }
        float rsv[8];
        { const float qs = (pn <= 1 || pn == 5 || pn == 6) ? 0.18033688011112042f : 1.0f;
#pragma unroll
          for (int r = 0; r < 8; ++r) rsv[r] = rstd_quarter(q[r]) * qs; }
#pragma unroll
        for (int ai = 0; ai < 2; ++ai)
#pragma unroll
            for (int m = 0; m < 4; ++m) {
                const int r = ai * 4 + m, row = row0 + erow(r);
                const float rs = rsv[r];
#pragma unroll
                for (int bj = 0; bj < 2; ++bj) {
                    f32x4 v0 = acc[ai][bj][m][0] * rs, v1 = acc[ai][bj][m][1] * rs;
                    if (rope_head && bj == 0) {
                        f32x4 c0, c1, s0, s1, p0, p1;
#pragma unroll
                        for (int e = 0; e < 4; ++e) { c0[e] = __shfl(tq[r][e], fr); c1[e] = __shfl(tq[r][e], fr + 16); s0[e] = __shfl(tq[r][e], fr + 32); s1[e] = __shfl(tq[r][e], fr + 48); }
#pragma unroll
                        for (int e = 0; e < 4; ++e) { p0[e] = __shfl_xor(v0[e], 16); p1[e] = __shfl_xor(v1[e], 16); }
                        if (fq == 0) { v0 = v0 * c0 - p0 * s0; v1 = v1 * c1 - p1 * s1; }
                        else if (fq == 1) { v0 = v0 * c0 + p0 * s0; v1 = v1 * c1 + p1 * s1; }
                    }
                    if (pn >= 14) {
#pragma unroll
                        for (int e = 0; e < 4; ++e) { v0[e] = sigmoidf_(v0[e]); v1[e] = sigmoidf_(v1[e]); }
                    } else if (pn == 13 && wc == 1 && bj == 0) {
                        if (fq == 0) { v0 = v0 * 0.044194173824159216f; v1 = v1 * 0.044194173824159216f; }
                        else {
#pragma unroll
                            for (int e = 0; e < 4; ++e) { v0[e] = sigmoidf_(v0[e]); v1[e] = sigmoidf_(v1[e]); }
                        }
                    }
                    u32x4 w; w.x = cvt_pk_bf16(v0[0], v0[1]); w.y = cvt_pk_bf16(v0[2], v0[3]); w.z = cvt_pk_bf16(v1[0], v1[1]); w.w = cvt_pk_bf16(v1[2], v1[3]);
                    *(u32x4*)(P + (size_t)row * PW + pn * BM + wc * 64 + bj * 32 + 8 * fq) = w;
                }
            }
    }
};
struct EpiNull { static constexpr bool PERM = true, AFTER_DRAIN = false;
    __device__ __forceinline__ void operator()(const f32x4 (&acc)[2][2][4][2], const Unit&, int, int, int, int) const {
#pragma unroll
        for (int a = 0; a < 2; ++a)
#pragma unroll
            for (int b = 0; b < 2; ++b)
#pragma unroll
                for (int m = 0; m < 4; ++m) asm volatile("" :: "v"(acc[a][b][m][0]), "v"(acc[a][b][m][1])); } };
struct EpiBranch2 {
    static constexpr bool PERM = true, AFTER_DRAIN = false;
    bf16_t* Pb; int cg0, cg1, ct, co;
    __device__ __forceinline__ void operator()(const f32x4 (&acc)[2][2][4][2], const Unit& u, int wr, int wc, int fr, int fq) const {
        const int cg = u.z ? cg1 : cg0, cst = u.z ? co : ct;
        bf16_t* p0 = Pb + (size_t)(u.pm * BM + wr * 64 + fr) * PW + u.pn * BM + wc * 64 + 8 * fq;
        u32x4 gw[8][2], tw[2][2];
#pragma unroll
        for (int r = 0; r < 8; ++r)
#pragma unroll
            for (int bj = 0; bj < 2; ++bj) gw[r][bj] = __builtin_nontemporal_load((const u32x4*)(p0 + (size_t)erow(r) * PW + bj * 32 + cg));
        if (u.z) {
#pragma unroll
            for (int r = 0; r < 2; ++r)
#pragma unroll
                for (int bj = 0; bj < 2; ++bj) tw[r][bj] = *(const u32x4*)(p0 + (size_t)erow(r) * PW + bj * 32 + ct);
        }
#pragma unroll
        for (int ai = 0; ai < 2; ++ai)
#pragma unroll
            for (int m = 0; m < 4; ++m) {
                const int r = ai * 4 + m;
                u32x4 w[2];
#pragma unroll
                for (int bj = 0; bj < 2; ++bj) {
                    const u32x4 g = gw[r][bj];
                    f32x4 v0 = acc[ai][bj][m][0], v1 = acc[ai][bj][m][1];
                    v0[0] *= bf_lo(g.x); v0[1] *= bf_hi(g.x); v0[2] *= bf_lo(g.y); v0[3] *= bf_hi(g.y);
                    v1[0] *= bf_lo(g.z); v1[1] *= bf_hi(g.z); v1[2] *= bf_lo(g.w); v1[3] *= bf_hi(g.w);
                    if (u.z) { const u32x4 t = tw[r & 1][bj];
                        v0[0] += bf_lo(t.x); v0[1] += bf_hi(t.x); v0[2] += bf_lo(t.y); v0[3] += bf_hi(t.y);
                        v1[0] += bf_lo(t.z); v1[1] += bf_hi(t.z); v1[2] += bf_lo(t.w); v1[3] += bf_hi(t.w); }
                    w[bj].x = cvt_pk_bf16(v0[0], v0[1]); w[bj].y = cvt_pk_bf16(v0[2], v0[3]); w[bj].z = cvt_pk_bf16(v1[0], v1[1]); w[bj].w = cvt_pk_bf16(v1[2], v1[3]);
                }
                if (u.z && r + 2 < 8) {
#pragma unroll
                    for (int bj = 0; bj < 2; ++bj) tw[r & 1][bj] = *(const u32x4*)(p0 + (size_t)erow(r + 2) * PW + bj * 32 + ct);
                }
#pragma unroll
                for (int bj = 0; bj < 2; ++bj) *(u32x4*)(p0 + (size_t)erow(r) * PW + bj * 32 + cst) = w[bj];
            }
    }
};
struct EpiResid {
    static constexpr bool PERM = true, AFTER_DRAIN = false;
    bf16_t* X; float* ss;
    __device__ __forceinline__ void operator()(const f32x4 (&acc)[2][2][4][2], const Unit& u, int wr, int wc, int fr, int fq) const {
        const int row0 = u.pm * BM + wr * 64 + fr;
        bf16_t* px0 = X + (size_t)row0 * 1024 + u.pn * BM + wc * 64 + 8 * fq;
        u32x4 xw[8][2];
#pragma unroll
        for (int r = 0; r < 8; ++r)
#pragma unroll
            for (int bj = 0; bj < 2; ++bj) xw[r][bj] = *(const u32x4*)(px0 + (size_t)erow(r) * 1024 + bj * 32);
#pragma unroll
        for (int ai = 0; ai < 2; ++ai)
#pragma unroll
            for (int m = 0; m < 4; ++m) {
                const int r = ai * 4 + m;
                float q = 0.f;
#pragma unroll
                for (int bj = 0; bj < 2; ++bj) {
                    const u32x4 x = xw[r][bj];
                    f32x4 v0 = acc[ai][bj][m][0], v1 = acc[ai][bj][m][1];
                    v0[0] += bf_lo(x.x); v0[1] += bf_hi(x.x); v0[2] += bf_lo(x.y); v0[3] += bf_hi(x.y);
                    v1[0] += bf_lo(x.z); v1[1] += bf_hi(x.z); v1[2] += bf_lo(x.w); v1[3] += bf_hi(x.w);
                    q += ((v0[0] * v0[0] + v0[1] * v0[1]) + (v0[2] * v0[2] + v0[3] * v0[3])) + ((v1[0] * v1[0] + v1[1] * v1[1]) + (v1[2] * v1[2] + v1[3] * v1[3]));
                    u32x4 w; w.x = cvt_pk_bf16(v0[0], v0[1]); w.y = cvt_pk_bf16(v0[2], v0[3]); w.z = cvt_pk_bf16(v1[0], v1[1]); w.w = cvt_pk_bf16(v1[2], v1[3]);
                    *(u32x4*)(px0 + (size_t)erow(r) * 1024 + bj * 32) = w;
                }
                q += __shfl_xor(q, 16); q += __shfl_xor(q, 32);
                if (fq == 0) ss[(size_t)(row0 + erow(r)) * 16 + u.pn * 4 + wc] = q;
            }
    }
};
struct EpiSwiglu {
    static constexpr bool PERM = true, AFTER_DRAIN = false;
    bf16_t* H; const float* rowss;
    __device__ __forceinline__ void operator()(const f32x4 (&acc)[2][2][4][2], const Unit& u, int wr, int wc, int fr, int fq) const {
        const int row0 = u.pm * BM + wr * 64 + fr;
        f32x4 q[8];
        { const float* rq = rowss + (size_t)row0 * 16 + fq * 4;
#pragma unroll
          for (int r = 0; r < 8; ++r) q[r] = *(const f32x4*)(rq + erow(r) * 16); }
        float rsv[8];
#pragma unroll
        for (int r = 0; r < 8; ++r) rsv[r] = rstd_quarter(q[r]);
#pragma unroll
        for (int ai = 0; ai < 2; ++ai)
#pragma unroll
            for (int m = 0; m < 4; ++m) {
                const int r = ai * 4 + m, row = row0 + erow(r);
                const float rs = rsv[r];
                float o[8];
#pragma unroll
                for (int n = 0; n < 2; ++n)
#pragma unroll
                    for (int e = 0; e < 4; ++e) { const float g = acc[ai][0][m][n][e] * rs, uu = acc[ai][1][m][n][e] * rs; o[n * 4 + e] = g * sigmoidf_(g) * uu; }
                u32x4 w; w.x = cvt_pk_bf16(o[0], o[1]); w.y = cvt_pk_bf16(o[2], o[3]); w.z = cvt_pk_bf16(o[4], o[5]); w.w = cvt_pk_bf16(o[6], o[7]);
                *(u32x4*)(H + (size_t)row * 2816 + u.pn * HALF + wc * 32 + 8 * fq) = w;
            }
    }
};
template <class Epi, class Sched, bool ALIGN_EPI = false, bool SP2 = false>
__device__ __forceinline__ void gemm_phase(PG8_LAS unsigned char* lds, const Gemm g, const Sched& S, const Epi& E, int wave_in) {
    int tid_; asm volatile("v_mbcnt_lo_u32_b32 %0, -1, 0\n\tv_mbcnt_hi_u32_b32 %0, -1, %0" : "=v"(tid_)); tid_ += wave_in * 64;
    const int tid = tid_, wid = __builtin_amdgcn_readfirstlane(tid >> 6), lane = tid & 63, wr = wid >> 2, wc = wid & 3, fr = lane & 15, fq = lane >> 4;
    const int K = g.K, nt = K / BK;
    unsigned voffA[2], voffB[2];
#pragma unroll
    for (int i = 0; i < 2; ++i) { int R, C; stage_rc(tid * 16 + i * 8192, R, C); const int Rb = Epi::PERM ? ((R & ~31) + perm32(R & 31)) : R;
        voffA[i] = (unsigned)(R * g.lda + C) * 2u; voffB[i] = (unsigned)(Rb * g.ldb + C) * 2u; }
    const size_t kstep = (size_t)(BK * 2);
    const size_t hstepA = (size_t)HALF * g.lda * 2, hstepB = (size_t)HALF * g.ldb * 2;
    const size_t tstepA = 2 * hstepA, tstepB = 2 * hstepB;
    const unsigned ldsw = (unsigned)wid * 1024u;
    const int aoff = lds_byte(wr * 64 + fr, fq * 8), boff = lds_byte(wc * 32 + fr, fq * 8);
#define PG8_SA(b, h) (((b) * 2 + (h)) * HTB)
#define PG8_SB(b, h) ((4 + (b) * 2 + (h)) * HTB)
#define PG8_STAGE(bufoff, gbase, voff) do { _Pragma("unroll") for (int _i = 0; _i < 2; ++_i) \
        __builtin_amdgcn_global_load_lds((const unsigned*)((const char*)(gbase) + (voff)[_i]), (PG8_LAS unsigned*)(lds + (bufoff) + ldsw + _i * 8192), 16, 0, 0); } while (0)
#define PG8_LDA(dst, b, h) do { _Pragma("unroll") for (int m = 0; m < 4; ++m) _Pragma("unroll") for (int k = 0; k < 2; ++k) dst[m][k] = *(const PG8_LAS bf16x8*)(lds + PG8_SA(b, h) + aoff + m * 2048 + k * 1024); } while (0)
#define PG8_LDB(dst, b, h) do { _Pragma("unroll") for (int n = 0; n < 2; ++n) _Pragma("unroll") for (int k = 0; k < 2; ++k) dst[n][k] = *(const PG8_LAS bf16x8*)(lds + PG8_SB(b, h) + boff + n * 2048 + k * 1024); } while (0)
#define PG8_MMA(ai, bj, At, Bt) do { __builtin_amdgcn_s_setprio(1); _Pragma("unroll") for (int m = 0; m < 4; ++m) _Pragma("unroll") for (int n = 0; n < 2; ++n) _Pragma("unroll") for (int k = 0; k < 2; ++k) \
        acc[ai][bj][m][n] = __builtin_amdgcn_mfma_f32_16x16x32_bf16(Bt[n][k], At[m][k], acc[ai][bj][m][n], 0, 0, 0); __builtin_amdgcn_s_setprio(0); } while (0)
#define PG8_WAIT_V(n) asm volatile("s_waitcnt vmcnt(" #n ")" ::: "memory")
#define PG8_WAIT_L(n) asm volatile("s_waitcnt lgkmcnt(" #n ")" ::: "memory")
#define PG8_BAR __builtin_amdgcn_s_barrier()
#define PG8_SCHED __builtin_amdgcn_sched_barrier(0)
    Unit cur, nxt; int ui = 0;
    if (!S.next(0, cur)) return;
    f32x4 acc[2][2][4][2];
#pragma unroll
    for (int a = 0; a < 2; ++a)
#pragma unroll
        for (int b = 0; b < 2; ++b)
#pragma unroll
            for (int m = 0; m < 4; ++m)
#pragma unroll
                for (int n = 0; n < 2; ++n) acc[a][b][m][n] = (f32x4){0.f, 0.f, 0.f, 0.f};
    bf16x8 At[4][2], B0[2][2], B1[2][2];
    const long dA2 = (const char*)g.A2 - (const char*)g.A, dB2 = (const char*)g.Bt2 - (const char*)g.Bt;
    const char* cA = (const char*)g.A + (cur.z ? dA2 : 0) + (size_t)cur.pm * tstepA; const char* cB = (const char*)g.Bt + (cur.z ? dB2 : 0) + (size_t)cur.pn * tstepB;
    S.a_ready(cur);
    if constexpr (SP2) {
        PG8_STAGE(PG8_SB(0, 0), cB, voffB); PG8_STAGE(PG8_SB(0, 1), cB + hstepB, voffB); PG8_STAGE(PG8_SA(0, 0), cA, voffA); PG8_STAGE(PG8_SA(0, 1), cA + hstepA, voffA);
        if (wr == 1) PG8_BAR;
        PG8_WAIT_V(2); PG8_BAR;
        PG8_STAGE(PG8_SB(1, 0), cB + kstep, voffB); PG8_STAGE(PG8_SA(1, 0), cA + kstep, voffA); PG8_STAGE(PG8_SB(1, 1), cB + hstepB + kstep, voffB);
        PG8_WAIT_V(6); PG8_BAR;
    } else {
        PG8_STAGE(PG8_SB(0, 0), cB, voffB); PG8_STAGE(PG8_SA(0, 0), cA, voffA); PG8_STAGE(PG8_SB(0, 1), cB + hstepB, voffB); PG8_STAGE(PG8_SA(0, 1), cA + hstepA, voffA);
        if (wr == 1) PG8_BAR;
        PG8_WAIT_V(4); PG8_BAR;
        PG8_STAGE(PG8_SB(1, 0), cB + kstep, voffB); PG8_STAGE(PG8_SA(1, 0), cA + kstep, voffA); PG8_STAGE(PG8_SB(1, 1), cB + hstepB + kstep, voffB);
        PG8_WAIT_V(6); PG8_BAR;
    }
    for (;;) {
        const bool has_next = S.next(ui + 1, nxt);
        const char* nA = has_next ? (const char*)g.A + (nxt.z ? dA2 : 0) + (size_t)nxt.pm * tstepA : cA; const char* nB = has_next ? (const char*)g.Bt + (nxt.z ? dB2 : 0) + (size_t)nxt.pn * tstepB : cB;
        for (int t = 0; t < nt; t += 2) {
            const bool last = (t == nt - 2);
            const char* a1 = cA + (size_t)(t + 1) * kstep;
            const char* a2 = last ? nA : cA + (size_t)(t + 2) * kstep; const char* b2 = last ? nB : cB + (size_t)(t + 2) * kstep;
            const char* a3 = a2 + kstep; const char* b3 = b2 + kstep;
            if (last && has_next) S.a_ready(nxt);
            if constexpr (SP2) {
            PG8_LDB(B0, 0, 0); PG8_LDB(B1, 0, 1); PG8_SCHED; PG8_LDA(At, 0, 0); PG8_STAGE(PG8_SA(1, 1), a1 + hstepA, voffA);
            PG8_WAIT_V(8); PG8_WAIT_L(0); PG8_BAR; PG8_MMA(0, 0, At, B0); PG8_MMA(0, 1, At, B1); PG8_BAR; PG8_SCHED;
            PG8_LDA(At, 0, 1); PG8_STAGE(PG8_SB(0, 0), b2, voffB); PG8_STAGE(PG8_SB(0, 1), b2 + hstepB, voffB); PG8_STAGE(PG8_SA(0, 0), a2, voffA);
            PG8_WAIT_V(8); PG8_WAIT_L(0); PG8_BAR; PG8_MMA(1, 0, At, B0); PG8_MMA(1, 1, At, B1); PG8_BAR; PG8_SCHED;
            PG8_LDB(B0, 1, 0); PG8_LDB(B1, 1, 1); PG8_SCHED; PG8_LDA(At, 1, 0); PG8_STAGE(PG8_SA(0, 1), a2 + hstepA, voffA);
            PG8_WAIT_V(8); PG8_WAIT_L(0); PG8_BAR; PG8_MMA(0, 0, At, B0); PG8_MMA(0, 1, At, B1); PG8_BAR; PG8_SCHED;
            PG8_LDA(At, 1, 1); PG8_STAGE(PG8_SB(1, 0), b3, voffB); PG8_STAGE(PG8_SB(1, 1), b3 + hstepB, voffB); PG8_STAGE(PG8_SA(1, 0), a3, voffA);
            PG8_WAIT_V(8); PG8_WAIT_L(0); PG8_BAR; PG8_MMA(1, 0, At, B0); PG8_MMA(1, 1, At, B1); PG8_BAR; PG8_SCHED;
            } else {
            PG8_LDB(B0, 0, 0); PG8_SCHED; PG8_LDA(At, 0, 0); PG8_STAGE(PG8_SA(1, 1), a1 + hstepA, voffA);
            PG8_WAIT_L(8); PG8_BAR; PG8_WAIT_L(0); PG8_MMA(0, 0, At, B0); PG8_BAR; PG8_SCHED;
            PG8_LDB(B1, 0, 1); PG8_STAGE(PG8_SB(0, 0), b2, voffB);
            PG8_BAR; PG8_WAIT_L(0); PG8_MMA(0, 1, At, B1); PG8_BAR;
            PG8_LDA(At, 0, 1); PG8_STAGE(PG8_SA(0, 0), a2, voffA);
            PG8_BAR; PG8_WAIT_L(0); PG8_MMA(1, 0, At, B0); PG8_BAR; PG8_SCHED;
            PG8_STAGE(PG8_SB(0, 1), b2 + hstepB, voffB);
            PG8_WAIT_V(6); PG8_BAR; PG8_MMA(1, 1, At, B1); PG8_BAR;
            PG8_LDB(B0, 1, 0); PG8_SCHED; PG8_LDA(At, 1, 0); PG8_STAGE(PG8_SA(0, 1), a2 + hstepA, voffA);
            PG8_WAIT_L(8); PG8_BAR; PG8_WAIT_L(0); PG8_MMA(0, 0, At, B0); PG8_BAR; PG8_SCHED;
            PG8_LDB(B1, 1, 1); PG8_STAGE(PG8_SB(1, 0), b3, voffB);
            PG8_BAR; PG8_WAIT_L(0); PG8_MMA(0, 1, At, B1); PG8_BAR;
            PG8_LDA(At, 1, 1); PG8_STAGE(PG8_SA(1, 0), a3, voffA);
            PG8_BAR; PG8_WAIT_L(0); PG8_MMA(1, 0, At, B0); PG8_BAR; PG8_SCHED;
            PG8_STAGE(PG8_SB(1, 1), b3 + hstepB, voffB);
            PG8_WAIT_V(6); PG8_BAR; PG8_MMA(1, 1, At, B1); PG8_BAR;
            }
        }
        if constexpr (ALIGN_EPI) { if (wr == 0) PG8_BAR; }
        if constexpr (!Epi::AFTER_DRAIN) { E(acc, cur, wr, wc, fr, fq); S.done(cur); }
        if (!has_next) break;
#pragma unroll
        for (int a = 0; a < 2; ++a)
#pragma unroll
            for (int b = 0; b < 2; ++b)
#pragma unroll
                for (int m = 0; m < 4; ++m)
#pragma unroll
                    for (int n = 0; n < 2; ++n) acc[a][b][m][n] = (f32x4){0.f, 0.f, 0.f, 0.f};
        cur = nxt; cA = nA; cB = nB; ++ui;
        if constexpr (ALIGN_EPI) { if (wr == 1) PG8_BAR; }
    }
    PG8_WAIT_V(0);
    if constexpr (!ALIGN_EPI) { if (wr == 0) PG8_BAR; }
    PG8_BAR;
    if constexpr (Epi::AFTER_DRAIN) { E.fused(acc, cur, wr, wc, fr, fq, lds, wid, lane); S.done(cur); }
#undef PG8_SA
#undef PG8_SB
#undef PG8_STAGE
#undef PG8_LDA
#undef PG8_LDB
#undef PG8_MMA
#undef PG8_WAIT_V
#undef PG8_WAIT_L
#undef PG8_BAR
#undef PG8_SCHED
}
}

constexpr int NB = 16, SEQ = 2048, DM = 1024, MTOK = NB * SEQ, DEPTH = 2, DIN = 5472, DFF = 2816;
using pg8::PW;
constexpr int C_NQ = 0, C_KCMP = 512, C_VCMP = 640, C_KSLC = 768, C_VSLC = 896, C_KWIN = 1024, C_VWIN = 1152, C_DQ = 1280, C_DK = 1792, C_DV = 2304,
              C_IQ = 2816, C_IK = 3328, C_IW = 3392, C_NG = 3400, C_GN = 3584, C_GD = 4608;
constexpr int C_TMP = 0, C_MRG = 1024;
__host__ __device__ __forceinline__ int proj_src_col(int n) {
    if (n < 1280) return n;
    if (n < 2816) return n - 1280 + 1304;
    if (n < 3328) return n - 2816 + 2840;
    if (n < 3392) return n - 3328 + 3352;
    if (n < 3400) return n - 3392 + 3416;
    if (n < 3424) return n - 3400 + 1280;
    if (n < 3584) return -1;
    return n - 3584 + 3424;
}
constexpr size_t MiB = 1u << 20;
constexpr size_t WS_CTL = 0, CTL_ZERO_BYTES = 65536;
constexpr size_t WS_ROPE = 1 * MiB;
constexpr size_t WS_CB1 = WS_ROPE + 131072;
constexpr size_t WS_RSS = 2 * MiB;
constexpr size_t WS_KC = 4 * MiB;
constexpr size_t WS_KCB = 6 * MiB;
constexpr size_t WS_SELM = 7 * MiB;
constexpr size_t WS_DMASK = 8 * MiB;
constexpr size_t WS_WIN = 16 * MiB;
constexpr size_t SZ_WIN = (size_t)PW * DM * 2, SZ_WBR = (size_t)DM * 512 * 2, SZ_WOUT = (size_t)DM * DM * 2, SZ_WGU = (size_t)PW * DM * 2, SZ_WDN = (size_t)DM * DFF * 2;
constexpr size_t WS_WBN = WS_WIN + DEPTH * SZ_WIN, WS_WBD = WS_WBN + DEPTH * SZ_WBR, WS_WOUT = WS_WBD + DEPTH * SZ_WBR, WS_WGU = WS_WOUT + DEPTH * SZ_WOUT, WS_WDN = WS_WGU + DEPTH * SZ_WGU;
constexpr size_t WS_W1B = WS_WDN + DEPTH * SZ_WDN;
constexpr size_t WS_R1 = 88 * MiB;
constexpr size_t WS_P = 152 * MiB;
constexpr size_t WS_END = WS_P + (size_t)MTOK * PW * 2;
static_assert(WS_W1B + 2 * MiB <= WS_R1 && WS_END <= 512 * MiB, "d_ws map");
constexpr int CW_TMO = 0, CW_CODE = 1, CW_BAR = 4096;

constexpr int LDSCTL_OFF = 0, MISC_OFF = 320, POOL_OFF = 1024;
constexpr int LDS_BYTES = 147456, POOL_BYTES = LDS_BYTES - POOL_OFF;
constexpr int NWAVES = 8, NTHR = 512;
#define GAS __attribute__((address_space(1)))
#define LAS __attribute__((address_space(3)))
typedef unsigned short bf16;
typedef unsigned v4u __attribute__((ext_vector_type(4)));
typedef float f32x4 __attribute__((ext_vector_type(4)));
typedef short bf16x8 __attribute__((ext_vector_type(8)));
typedef GAS unsigned gu32;
typedef GAS unsigned long long gu64;
#define RLX_AGENT __ATOMIC_RELAXED, __HIP_MEMORY_SCOPE_AGENT
#define LDS_WAIT() asm volatile("s_waitcnt lgkmcnt(0)" ::: "memory")
#define VM_WAIT() asm volatile("s_waitcnt vmcnt(0)" ::: "memory")
__device__ __forceinline__ unsigned long long rt() { return __builtin_amdgcn_s_memrealtime(); }
__device__ __forceinline__ unsigned f2bf(float f) { unsigned u = __builtin_bit_cast(unsigned, f); return (u + 0x7fffu + ((u >> 16) & 1u)) >> 16; }
__device__ __forceinline__ unsigned pk2(float lo, float hi) { return f2bf(lo) | (f2bf(hi) << 16); }

#define XB_TMO      128
#define XB_XCNT(j)  (256  + 64 * (j))
#define XB_XSUB(j)  (1280 + 64 * (j))
#define XB_XGEN(j)  (2304 + 64 * (j))
#define XB_TOP      3328
#define XB_TOPGEN   3392
#define XCD_BAR_WORDS 3456
#define XB_SPIN_CAP (1u << 18)

__device__ __forceinline__ unsigned xb_ld(unsigned* p)              { return __hip_atomic_load(p, __ATOMIC_RELAXED, __HIP_MEMORY_SCOPE_AGENT); }
__device__ __forceinline__ unsigned xb_add(unsigned* p, unsigned v) { return __hip_atomic_fetch_add(p, v, __ATOMIC_RELAXED, __HIP_MEMORY_SCOPE_AGENT); }
__device__ __forceinline__ unsigned xb_xcc_id() { return (unsigned)__builtin_amdgcn_s_getreg((3 << 11) | 20) & 0xFu; }
#define XB_SPIN(cond, bar) do { unsigned _sp = 0; while (cond) { __builtin_amdgcn_s_sleep(1); \
    if ((++_sp & 255u) == 0u) { if (xb_ld(&(bar)[XB_TMO])) break; if (_sp > XB_SPIN_CAP) { atomicAdd(&(bar)[XB_TMO], 1u); break; } } } } while (0)

struct XcdBarrier {
    unsigned* bar; unsigned x;
    volatile LAS unsigned* st;
};

__device__ __forceinline__ XcdBarrier xcd_barrier_post(unsigned* bar, volatile LAS unsigned* st) {
    XcdBarrier b; b.bar = bar; b.x = xb_xcc_id(); b.st = st;
    if (threadIdx.x == 0) (void)xb_add(&bar[XB_XCNT(b.x)], 1u);
    return b;
}
__device__ __forceinline__ void xcd_barrier_complete(unsigned* bar, unsigned x, unsigned& nloc, unsigned& nx) {
    const unsigned G = gridDim.x * gridDim.y * gridDim.z;
    unsigned sum, cnt, mine, sp = 0u;
    for (;;) {
        sum = 0u; cnt = 0u; mine = 0u;
#pragma unroll
        for (unsigned j = 0; j < 16; ++j) { const unsigned c = xb_ld(&bar[XB_XCNT(j)]); sum += c; cnt += (c > 0u) ? 1u : 0u; mine = (j == x) ? c : mine; }
        if (sum == G) break;
        __builtin_amdgcn_s_sleep(1);
        if ((++sp & 255u) == 0u) { if (xb_ld(&bar[XB_TMO])) break; if (sp > XB_SPIN_CAP) { atomicAdd(&bar[XB_TMO], 1u); break; } }
    }
    nloc = mine > 0u ? mine : 1u; nx = cnt > 0u ? cnt : 1u;
}

__device__ __forceinline__ void xcd_barrier(const XcdBarrier& b) {
    asm volatile("s_waitcnt vmcnt(0)" ::: "memory");
    __syncthreads();
    if (threadIdx.x == 0) {
        unsigned* bar = b.bar;
        __builtin_amdgcn_s_waitcnt(0);
        unsigned nloc = b.st[0], nx = b.st[1];
        if (nloc == 0u) { xcd_barrier_complete(bar, b.x, nloc, nx); b.st[0] = nloc; b.st[1] = nx; }
        const unsigned old = xb_add(&bar[XB_XSUB(b.x)], 1u);
        const unsigned gen = old / nloc;
        if (old + 1u == (gen + 1u) * nloc) {
            __builtin_amdgcn_fence(__ATOMIC_RELEASE, "agent");
            asm volatile("s_waitcnt vmcnt(0)" ::: "memory");
            const unsigned og = xb_add(&bar[XB_TOP], 1u);
            const unsigned tg = og / nx;
            if (og + 1u == (tg + 1u) * nx) xb_add(&bar[XB_TOPGEN], 1u);
            else XB_SPIN(xb_ld(&bar[XB_TOPGEN]) == tg, bar);
            __builtin_amdgcn_fence(__ATOMIC_ACQUIRE, "agent");
            xb_add(&bar[XB_XGEN(b.x)], 1u);
            asm volatile("s_waitcnt vmcnt(0)" ::: "memory");
        } else {
            XB_SPIN(xb_ld(&bar[XB_XGEN(b.x)]) == gen, bar);
            __builtin_amdgcn_fence(__ATOMIC_ACQUIRE, "agent");
            asm volatile("s_waitcnt vmcnt(0)" ::: "memory");
        }
    }
    __syncthreads();
}
struct Args { const float* in[21]; float* out; unsigned char* ws; int ph_lo, ph_hi, li, pad; };
struct Ctx { LAS unsigned char* lds; int tid, lane, wave, G; };
typedef const __attribute__((address_space(4))) Args* KArgs;
__device__ __forceinline__ KArgs kargs() { KArgs p = (KArgs)__builtin_amdgcn_kernarg_segment_ptr(); asm volatile("" : "+s"(p)); return p; }
__device__ __forceinline__ int fresh_tid(const Ctx& C0) { int ln; asm volatile("v_mbcnt_lo_u32_b32 %0, -1, 0\n\tv_mbcnt_hi_u32_b32 %0, -1, %0" : "=v"(ln)); return C0.wave * 64 + ln; }
#define AIN(i) (kargs()->in[i])
#define AOUT (kargs()->out)
#define AWS (kargs()->ws)
__device__ __forceinline__ float bf2f(bf16 b) { return __uint_as_float((unsigned)b << 16); }
__device__ __forceinline__ float wave_sum(float v) {
#pragma unroll
    for (int o = 1; o < 64; o <<= 1) v += __shfl_xor(v, o);
    return v;
}
__device__ __forceinline__ float wave_max(float v) {
#pragma unroll
    for (int o = 1; o < 64; o <<= 1) v = fmaxf(v, __shfl_xor(v, o));
    return v;
}
__host__ __device__ __forceinline__ int mask_bitpos(int u) { return (u & 3) + 4 * (u >> 3) + 16 * ((u >> 2) & 1); }

__device__ __forceinline__ void p0_transpose_item(const float* srcp, int Ns, bf16* WT, int K, int k0, int n0, LAS float* scr, int lane, const float* gk = nullptr) {
    float tv[32];
#pragma unroll
    for (int i = 0; i < 32; ++i) { const int kk = 2 * i + (lane >> 5); tv[i] = srcp ? __builtin_nontemporal_load(srcp + (size_t)(k0 + kk) * Ns) : 0.f; }
#pragma unroll
    for (int i = 0; i < 32; ++i) { const int kk = 2 * i + (lane >> 5); scr[kk * 33 + (lane & 31)] = gk ? tv[i] * gk[k0 + kk] : tv[i]; }
    LDS_WAIT(); asm volatile("" ::: "memory");
    const int c = lane & 7;
#pragma unroll
    for (int j = 0; j < 4; ++j) { const int n = (lane >> 3) + 8 * j; const LAS float* s = scr + (8 * c) * 33 + n;
        v4u o; o.x = pk2(s[0 * 33], s[1 * 33]); o.y = pk2(s[2 * 33], s[3 * 33]); o.z = pk2(s[4 * 33], s[5 * 33]); o.w = pk2(s[6 * 33], s[7 * 33]);
        *(GAS v4u*)(WT + (size_t)(n0 + n) * K + k0 + 8 * c) = o; }
    LDS_WAIT(); asm volatile("" ::: "memory");
}
__device__ __forceinline__ void sincos_small(double r, double& s, double& c) {
    const double r2 = r * r; double ts = 1.0, tc = 1.0, ss = 1.0, cc = 1.0;
#pragma unroll
    for (int k = 1; k <= 14; ++k) { tc = -tc * r2 * (1.0 / (double)((2 * k - 1) * (2 * k))); ts = -ts * r2 * (1.0 / (double)((2 * k) * (2 * k + 1))); cc += tc; ss += ts; }
    s = r * ss; c = cc;
}
__device__ __forceinline__ void p0_prologue(Ctx& C0) {
    Ctx C = C0; C.tid = fresh_tid(C0); C.lane = C.tid & 63;
    LAS float* scr = (LAS float*)(C.lds + POOL_OFF + C.wave * 16384);
    const int gw = blockIdx.x * NWAVES + C.wave, NGW = C.G * NWAVES, lane = C.lane;
    constexpr int I_WIN = 16 * (PW / 32), I_WBR = 8 * 32, I_WOUT = 16 * 32, I_WGU = 16 * (PW / 32), I_WDN = 44 * 32, I_L = I_WIN + 2 * I_WBR + I_WOUT + I_WGU + I_WDN;
    for (int it = gw; it < DEPTH * I_L; it += NGW) {
        const int l = it / I_L; int r = it % I_L;
        if (r < I_WIN) { const int nblk = PW / 32, kb = r / nblk, nb = r % nblk, n = nb * 32 + (lane & 31), rho = n & 255,
                sc = proj_src_col((n & ~255) + 64 * ((rho >> 5) & 3) + 32 * (rho >> 7) + (rho & 31));
            p0_transpose_item(sc >= 0 ? AIN(2) + (size_t)l * DM * DIN + sc : nullptr, DIN, (bf16*)(AWS + WS_WIN + l * SZ_WIN), DM, kb * 64, nb * 32, scr, lane, AIN(1) + l * DM); continue; } r -= I_WIN;
        if (r < I_WBR) { const int kb = r / 32, nb = r % 32, n0_ = nb * 32 + (lane & 31), rho = n0_ & 255, n = (n0_ & ~255) + 64 * ((rho >> 5) & 3) + 32 * (rho >> 7) + (rho & 31);
            p0_transpose_item(AIN(13) + (size_t)l * 512 * DM + n, DM, (bf16*)(AWS + WS_WBN + l * SZ_WBR), 512, kb * 64, nb * 32, scr, lane); continue; } r -= I_WBR;
        if (r < I_WBR) { const int kb = r / 32, nb = r % 32, n0_ = nb * 32 + (lane & 31), rho = n0_ & 255, n = (n0_ & ~255) + 64 * ((rho >> 5) & 3) + 32 * (rho >> 7) + (rho & 31);
            p0_transpose_item(AIN(14) + (size_t)l * 512 * DM + n, DM, (bf16*)(AWS + WS_WBD + l * SZ_WBR), 512, kb * 64, nb * 32, scr, lane); continue; } r -= I_WBR;
        if (r < I_WOUT) { const int kb = r / 32, nb = r % 32, n0_ = nb * 32 + (lane & 31), rho = n0_ & 255, n = (n0_ & ~255) + 64 * ((rho >> 5) & 3) + 32 * (rho >> 7) + (rho & 31);
            p0_transpose_item(AIN(15) + (size_t)l * DM * DM + n, DM, (bf16*)(AWS + WS_WOUT + l * SZ_WOUT), DM, kb * 64, nb * 32, scr, lane); continue; } r -= I_WOUT;
        if (r < I_WGU) { const int nblk = PW / 32, kb = r / nblk, nb = r % nblk, n = nb * 32 + (lane & 31), j = n & 255, hcol = (n >> 8) * 128 + (j & 127);
            const float* src = (j < 128 ? AIN(17) : AIN(18)) + (size_t)l * DM * DFF + hcol;
            p0_transpose_item(src, DFF, (bf16*)(AWS + WS_WGU + l * SZ_WGU), DM, kb * 64, nb * 32, scr, lane, AIN(16) + l * DM); continue; } r -= I_WGU;
        { const int kb = r / 32, nb = r % 32, n0_ = nb * 32 + (lane & 31), rho = n0_ & 255, n = (n0_ & ~255) + 64 * ((rho >> 5) & 3) + 32 * (rho >> 7) + (rho & 31);
            p0_transpose_item(AIN(19) + (size_t)l * DFF * DM + n, DM, (bf16*)(AWS + WS_WDN + l * SZ_WDN), DFF, kb * 64, nb * 32, scr, lane); }
    }
    for (int it = gw; it < DEPTH * 2 * 32 * 4; it += NGW) {
        const int l = it / 256, r = it % 256, kv = r / 128, kb = (r % 128) / 4, nb = r % 4, n = nb * 32 + (lane & 31);
        p0_transpose_item(AIN(kv ? 9 : 4) + (size_t)l * 2048 * 128 + n, 128, (bf16*)(AWS + WS_W1B) + (size_t)(l * 2 + kv) * 128 * 2048, 2048, kb * 64, nb * 32, scr, lane);
    }
    {
        bf16* XG = (bf16*)(AWS + WS_R1); float* rss = (float*)(AWS + WS_RSS);
        const float* xin = AIN(0);
        for (int m0 = gw * 2; m0 < MTOK; m0 += NGW * 2) {
            f32x4 v[2][4];
#pragma unroll
            for (int rr = 0; rr < 2; ++rr)
#pragma unroll
                for (int j = 0; j < 4; ++j) v[rr][j] = __builtin_nontemporal_load((const GAS f32x4*)(xin + (size_t)(m0 + rr) * DM) + lane + 64 * j);
#pragma unroll
            for (int rr = 0; rr < 2; ++rr) { const int m = m0 + rr;
                GAS unsigned long long* o8 = (GAS unsigned long long*)(XG + (size_t)m * DM) + lane;
                float s = 0.f;
#pragma unroll
                for (int j = 0; j < 4; ++j) { const f32x4 vv = v[rr][j]; s += (vv.x * vv.x + vv.y * vv.y) + (vv.z * vv.z + vv.w * vv.w); const f32x4 y = vv;
                    o8[64 * j] = (unsigned long long)pk2(y.x, y.y) | ((unsigned long long)pk2(y.z, y.w) << 32); }
                s = wave_sum(s);
                if (lane < 16) rss[(size_t)m * 16 + lane] = (lane == 0) ? s : 0.f; }
        }
    }
    {
        float* rc = (float*)(AWS + WS_ROPE);
        const float invf[8] = {1.0f, 0.1939227432012558f, 0.03760603070259094f, 0.007292664609849453f, 0.0014142135623842478f, 0.00027424818836152554f, 5.3182957344688475e-05f, 1.0313385246263351e-05f};
        for (int i = blockIdx.x * NTHR + C.tid; i < 2048 * 8; i += C.G * NTHR) {
            const int pos = i >> 3, j = i & 7; float f = invf[0];
#pragma unroll
            for (int q = 1; q < 8; ++q) f = (j == q) ? invf[q] : f;
            const float ang = (float)pos * f; const double a = (double)ang;
            const double k = __builtin_rint(a * 0.15915494309189535); const double r = (a - k * 6.283185307179586) - k * 2.4492935982947064e-16;
            double s, c; sincos_small(r, s, c);
            rc[pos * 16 + j] = (float)c; rc[pos * 16 + 8 + j] = (float)s;
        }
    }
    for (int it = blockIdx.x; it < DEPTH * 2 * 64; it += C.G) {
        const int lkv = it >> 6, ks = it & 63, l = lkv >> 1, kv = lkv & 1; const float* pos = AIN(kv ? 8 : 3) + (size_t)l * 2048; const float* w1 = AIN(kv ? 9 : 4) + (size_t)l * 2048 * 128;
        LAS float* red = (LAS float*)(C.lds + POOL_OFF);
        __syncthreads();
        const int n = C.tid & 127, q = C.tid >> 7; float a = 0.f;
#pragma unroll
        for (int k = 32 * ks + 8 * q; k < 32 * ks + 8 * q + 8; ++k) a += pos[k] * w1[(size_t)k * 128 + n];
        red[C.tid] = a; __syncthreads();
        if (C.tid < 128) ((float*)(AWS + WS_CB1))[(lkv * 64 + ks) * 128 + n] = (red[n] + red[128 + n]) + (red[256 + n] + red[384 + n]);
        __syncthreads();
    }
}
__device__ __forceinline__ float gelu_tanh(float x) { const float u = 0.7978845608028654f * (x + 0.044715f * x * x * x); const float t = 1.0f - 2.0f / (__expf(2.0f * u) + 1.0f); return 0.5f * x * (1.0f + t); }
__device__ __forceinline__ void final_norm(Ctx& C0) {
    Ctx C = C0; C.tid = fresh_tid(C0); C.lane = C.tid & 63; __syncthreads();
    const float* gn = AIN(20); const int lane = C.lane, wave = C.tid >> 6; const float* rss = (const float*)(AWS + WS_RSS); const bf16* X = (const bf16*)(AWS + WS_R1);
    f32x4 g[4];
#pragma unroll
    for (int j = 0; j < 4; ++j) g[j] = ((const f32x4*)gn)[lane + 64 * j];
    for (int m = blockIdx.x * NWAVES + wave; m < MTOK; m += C.G * NWAVES) {
        GAS f32x4* orow = (GAS f32x4*)(AOUT + (size_t)m * DM) + lane;
        const unsigned long long* xr = (const unsigned long long*)(X + (size_t)m * DM) + lane;
        const float rs = pg8::row_rstd(rss, m);
#pragma unroll
        for (int j = 0; j < 4; ++j) { const unsigned long long w = __builtin_nontemporal_load(xr + 64 * j); const unsigned wl = (unsigned)w, wh = (unsigned)(w >> 32);
            const f32x4 x = {pg8::bf_lo(wl), pg8::bf_hi(wl), pg8::bf_lo(wh), pg8::bf_hi(wh)};
            __builtin_nontemporal_store(x * rs * g[j], orow + 64 * j); }
    }
}
namespace fa {
typedef float f32x16 __attribute__((ext_vector_type(16)));
typedef short s16x4 __attribute__((ext_vector_type(4)));
typedef short v4i16_t __attribute__((ext_vector_type(4)));
typedef short bf16x8 __attribute__((ext_vector_type(8)));
typedef unsigned u32x4 __attribute__((ext_vector_type(4)));
typedef float f32x2_t __attribute__((ext_vector_type(2))); typedef __bf16 bf16x2_t __attribute__((ext_vector_type(2)));
constexpr int SLOTB = 8192, NSLOT = 3;
constexpr int L_K = 0, L_V = NSLOT * SLOTB, L_WS = 2 * NSLOT * SLOTB, L_OST = L_WS + 8 * 256, L_END = L_OST + 8 * 4096;
constexpr float THR = 8.0f, BIGSUM = 1.0e30f;
struct W { int lane, r32, hi, wid; LAS unsigned char* shm; };
__device__ __forceinline__ int crow(int r, int hi) { return (r & 3) + 8 * (r >> 2) + 4 * hi; }
__device__ __forceinline__ unsigned cvtpk(float lo, float hi) { f32x2_t v = {lo, hi}; bf16x2_t b = __builtin_convertvector(v, bf16x2_t); return __builtin_bit_cast(unsigned, b); }
__device__ __forceinline__ float max3f(float a, float b, float c) { return __builtin_fmaxf(__builtin_fmaxf(a, b), c); }
#define FA_WAIT_BAR(N) asm volatile("s_waitcnt vmcnt(" #N ") lgkmcnt(0)\n\ts_barrier" ::: "memory")
__device__ __forceinline__ void glds16(const void* gsrc, unsigned lds_dst) { unsigned keep;
    asm volatile("s_mov_b32 %0, m0\n\ts_mov_b32 m0, %2\n\ts_nop 0\n\tglobal_load_lds_dwordx4 %1, off\n\ts_mov_b32 m0, %0" : "=&s"(keep) : "v"(gsrc), "s"(lds_dst) : "memory"); }
__device__ __forceinline__ void dma_tile(const W& w, const bf16* Kb, const bf16* Vb, int pitch, int tile, int slot) {
    const bf16* ks = Kb + (size_t)(64 * tile + w.lane) * pitch + w.wid * 8;
    const bf16* vs = Vb + (size_t)(64 * tile + 16 * (w.wid & 3) + (w.lane >> 2)) * pitch + (w.wid >> 2) * 32 + (w.lane & 3) * 8;
    const unsigned l0 = (unsigned)(uintptr_t)(w.shm) + slot * SLOTB + w.wid * 1024;
    glds16(ks, (unsigned)__builtin_amdgcn_readfirstlane(l0 + L_K)); glds16(vs, (unsigned)__builtin_amdgcn_readfirstlane(l0 + L_V));
}
__device__ __forceinline__ void qkt(f32x16& p0, f32x16& p1, const LAS unsigned char* Kslot, const bf16x8 (&qr)[4], int r32, int hi) {
    const f32x16 zero = f32x16{};
    const LAS unsigned char* kb = Kslot + hi * 1024 + r32 * 16;
#pragma unroll
    for (int dh = 0; dh < 2; ++dh) {
        bf16x8 b0[2], b1[2];
#pragma unroll
        for (int d = 0; d < 2; ++d) { b0[d] = *(const LAS bf16x8*)(kb + (2 * dh + d) * 2048); b1[d] = *(const LAS bf16x8*)(kb + (2 * dh + d) * 2048 + 512); }
        __builtin_amdgcn_sched_barrier(0);
#pragma unroll
        for (int d = 0; d < 2; ++d) { const int d0 = 2 * dh + d;
            if (d0 == 0) { p0 = __builtin_amdgcn_mfma_f32_32x32x16_bf16(b0[d], qr[0], zero, 0, 0, 0); p1 = __builtin_amdgcn_mfma_f32_32x32x16_bf16(b1[d], qr[0], zero, 0, 0, 0); }
            else { p0 = __builtin_amdgcn_mfma_f32_32x32x16_bf16(b0[d], qr[d0], p0, 0, 0, 0); p1 = __builtin_amdgcn_mfma_f32_32x32x16_bf16(b1[d], qr[d0], p1, 0, 0, 0); } }
    }
}
__device__ __forceinline__ s16x4 vtr(const LAS unsigned char* p) { return __builtin_bit_cast(s16x4, __builtin_amdgcn_ds_read_tr16_b64_v4i16((LAS v4i16_t*)p)); }
template <bool WITH_L = true> __device__ __forceinline__ void pv(f32x16 (&o)[2], f32x16& lacc, const LAS unsigned char* vp, const u32x4 (&pw)[4]) {
    const bf16x8 ones = {16256, 16256, 16256, 16256, 16256, 16256, 16256, 16256};
#pragma unroll
    for (int d0 = 0; d0 < 2; ++d0) {
        s16x4 lo[4], hi[4];
#pragma unroll
        for (int ks = 0; ks < 4; ++ks) { lo[ks] = vtr(vp + d0 * 4096 + ks * 1024); hi[ks] = vtr(vp + d0 * 4096 + ks * 1024 + 512); }
        __builtin_amdgcn_sched_barrier(0);
        if (WITH_L && d0 == 0) {
#pragma unroll
            for (int ks = 0; ks < 4; ++ks) lacc = __builtin_amdgcn_mfma_f32_32x32x16_bf16(__builtin_bit_cast(bf16x8, pw[ks]), ones, lacc, 0, 0, 0);
            __builtin_amdgcn_sched_barrier(0);
        }
#pragma unroll
        for (int ks = 0; ks < 4; ++ks) { const bf16x8 vf = {lo[ks][0], lo[ks][1], lo[ks][2], lo[ks][3], hi[ks][0], hi[ks][1], hi[ks][2], hi[ks][3]};
            o[d0] = __builtin_amdgcn_mfma_f32_32x32x16_bf16(__builtin_bit_cast(bf16x8, pw[ks]), vf, o[d0], 0, 0, 0); }
    }
}
__device__ __forceinline__ void pv(f32x16 (&o)[2], const LAS unsigned char* vp, const u32x4 (&pw)[4]) { f32x16 none; pv<false>(o, none, vp, pw); }
__device__ __forceinline__ float half_swap(float v) { const auto rr = __builtin_amdgcn_permlane32_swap(__float_as_uint(v), __float_as_uint(v), false, false); return __uint_as_float(rr[0] == __float_as_uint(v) ? rr[1] : rr[0]); }
__device__ __forceinline__ float rowmax(const f32x16& p0, const f32x16& p1) {
    float a = max3f(p0[0], p0[1], p1[0]), b = max3f(p0[2], p0[3], p1[1]); a = max3f(a, p1[2], p1[3]);
#pragma unroll
    for (int r = 4; r < 16; r += 4) { a = max3f(a, p0[r], p0[r + 1]); b = max3f(b, p0[r + 2], p0[r + 3]); a = max3f(a, p1[r], p1[r + 1]); b = max3f(b, p1[r + 2], p1[r + 3]); }
    const float m = __builtin_fmaxf(a, b);
    const auto rr = __builtin_amdgcn_permlane32_swap(__float_as_uint(m), __float_as_uint(m), false, false);
    return __builtin_fmaxf(__uint_as_float(rr[0]), __uint_as_float(rr[1]));
}
struct St { f32x16 o[2], lacc; float mref; bool moved; };
__device__ __forceinline__ void st_init(St& s) { s.o[0] = f32x16{}; s.o[1] = f32x16{}; s.lacc = f32x16{}; s.mref = 0.f; s.moved = false; }
template <class MaskF> __device__ __forceinline__ void tile_step(const W& w, int slot, const bf16x8 (&qr)[4], MaskF& MF, St& s, bool safe) {
    f32x16 p0, p1;
    qkt(p0, p1, w.shm + L_K + slot * SLOTB, qr, w.r32, w.hi);
    MF.pre(p0, p1);
    if (__builtin_expect(safe, 0)) {
        if (s.moved) {
#pragma unroll
            for (int r = 0; r < 16; ++r) { p0[r] -= s.mref; p1[r] -= s.mref; } }
        MF.pre_slow(p0, p1);
        const float rm = rowmax(p0, p1);
        if (__any(rm > THR)) {
            const float dl = __builtin_fmaxf(rm, 0.f); s.mref += dl; s.moved = true;
#pragma unroll
            for (int r = 0; r < 16; ++r) { p0[r] -= dl; p1[r] -= dl; }
            const float f = __builtin_amdgcn_exp2f(-dl);
            LAS float* wsf = (LAS float*)(w.shm + L_WS) + w.wid * 64;
            if (w.hi == 0) wsf[w.r32] = f;
            asm volatile("s_waitcnt lgkmcnt(0)" ::: "memory");
#pragma unroll
            for (int r = 0; r < 16; ++r) { const float fr = wsf[crow(r, w.hi)]; s.o[0][r] *= fr; s.o[1][r] *= fr; s.lacc[r] *= fr; }
        }
    }
#pragma unroll
    for (int r = 0; r < 16; ++r) { p0[r] = __builtin_amdgcn_exp2f(p0[r]); p1[r] = __builtin_amdgcn_exp2f(p1[r]); }
    MF.post(p0, p1);
    u32x4 pw[4];
#pragma unroll
    for (int k = 0; k < 4; ++k) { pw[0][k] = cvtpk(p0[2 * k], p0[2 * k + 1]); pw[1][k] = cvtpk(p0[8 + 2 * k], p0[9 + 2 * k]); pw[2][k] = cvtpk(p1[2 * k], p1[2 * k + 1]); pw[3][k] = cvtpk(p1[8 + 2 * k], p1[9 + 2 * k]); }
    MF.postw(pw);
    const LAS unsigned char* vp = w.shm + L_V + slot * SLOTB + ((w.lane >> 4) & 1) * 32 + (w.lane & 3) * 8 + (4 * w.hi + ((w.lane & 15) >> 2)) * 64;
    pv(s.o, s.lacc, vp, pw);
}
__device__ __forceinline__ bool branch_overflowed(const W& w, const St& s, int epoch) {
    volatile LAS int* flag = (volatile LAS int*)(w.shm - POOL_OFF + LDSCTL_OFF);
    float t = 0.f;
#pragma unroll
    for (int r = 0; r < 16; ++r) t += s.lacc[r];
    if (__builtin_expect(__any(!(t < BIGSUM)), 0)) { if (w.lane == 0) *flag = epoch; }
    asm volatile("s_waitcnt lgkmcnt(0)\n\ts_barrier" ::: "memory");
    return __builtin_amdgcn_readfirstlane(*flag) == epoch;
}
template <class TS, class MaskF> __device__ __forceinline__ bool run_branch(const W& w_in, const bf16* Kb, const bf16* Vb, int pitch, TS ts, bf16x8 (&qr)[4], MaskF& MF, St& s, bool safe, int epoch) {
    const W& w = w_in;
    const int n = ts.n;
    asm volatile("s_waitcnt vmcnt(0)" : "+v"(qr[0]), "+v"(qr[1]), "+v"(qr[2]), "+v"(qr[3]) :: "memory");
    int t0 = 0, t1 = 0, t2 = 0;
    if (n > 0) { t0 = ts.next(); MF.issue(t0); dma_tile(w, Kb, Vb, pitch, t0, 0); }
    if (n > 1) { t1 = ts.next(); dma_tile(w, Kb, Vb, pitch, t1, 1); MF.template settle<4>(); } else { MF.template settle<2>(); }
    int slot = 0;
#pragma nounroll
    for (int k = 0; k < n; ++k) {
        if (k + 1 < n) { FA_WAIT_BAR(2); } else { FA_WAIT_BAR(0); }
        MF.advance(t0);
        if (k + 1 < n) MF.issue(t1);
        if (k + 2 < n) { t2 = ts.next(); int s2 = slot + 2; s2 = s2 >= NSLOT ? s2 - NSLOT : s2; dma_tile(w, Kb, Vb, pitch, t2, s2); }
        if (MF.active(t0)) tile_step(w, slot, qr, MF, s, safe);
        if (k + 2 < n) { MF.template settle<2>(); } else { MF.template settle<0>(); }
        slot = (slot == NSLOT - 1) ? 0 : slot + 1; t0 = t1; t1 = t2;
    }
    return branch_overflowed(w, s, epoch);
}
__device__ __forceinline__ void finish_branch(const W& w, St& s, float gate, f32x16 (&oacc)[2]) {
    LAS float* wsf = (LAS float*)(w.shm + L_WS) + w.wid * 64;
    if (w.hi == 0) wsf[32 + w.r32] = gate;
    asm volatile("s_waitcnt lgkmcnt(0)" ::: "memory");
#pragma unroll
    for (int r = 0; r < 16; ++r) { const float l = s.lacc[r]; const float sc = (l > 0.f) ? wsf[32 + crow(r, w.hi)] * __builtin_amdgcn_rcpf(l) : 0.f; oacc[0][r] += s.o[0][r] * sc; oacc[1][r] += s.o[1][r] * sc; }
    asm volatile("s_waitcnt lgkmcnt(0)" ::: "memory");
}
__device__ __forceinline__ void store_o(const W& w_in, const f32x16 (&oacc)[2], bf16* Ow, int opitch) {
    const W& w = w_in;
    LAS bf16* stg = (LAS bf16*)(w.shm + L_OST) + w.wid * 2048;
#pragma unroll
    for (int r = 0; r < 16; ++r) { const int orow = crow(r, w.hi);
#pragma unroll
        for (int d0 = 0; d0 < 2; ++d0) stg[orow * 64 + d0 * 32 + w.r32] = (bf16)(cvtpk(oacc[d0][r], 0.f) & 0xffffu); }
    asm volatile("s_waitcnt lgkmcnt(0)" ::: "memory");
#pragma unroll
    for (int i = 0; i < 4; ++i) { const int row = i * 8 + (w.lane >> 3), ch = w.lane & 7; const u32x4 v = *(const LAS u32x4*)(stg + row * 64 + ch * 8); *(u32x4*)(Ow + (size_t)row * opitch + ch * 8) = v; }
    asm volatile("s_waitcnt lgkmcnt(0)" ::: "memory");
}
struct SeqRange { int n, t; __device__ __forceinline__ int next() { return t++; } };
struct SeqBits { int n; unsigned rem; __device__ __forceinline__ int next() { const int t = __builtin_ctz(rem); rem &= rem - 1u; return t; } };
}

constexpr int L_MK = fa::L_END, L_MK_SLOT = 2048, DSA_LDS_END = L_MK + fa::NSLOT * L_MK_SLOT;
struct DsaMask {
    const LAS unsigned char* mlds;
    int hi, last_tile; unsigned w0, w1;
    __device__ __forceinline__ bool active(int t) const { return t <= last_tile; }
    __device__ __forceinline__ void advance_slot(int slot) { w0 = *(const LAS unsigned*)(mlds + slot * L_MK_SLOT) >> (16 * hi); w1 = *(const LAS unsigned*)(mlds + slot * L_MK_SLOT + 1024) >> (16 * hi); }
    __device__ __forceinline__ void pre(fa::f32x16&, fa::f32x16&) const {}
    __device__ __forceinline__ void pre_slow(fa::f32x16& p0, fa::f32x16& p1) const {
#pragma unroll
        for (int r = 0; r < 16; ++r) {
            if (!((w0 >> r) & 1u)) p0[r] = -INFINITY;
            if (!((w1 >> r) & 1u)) p1[r] = -INFINITY; }
    }
    __device__ __forceinline__ void postw(fa::u32x4 (&)[4]) const {}
    __device__ __forceinline__ void post(fa::f32x16& p0, fa::f32x16& p1) const {
#pragma unroll
        for (int r = 0; r < 16; ++r) {
            unsigned m0, m1;
            asm("v_bfe_i32 %0, %1, %2, 1" : "=v"(m0) : "v"(w0), "n"(r));
            asm("v_bfe_i32 %0, %1, %2, 1" : "=v"(m1) : "v"(w1), "n"(r));
            p0[r] = __uint_as_float(__float_as_uint(p0[r]) & m0);
            p1[r] = __uint_as_float(__float_as_uint(p1[r]) & m1); }
    }
};
__device__ __forceinline__ void dsa_dma_tile(const fa::W& w, const bf16* Kb, const bf16* Vb, const unsigned* mk, int tile, int slot) {
    fa::dma_tile(w, Kb, Vb, PW, tile, slot);
    if (w.wid < 2) fa::glds16(mk + (size_t)(2 * tile + w.wid) * SEQ + 4 * w.lane, (unsigned)__builtin_amdgcn_readfirstlane((unsigned)(uintptr_t)(w.shm) + L_MK + slot * L_MK_SLOT + w.wid * 1024));
}
#define DSA_WAIT_BAR(wid_, N2, N3) do { if ((wid_) < 2) { FA_WAIT_BAR(N3); } else { FA_WAIT_BAR(N2); } } while (0)
__device__ __forceinline__ bool run_branch_dsa(const fa::W& w, const bf16* Kb, const bf16* Vb, const unsigned* mk, int n, fa::bf16x8 (&qr)[4], DsaMask& MF, fa::St& s, bool safe, int epoch) {
    asm volatile("s_waitcnt vmcnt(0)" : "+v"(qr[0]), "+v"(qr[1]), "+v"(qr[2]), "+v"(qr[3]) :: "memory");
    dsa_dma_tile(w, Kb, Vb, mk, 0, 0);
    if (n > 1) dsa_dma_tile(w, Kb, Vb, mk, 1, 1);
    int slot = 0;
#pragma nounroll
    for (int k = 0; k < n; ++k) {
        if (k + 1 < n) { DSA_WAIT_BAR(w.wid, 2, 3); } else { FA_WAIT_BAR(0); }
        MF.advance_slot(slot);
        if (k + 2 < n) { int s2 = slot + 2; s2 = s2 >= fa::NSLOT ? s2 - fa::NSLOT : s2; dsa_dma_tile(w, Kb, Vb, mk, k + 2, s2); }
        if (MF.active(k)) fa::tile_step(w, slot, qr, MF, s, safe);
        slot = (slot == fa::NSLOT - 1) ? 0 : slot + 1;
    }
    return fa::branch_overflowed(w, s, epoch);
}
__device__ __forceinline__ void dsa_mfma(Ctx& C0) {
    Ctx C = C0; C.tid = fresh_tid(C0); C.lane = C.tid & 63; if (C.tid == 0) *(volatile LAS int*)(C.lds + LDSCTL_OFF) = 0; __syncthreads();
    int ep = 0;
    fa::W w; w.lane = C.lane; w.r32 = C.lane & 31; w.hi = C.lane >> 5; w.wid = C.wave; w.shm = C.lds + POOL_OFF;
    const bf16* P = (const bf16*)(AWS + WS_P); bf16* O = (bf16*)AOUT;        const unsigned* DMK = (const unsigned*)(AWS + WS_DMASK);
    const int G = C.G, bx = blockIdx.x, vcu = (G % 8 == 0) ? (bx % 8) * (G / 8) + bx / 8 : bx;
    for (int sl = vcu; sl < 256; sl += G) {
        const int bh = sl >> 1, sub = sl & 1, b = bh >> 3, h = bh & 7;
        for (int i = 0; i < 4; ++i) {
            const int qb = sub == 0 ? (i == 0 ? 7 : i == 1 ? 0 : i == 2 ? 4 : 3) : (i == 0 ? 6 : i == 1 ? 1 : i == 2 ? 5 : 2);
            { int tidu = fresh_tid(C0); w.lane = tidu & 63; w.r32 = w.lane & 31; w.hi = w.lane >> 5; w.wid = __builtin_amdgcn_readfirstlane(tidu >> 6); }
            const int q0 = qb * 256, tq = q0 + 32 * w.wid + w.r32;
            const bf16* Pb = P + (size_t)b * SEQ * PW;
            const bf16* Qrow = Pb + (size_t)tq * PW + C_DQ + h * 64;
            fa::bf16x8 qr[4];
#pragma unroll
            for (int d0 = 0; d0 < 4; ++d0) qr[d0] = *(const fa::bf16x8*)(Qrow + d0 * 16 + w.hi * 8);
            fa::St st;
#pragma nounroll
            for (int pass = 0; pass < 2; ++pass) {
                DsaMask MF; MF.mlds = w.shm + L_MK + (32 * w.wid + w.r32) * 4; MF.hi = w.hi; MF.last_tile = (q0 + 32 * w.wid + 31) >> 6; MF.w0 = MF.w1 = 0u;
                fa::st_init(st); ++ep;
                if (!run_branch_dsa(w, Pb + C_DK + h * 64, Pb + C_DV + h * 64, DMK + (size_t)b * 64 * SEQ + q0, (q0 + 256) / 64, qr, MF, st, pass != 0, ep)) break;
            }
            fa::f32x16 oacc[2]; oacc[0] = fa::f32x16{}; oacc[1] = fa::f32x16{};
            fa::finish_branch(w, st, 1.0f, oacc);
            fa::store_o(w, oacc, O + (size_t)(b * SEQ + q0 + 32 * w.wid) * 1024 + 512 + h * 64, 1024);
        }
    }
}
struct NsaSlcMask {
    unsigned rowsel, wmask; int diag, tq, hi; unsigned cursel;
    __device__ __forceinline__ bool active(int t) const { return (wmask >> t) & 1u; }
    __device__ __forceinline__ void issue(int) {}
    template <int N> __device__ __forceinline__ void settle() {}
    int curt;
    __device__ __forceinline__ void advance(int t) { curt = t; cursel = ((rowsel >> t) & 1u) ? 0xffffffffu : 0u; }
    __device__ __forceinline__ void pre(fa::f32x16& p0, fa::f32x16& p1) const {
        if (curt == diag) {
            const int lim = tq - 64 * diag - 4 * hi;
#pragma unroll
            for (int r = 0; r < 16; ++r) { const int ko = (r & 3) + 8 * (r >> 2); if (ko > lim) p0[r] = -INFINITY; if (ko + 32 > lim) p1[r] = -INFINITY; }
        }
    }
    __device__ __forceinline__ void pre_slow(fa::f32x16& p0, fa::f32x16& p1) const {
        if (!cursel) {
#pragma unroll
            for (int r = 0; r < 16; ++r) { p0[r] = -INFINITY; p1[r] = -INFINITY; } }
    }
    __device__ __forceinline__ void post(fa::f32x16&, fa::f32x16&) const {}
    __device__ __forceinline__ void postw(fa::u32x4 (&pw)[4]) const {
#pragma unroll
        for (int i = 0; i < 4; ++i) { pw[i][0] &= cursel; pw[i][1] &= cursel; pw[i][2] &= cursel; pw[i][3] &= cursel; }
    }
};
struct NsaWinMask {
    int tq, hi, tq0, curt;
    __device__ __forceinline__ bool active(int t) const { return 64 * t + 63 >= tq0 - 511 && 64 * t <= tq0 + 31; }
    __device__ __forceinline__ void issue(int) {}
    template <int N> __device__ __forceinline__ void settle() {}
    __device__ __forceinline__ void advance(int t) { curt = t; }
    __device__ __forceinline__ void pre(fa::f32x16& p0, fa::f32x16& p1) const {
        const int k0 = 64 * curt;
        if (k0 < tq0 - 480 || k0 + 63 > tq0) {
            const int hiL = tq - k0 - 4 * hi, loL = hiL - 511;
#pragma unroll
            for (int r = 0; r < 16; ++r) { const int ko = (r & 3) + 8 * (r >> 2); if (ko > hiL || ko < loL) p0[r] = -INFINITY; if (ko + 32 > hiL || ko + 32 < loL) p1[r] = -INFINITY; }
        }
    }
    __device__ __forceinline__ void pre_slow(fa::f32x16&, fa::f32x16&) const {}
    __device__ __forceinline__ void post(fa::f32x16&, fa::f32x16&) const {}
    __device__ __forceinline__ void postw(fa::u32x4 (&)[4]) const {}
};
template <int MODE> __device__ __forceinline__ void nsa_mfma(Ctx& C0) {
    Ctx C = C0; C.tid = fresh_tid(C0); C.lane = C.tid & 63; if (C.tid == 0) *(volatile LAS int*)(C.lds + LDSCTL_OFF) = 0; __syncthreads();
    int ep = 0;
    using namespace fa;
    W w; w.lane = C.lane; w.r32 = C.lane & 31; w.hi = C.lane >> 5; w.wid = C.wave; w.shm = C.lds + POOL_OFF;
    LAS float* impbuf = (LAS float*)(w.shm + L_END);
    LAS float* impsum = impbuf + 4 * 2 * 32 * 33;
    LAS unsigned* selm = (LAS unsigned*)(impsum + 64 * 33);
    const bf16* P = (const bf16*)(AWS + WS_P); bf16* O = (bf16*)AOUT;
    const bf16* KCB = (const bf16*)(AWS + WS_KCB);
    const int G = C.G, bx = blockIdx.x, vcu = (G % 8 == 0) ? (bx % 8) * (G / 8) + bx / 8 : bx;
    for (int sl = vcu; sl < 256; sl += G) {
        const int bg = sl >> 3, b = bg >> 1, g = bg & 1, s8 = sl & 7;
        for (int ui = 0; ui < 4; ++ui) {
            const int cur = (ui == 0) ? 31 - s8 : (ui == 1) ? s8 : (ui == 2) ? 16 + s8 : 15 - s8;
            int tidu = fresh_tid(C0);
            C.tid = tidu; C.lane = tidu & 63; C.wave = __builtin_amdgcn_readfirstlane(tidu >> 6);
            w.lane = C.lane; w.r32 = C.lane & 31; w.hi = C.lane >> 5; w.wid = C.wave;
            const int r = w.wid & 3, th = w.wid >> 2;
            const int q0 = 64 * cur, tq0 = q0 + 32 * th, tq = tq0 + w.r32, head = 4 * g + r;
            const bf16* Pb = P + (size_t)b * SEQ * PW; const bf16* Prow = Pb + (size_t)tq * PW;
            bf16x8 qr[4];
#pragma unroll
            for (int d0 = 0; d0 < 4; ++d0) qr[d0] = *(const bf16x8*)(Prow + C_NQ + head * 64 + d0 * 16 + w.hi * 8);
            const float g_c = bf2f(Prow[C_NG + 0 * 8 + head]), g_s = bf2f(Prow[C_NG + 1 * 8 + head]), g_w = bf2f(Prow[C_NG + 2 * 8 + head]);
            if (C.tid < 3) selm[64 + C.tid] = 0u;
            f32x16 oacc[2];
            {
                const bf16* kc = KCB + (size_t)((0 * NB + b) * 2 + g) * 128 * 64; const bf16* vc = KCB + (size_t)((1 * NB + b) * 2 + g) * 128 * 64;
                const bool two = (q0 >= 1024);
                asm volatile("s_waitcnt vmcnt(0)" : "+v"(qr[0]), "+v"(qr[1]), "+v"(qr[2]), "+v"(qr[3]) :: "memory");
                dma_tile(w, kc, vc, 64, 0, 0); if (two) dma_tile(w, kc, vc, 64, 1, 1);
                FA_WAIT_BAR(0);
                f32x16 p[4];
                qkt(p[0], p[1], w.shm + L_K, qr, w.r32, w.hi);
                if (two) qkt(p[2], p[3], w.shm + L_K + SLOTB, qr, w.r32, w.hi);
                else {
#pragma unroll
                    for (int i = 0; i < 16; ++i) { p[2][i] = -INFINITY; p[3][i] = -INFINITY; } }
                const int lim = (tq >= 31 ? ((tq - 31) >> 4) : -1) - 4 * w.hi;
                float m = -INFINITY;
#pragma unroll
                for (int T = 0; T < 4; ++T)
#pragma unroll
                    for (int i = 0; i < 16; ++i) { const int c = 32 * T + (i & 3) + 8 * (i >> 2); if (c > lim) p[T][i] = -INFINITY; m = __builtin_fmaxf(m, p[T][i]); }
                { const auto rr = __builtin_amdgcn_permlane32_swap(__float_as_uint(m), __float_as_uint(m), false, false); m = __builtin_fmaxf(__uint_as_float(rr[0]), __uint_as_float(rr[1])); }
                const float msub = (m == -INFINITY) ? 0.f : m; float l = 0.f;
#pragma unroll
                for (int T = 0; T < 4; ++T)
#pragma unroll
                    for (int i = 0; i < 16; ++i) { p[T][i] = __builtin_amdgcn_exp2f(p[T][i] - msub); l += p[T][i]; }
                { const auto rr = __builtin_amdgcn_permlane32_swap(__float_as_uint(l), __float_as_uint(l), false, false); l = __uint_as_float(rr[0]) + __uint_as_float(rr[1]); }
                const float inv = (l > 0.f) ? 1.0f / l : 0.f;
#pragma unroll
                for (int T = 0; T < 4; ++T)
#pragma unroll
                    for (int i = 0; i < 16; ++i) p[T][i] *= inv;
                if (cur >= 16) {
                    LAS float* ib = impbuf + ((r * 2 + th) * 32 + w.r32) * 33;
                    float prv = 0.f;
#pragma unroll
                    for (int T = 0; T < 4; ++T)
#pragma unroll
                        for (int a = 0; a < 4; ++a) {
                            const float car = 0.5f * p[T][4 * a + 3], part = (p[T][4 * a] + p[T][4 * a + 1]) + (p[T][4 * a + 2] + car);
                            const auto rr = __builtin_amdgcn_permlane32_swap(__float_as_uint(car), __float_as_uint(car), false, false);
                            const float oth = (w.hi == 0) ? __uint_as_float(rr[1]) : __uint_as_float(rr[0]);
                            ib[8 * T + 2 * a + w.hi] = part + (w.hi ? oth : prv); prv = oth; }
                }
                {
                    u32x4 pwA[4], pwB[4];
#pragma unroll
                    for (int k = 0; k < 4; ++k) { pwA[0][k] = cvtpk(p[0][2 * k], p[0][2 * k + 1]); pwA[1][k] = cvtpk(p[0][8 + 2 * k], p[0][9 + 2 * k]); pwA[2][k] = cvtpk(p[1][2 * k], p[1][2 * k + 1]); pwA[3][k] = cvtpk(p[1][8 + 2 * k], p[1][9 + 2 * k]);
                        pwB[0][k] = cvtpk(p[2][2 * k], p[2][2 * k + 1]); pwB[1][k] = cvtpk(p[2][8 + 2 * k], p[2][9 + 2 * k]); pwB[2][k] = cvtpk(p[3][2 * k], p[3][2 * k + 1]); pwB[3][k] = cvtpk(p[3][8 + 2 * k], p[3][9 + 2 * k]); }
                    asm volatile("" : "+v"(pwA[0]), "+v"(pwA[1]), "+v"(pwA[2]), "+v"(pwA[3]), "+v"(pwB[0]), "+v"(pwB[1]), "+v"(pwB[2]), "+v"(pwB[3]));
                    f32x16 oc[2]; oc[0] = f32x16{}; oc[1] = f32x16{};
                    const LAS unsigned char* vp = w.shm + L_V + ((w.lane >> 4) & 1) * 32 + (w.lane & 3) * 8 + (4 * w.hi + ((w.lane & 15) >> 2)) * 64;
                    pv(oc, vp, pwA);
                    if (two) pv(oc, vp + SLOTB, pwB);
                    LAS float* wsf = (LAS float*)(w.shm + L_WS) + w.wid * 64;
                    if (w.hi == 0) wsf[32 + w.r32] = g_c;
                    asm volatile("s_waitcnt lgkmcnt(0)" ::: "memory");
#pragma unroll
                    for (int i = 0; i < 16; ++i) { const float scl = wsf[32 + crow(i, w.hi)]; oacc[0][i] = oc[0][i] * scl; oacc[1][i] = oc[1][i] * scl; }
                }
                asm volatile("s_waitcnt lgkmcnt(0)\n\ts_barrier" ::: "memory");
            }
            unsigned rowsel, umask, wmask;
#ifndef NSA_NO_RANK
            if (cur >= 16) {
                for (int e = C.tid; e < 64 * 32; e += NTHR) { const int tk = e >> 5, j = e & 31; float a = 0.f;
#pragma unroll
                    for (int rr2 = 0; rr2 < 4; ++rr2) a += impbuf[((rr2 * 2 + (tk >> 5)) * 32 + (tk & 31)) * 33 + j];
                    impsum[tk * 33 + j] = a; }
                asm volatile("s_waitcnt lgkmcnt(0)\n\ts_barrier" ::: "memory");
                const int tk = C.tid >> 3, jg = C.tid & 7; float sv[32];
#pragma unroll
                for (int j = 0; j < 32; ++j) { const float im = impsum[tk * 33 + j]; sv[j] = (j > cur) ? -INFINITY : ((j == 0 || j == cur || j == cur - 1) ? 1e4f : im); }
                unsigned bits = 0u;
#pragma unroll
                for (int q = 0; q < 4; ++q) { const int j = 4 * jg + q; float mine = sv[0];
#pragma unroll
                    for (int i = 1; i < 32; ++i) mine = (i == j) ? sv[i] : mine;
                    int rank = 0;
#pragma unroll
                    for (int i = 0; i < 32; ++i) rank += (sv[i] > mine || (sv[i] == mine && i < j)) ? 1 : 0;
                    if (rank < 16 && j <= cur) bits |= 1u << j; }
                bits |= __shfl_xor(bits, 1); bits |= __shfl_xor(bits, 2); bits |= __shfl_xor(bits, 4);
                if (jg == 0) { selm[tk] = bits; __hip_atomic_fetch_or(&selm[64], bits, __ATOMIC_RELAXED, __HIP_MEMORY_SCOPE_WORKGROUP); __hip_atomic_fetch_or(&selm[65 + (tk >> 5)], bits, __ATOMIC_RELAXED, __HIP_MEMORY_SCOPE_WORKGROUP); }
                asm volatile("s_waitcnt lgkmcnt(0)\n\ts_barrier" ::: "memory");
                rowsel = selm[32 * th + w.r32]; umask = selm[64]; wmask = selm[65 + th];
            } else
#endif
            { rowsel = umask = wmask = (cur == 31) ? 0xffffffffu : ((1u << (cur + 1)) - 1u); }
            umask = (unsigned)__builtin_amdgcn_readfirstlane((int)umask); wmask = (unsigned)__builtin_amdgcn_readfirstlane((int)wmask);
#ifndef NSA_NO_SLC
            if (MODE == 0 || MODE >= 2) {
                St st;
#pragma nounroll
                for (int pass = 0; pass < 2; ++pass) {
                    NsaSlcMask MF; MF.rowsel = rowsel; MF.wmask = wmask; MF.diag = cur; MF.tq = tq; MF.hi = w.hi; MF.cursel = 0u; MF.curt = 0;
                    st_init(st); ++ep;
                    SeqBits ts{__builtin_popcount(umask), umask};
                    if (!run_branch(w, Pb + C_KSLC + g * 64, Pb + C_VSLC + g * 64, PW, ts, qr, MF, st, pass != 0, ep)) break;
                }
                finish_branch(w, st, g_s, oacc);
            }
#endif
#ifndef NSA_NO_WIN
            if (MODE == 0 || MODE >= 3) {
                St st;
                const int tlo = cur >= 8 ? cur - 8 : 0;
#pragma nounroll
                for (int pass = 0; pass < 2; ++pass) {
                    NsaWinMask MF; MF.tq = tq; MF.hi = w.hi; MF.tq0 = tq0; MF.curt = 0;
                    st_init(st); ++ep;
                    SeqRange ts{cur - tlo + 1, tlo};
                    if (!run_branch(w, Pb + C_KWIN + g * 64, Pb + C_VWIN + g * 64, PW, ts, qr, MF, st, pass != 0, ep)) break;
                }
                finish_branch(w, st, g_w, oacc);
            }
#endif
            if (MODE == 0) store_o(w, oacc, O + (size_t)(b * SEQ + tq0) * 1024 + head * 64, 1024); else asm volatile("" :: "v"(oacc[0]), "v"(oacc[1]));
            asm volatile("s_waitcnt lgkmcnt(0)\n\ts_barrier" ::: "memory");
        }
    }
}
__device__ __forceinline__ unsigned fkey32(float f) { const unsigned u = __float_as_uint(f + 0.0f); return (f == -INFINITY) ? 0u : ((u & 0x80000000u) ? ~u : (u | 0x80000000u)); }
__device__ __forceinline__ int wave_sum_i32(int v) {
    v += __builtin_amdgcn_update_dpp(0, v, 0xB1, 0xF, 0xF, true);
    v += __builtin_amdgcn_update_dpp(0, v, 0x4E, 0xF, 0xF, true);
    v += __builtin_amdgcn_update_dpp(0, v, 0x141, 0xF, 0xF, true);
    v += __builtin_amdgcn_update_dpp(0, v, 0x140, 0xF, 0xF, true);
    return __builtin_amdgcn_readlane(v, 0) + __builtin_amdgcn_readlane(v, 16) + __builtin_amdgcn_readlane(v, 32) + __builtin_amdgcn_readlane(v, 48);
}
__device__ __forceinline__ float wave_max_dpp(float v) {
#define WMD_STEP(CTRL) v = __builtin_fmaxf(v, __int_as_float(__builtin_amdgcn_update_dpp(__float_as_int(v), __float_as_int(v), CTRL, 0xF, 0xF, false)))
    WMD_STEP(0xB1); WMD_STEP(0x4E); WMD_STEP(0x141); WMD_STEP(0x140);
#undef WMD_STEP
    const float a = __int_as_float(__builtin_amdgcn_readlane(__float_as_int(v), 0)), b = __int_as_float(__builtin_amdgcn_readlane(__float_as_int(v), 16));
    const float c = __int_as_float(__builtin_amdgcn_readlane(__float_as_int(v), 32)), d = __int_as_float(__builtin_amdgcn_readlane(__float_as_int(v), 48));
    return __builtin_fmaxf(__builtin_fmaxf(a, b), __builtin_fmaxf(c, d));
}
__device__ __forceinline__ unsigned wave_excl_prefix(unsigned v, int lane) {
    unsigned x = v;
#pragma unroll
    for (int o = 1; o < 64; o <<= 1) { const unsigned y = __shfl_up(x, o); x += (lane >= o) ? y : 0u; }
    return x - v;
}
typedef float f32x2_t __attribute__((ext_vector_type(2)));
#define VV(u) v2[(u) >> 1][(u) & 1]
__device__ __forceinline__ f32x2_t pk_fma_clamp(f32x2_t a, f32x2_t b, f32x2_t c) { f32x2_t d; asm("v_pk_fma_f32 %0, %1, %2, %3 clamp" : "=v"(d) : "v"(a), "s"(b), "v"(c)); return d; }
__device__ __forceinline__ f32x2_t pk_mul_clamp(f32x2_t a, f32x2_t b) { f32x2_t d; asm("v_pk_mul_f32 %0, %1, %2 clamp" : "=v"(d) : "v"(a), "s"(b)); return d; }
__device__ __forceinline__ f32x2_t pk_add(f32x2_t a, f32x2_t b) { f32x2_t d; asm("v_pk_add_f32 %0, %1, %2" : "=v"(d) : "v"(a), "v"(b)); return d; }
template <int MODE> __device__ __forceinline__ void idx_mfma(Ctx& C0) {
    Ctx C = C0; C.tid = fresh_tid(C0); C.lane = C.tid & 63; __syncthreads();
    typedef float f32x4_t __attribute__((ext_vector_type(4)));
    typedef short bf16x8 __attribute__((ext_vector_type(8)));
    constexpr int RS = 2113;
    LAS unsigned char* shm = C.lds + POOL_OFF;
    LAS unsigned char* qlds = shm;
    LAS float* scr = (LAS float*)shm;
    const bf16* P = (const bf16*)(AWS + WS_P); unsigned* DMK = (unsigned*)(AWS + WS_DMASK);
    const int G = C.G, bx = blockIdx.x, vcu = (G % 8 == 0) ? (bx % 8) * (G / 8) + bx / 8 : bx;
    for (int sl = vcu; sl < 256; sl += G) {
        const int b = sl >> 4, s16 = sl & 15;
#pragma nounroll
        for (int ui = 0; ui < 8; ++ui) {
            int tidu = fresh_tid(C0);
            const int tid = tidu, lane = tid & 63, tok = lane & 15, g = lane >> 4, wid = __builtin_amdgcn_readfirstlane(tid >> 6);
            const int q16 = ((ui & 1) ? (ui >> 1) * 32 + 31 - s16 : (ui >> 1) * 32 + s16);
            const int t = 16 * q16 + tok, nkt = (q16 >> 1) + 1;
            const bf16* Pb = P + (size_t)b * SEQ * PW;
#pragma unroll
            for (int k = 0; k < 2; ++k) { const int id = tid + 512 * k, tk = id >> 6, pc = id & 63;
                const v4u v = *(const v4u*)(Pb + (size_t)(16 * q16 + tk) * PW + C_IQ + pc * 8);
                *(LAS v4u*)(qlds + (pc * 16 + tk) * 16) = v; }
            const v4u wvp = *(const v4u*)(Pb + (size_t)t * PW + C_IW);
            asm volatile("s_waitcnt vmcnt(0) lgkmcnt(0)\n\ts_barrier" ::: "memory");
            float sv[8][8];
            bf16x8 qf[8][2];
#pragma unroll
            for (int h = 0; h < 8; ++h) { qf[h][0] = *(const LAS bf16x8*)(qlds + (g * 16 + tok) * 16 + (h * 8) * 256); qf[h][1] = *(const LAS bf16x8*)(qlds + (g * 16 + tok) * 16 + (h * 8 + 4) * 256); }
            bf16x8 ka0, ka1, kn0, kn1;
#define IDX_LOADK(d0, d1, kt_, s_) do { const bf16* krow_ = Pb + (size_t)(32 * (kt_) + 16 * (s_) + tok) * PW + C_IK + 8 * g; d0 = *(const bf16x8*)(krow_); d1 = *(const bf16x8*)(krow_ + 32); } while (0)
            if (wid < nkt) IDX_LOADK(ka0, ka1, wid, 0);
#pragma unroll
            for (int st = 0; st < 16; ++st) {
                const int j = st >> 1, s = st & 1, kt = wid + 8 * j;
                if (st + 1 < 16) { const int kt2 = wid + 8 * ((st + 1) >> 1); if (kt2 < nkt) IDX_LOADK(kn0, kn1, kt2, (st + 1) & 1); }
                if (kt < nkt) {
                    f32x4_t sc = {0.f, 0.f, 0.f, 0.f};
#pragma unroll
                    for (int h = 0; h < 8; ++h) {
                        f32x4_t acc = {0.f, 0.f, 0.f, 0.f};
                        acc = __builtin_amdgcn_mfma_f32_16x16x32_bf16(ka0, qf[h][0], acc, 0, 0, 0);
                        acc = __builtin_amdgcn_mfma_f32_16x16x32_bf16(ka1, qf[h][1], acc, 0, 0, 0);
                        const unsigned wpk = (h < 2) ? wvp.x : (h < 4) ? wvp.y : (h < 6) ? wvp.z : wvp.w; const float wh = (h & 1) ? pg8::bf_hi(wpk) : pg8::bf_lo(wpk);
#pragma unroll
                        for (int r = 0; r < 4; ++r) sc[r] = __builtin_fmaf(wh, __builtin_fmaxf(acc[r], 0.f), sc[r]);
                    }
                    const int kpos = 32 * kt + 16 * s + 4 * g;
#pragma unroll
                    for (int r = 0; r < 4; ++r) sv[j][4 * s + r] = (kpos + r <= t) ? sc[r] + 0.0f : -INFINITY;
                } else {
#pragma unroll
                    for (int r = 0; r < 4; ++r) sv[j][4 * s + r] = -INFINITY;
                }
                ka0 = kn0; ka1 = kn1;
            }
#undef IDX_LOADK
            if (q16 < 16) {
#pragma unroll
                for (int j = 0; j < 8; ++j) { const int kt = wid + 8 * j; unsigned bits = 0u;
#pragma unroll
                    for (int i = 0; i < 8; ++i) bits |= (sv[j][i] != -INFINITY) ? (1u << ((i & 3) + 8 * (i >> 2) + 4 * (g >> 1) + 16 * (g & 1))) : 0u;
                    bits |= __shfl_xor(bits, 16); bits |= __shfl_xor(bits, 32);
                    if (MODE == 0) { if (g == 0) DMK[(size_t)(b * 64 + kt) * SEQ + t] = bits; } else { asm volatile("" :: "v"(bits)); } }
                asm volatile("s_waitcnt lgkmcnt(0)\n\ts_barrier" ::: "memory");
                continue;
            }
            if (MODE == 1) { asm volatile("" :: "v"(sv[0][0]), "v"(sv[7][7])); asm volatile("s_waitcnt lgkmcnt(0)\n\ts_barrier" ::: "memory"); continue; }
            asm volatile("s_waitcnt lgkmcnt(0)\n\ts_barrier" ::: "memory");
#pragma unroll
            for (int j = 0; j < 8; ++j)
#pragma unroll
                for (int i = 0; i < 8; ++i) scr[tok * RS + 33 * (wid + 8 * j) + 16 * (i >> 2) + 4 * g + (i & 3)] = sv[j][i];
            asm volatile("s_waitcnt lgkmcnt(0)\n\ts_barrier" ::: "memory");
#pragma nounroll
            for (int tt = 0; tt < 2; ++tt) {
                const int tau = wid + 8 * tt, tq = 16 * q16 + tau;
                f32x2_t v2[16];
#pragma unroll
                for (int u = 0; u < 32; ++u) VV(u) = scr[tau * RS + 33 * lane + u];
#define IDX_CNT(PRED, OUT) do { int c_ = 0; _Pragma("unroll") for (int u = 0; u < 32; ++u) { const float fx = VV(u); c_ += (PRED) ? 1 : 0; } OUT = wave_sum_i32(c_); } while (0)
                const f32x2_t pbig2 = {1.2676506002282294e30f, 1.2676506002282294e30f}, nbig2 = {-1.2676506002282294e30f, -1.2676506002282294e30f};
                float mx = -INFINITY, mn = INFINITY;
#pragma unroll
                for (int u = 0; u < 32; ++u) { mx = __builtin_fmaxf(mx, VV(u)); mn = (VV(u) == -INFINITY) ? mn : __builtin_fminf(mn, VV(u)); }
                mx = wave_max_dpp(mx); mn = -wave_max_dpp(-mn);
#define IDX_CNTLT(PIV, OUT) do { const float pb_ = (PIV) * 1.2676506002282294e30f; const f32x2_t pb2_ = {pb_, pb_}; f32x2_t a0_ = {0.f, 0.f}, a1_ = {0.f, 0.f}; \
                    _Pragma("unroll") for (int u = 0; u < 16; u += 2) { a0_ = pk_add(a0_, pk_fma_clamp(v2[u], nbig2, pb2_)); a1_ = pk_add(a1_, pk_fma_clamp(v2[u + 1], nbig2, pb2_)); } \
                    OUT = wave_sum_i32((int)((a0_[0] + a0_[1]) + (a1_[0] + a1_[1]))); } while (0)
                int cp, c0;
                {
                    f32x2_t ap = {0.f, 0.f}, an = {0.f, 0.f};
#pragma unroll
                    for (int u = 0; u < 16; ++u) { ap = pk_add(ap, pk_mul_clamp(v2[u], pbig2)); an = pk_add(an, pk_mul_clamp(v2[u], nbig2)); }
                    cp = wave_sum_i32((int)(ap[0] + ap[1])); c0 = 2048 - wave_sum_i32((int)(an[0] + an[1]));
                    if (cp == 256) { int ce; IDX_CNT(fx > 0.f, ce); cp = ce; }
                }
                float thr = 0.f, tv = 0.f; int need = 0; bool tie = false, done = false, strict = false;
                float lo, hi_, clo, chi, wprev = INFINITY;
                if (cp >= 256) { lo = 0.f; hi_ = mx; clo = (float)cp; chi = 1.f; if (cp == 256) { done = true; strict = true; thr = 0.f; } }
                else if (c0 < 256) { lo = mn; hi_ = 0.f; clo = (float)(tq + 1); chi = (float)c0; }
                else { lo = hi_ = clo = chi = 0.f; tie = true; tv = 0.f; need = 256 - cp; done = true; }
#pragma nounroll
                for (int rd = 0; rd < 64 && !done; ++rd) {
                    const float wdt = hi_ - lo, fi = __builtin_fminf(__builtin_fmaxf((clo - 256.5f) / (clo - chi), 0.02f), 0.98f);
                    const float frac = ((rd & 1) && wdt > 0.5f * wprev) ? 0.5f : fi;
                    if (!(rd & 1)) wprev = wdt;
                    const float mid = lo + wdt * frac;
                    if (!(mid > lo) || !(mid < hi_)) {
                        int cg; IDX_CNT(fx >= hi_, cg); tie = true; done = true; need = 256 - cg;
                        float below = -INFINITY;
#pragma unroll
                        for (int u = 0; u < 32; ++u) below = (VV(u) < hi_) ? __builtin_fmaxf(below, VV(u)) : below;
                        tv = wave_max_dpp(below);
                        break; }
                    int c; { int clt; IDX_CNTLT(mid, clt); c = 2048 - clt; }
                    if (c == 256) { int ce; IDX_CNT(fx >= mid, ce); c = ce; }
                    if (c == 256) { done = true; thr = mid; } else if (c > 256) { lo = mid; clo = (float)c; } else { hi_ = mid; chi = (float)c; }
                }
                bool redo = !done;
                if (tie && !redo) { int cgt, ceq; IDX_CNT(fx > tv, cgt); IDX_CNT(fx == tv, ceq); need = 256 - cgt; redo = (need < 1 || need > ceq); }
                if (__builtin_expect(redo, 0)) {
                    unsigned T = 0u;
#pragma nounroll
                    for (int bit = 31; bit >= 0; --bit) { const unsigned cand = T | (1u << bit); int c; IDX_CNT(fkey32(fx) >= cand, c); if (c >= 256) T = cand; }
                    tv = __uint_as_float((T & 0x80000000u) ? (T ^ 0x80000000u) : ~T); tie = true; strict = false;
                    int cgt; IDX_CNT(fx > tv, cgt); need = 256 - cgt;
                }
                unsigned word = 0u;
                if (!tie) {
#pragma unroll
                    for (int u = 0; u < 32; ++u) word |= ((strict ? VV(u) > thr : VV(u) >= thr)) ? (1u << ((u & 3) + 4 * (u >> 3) + 16 * ((u >> 2) & 1))) : 0u;
                } else {
                    unsigned nt = 0u;
#pragma unroll
                    for (int u = 0; u < 32; ++u) nt += (VV(u) == tv) ? 1u : 0u;
                    unsigned rank = wave_excl_prefix(nt, lane);
#pragma unroll
                    for (int u = 0; u < 32; ++u) { const bool eq = (VV(u) == tv); const bool sel = (VV(u) > tv) || (eq && (int)rank < need); rank += eq ? 1u : 0u;
                        word |= sel ? (1u << ((u & 3) + 4 * (u >> 3) + 16 * ((u >> 2) & 1))) : 0u; }
                }
                DMK[(size_t)(b * 64 + lane) * SEQ + tq] = word;
#undef IDX_CNT
#undef IDX_CNTLT
            }
            asm volatile("s_waitcnt lgkmcnt(0)\n\ts_barrier" ::: "memory");
        }
    }
}
__device__ __forceinline__ void compress_mfma(Ctx& C0, int l) {
    Ctx C = C0; C.tid = fresh_tid(C0); C.lane = C.tid & 63; __syncthreads();
    typedef float f32x16 __attribute__((ext_vector_type(16)));
    typedef short bf16x8 __attribute__((ext_vector_type(8)));
    LAS float* hidp = (LAS float*)(C.lds + POOL_OFF);
    LAS float* hid = hidp + 2 * 32 * 132;
    const bf16* P = (const bf16*)(AWS + WS_P);
    const int lane = C.lane, r32 = lane & 31, hi = lane >> 5, wid = C.wave, nb = wid & 3, kh = wid >> 2;
    for (int u = blockIdx.x; u < 256; u += C.G) {
        const int kv = u >> 7, b = (u >> 3) & 15, g = (u >> 2) & 1, mb = u & 3, c0 = 32 * mb;
        const int crow_ = (c0 + r32 < 127) ? c0 + r32 : 126;
        const bf16* arow = P + (size_t)(b * SEQ + 16 * crow_) * PW + (kv ? C_VCMP : C_KCMP) + g * 64 + 8 * hi;
        const bf16* brow = (const bf16*)(AWS + WS_W1B) + ((size_t)(l * 2 + kv) * 128 + 32 * nb + r32) * 2048 + 1024 * kh + 8 * hi;
        f32x16 acc = f32x16{};
#pragma unroll 8
        for (int kk = 0; kk < 64; ++kk) {
            const int k = 1024 * kh + 16 * kk;
            const bf16x8 a = *(const bf16x8*)(arow + (size_t)(k >> 6) * PW + (k & 63));
            const bf16x8 bq = *(const bf16x8*)(brow + 16 * kk);
            acc = __builtin_amdgcn_mfma_f32_32x32x16_bf16(a, bq, acc, 0, 0, 0);
        }
        __syncthreads();
#pragma unroll
        for (int i = 0; i < 16; ++i) hidp[(kh * 32 + (i & 3) + 8 * (i >> 2) + 4 * hi) * 132 + 32 * nb + r32] = acc[i];
        __syncthreads();
        LAS float* cb1 = hid + 32 * 132;
        if (C.tid < 128) { const float* cp = (const float*)(AWS + WS_CB1) + (size_t)(l * 2 + kv) * 64 * 128 + C.tid; float a = AIN(kv ? 10 : 5)[l * 128 + C.tid];
            for (int ks = 0; ks < 64; ++ks) a += cp[ks * 128];
            cb1[C.tid] = a; }
        __syncthreads();
        for (int e = C.tid; e < 32 * 128; e += NTHR) { const int c = e >> 7, n = e & 127; hid[c * 132 + n] = gelu_tanh(hidp[c * 132 + n] + hidp[(32 + c) * 132 + n] + cb1[n]); }
        __syncthreads();
        {
            const float* w2 = AIN(kv ? 11 : 6) + (size_t)l * 128 * 64; const float* b2 = AIN(kv ? 12 : 7) + l * 64;
            const int c = C.tid >> 4, d4 = (C.tid & 15) * 4;
            f32x4 a = *(const f32x4*)(b2 + d4);
            for (int n = 0; n < 128; ++n) a += hid[c * 132 + n] * *(const f32x4*)(w2 + n * 64 + d4);
            if (c0 + c >= 127) a = (f32x4){0.f, 0.f, 0.f, 0.f};
            const size_t o = ((size_t)((kv * NB + b) * 2 + g) * 128 + c0 + c) * 64 + d4;
            *(f32x4*)((float*)(AWS + WS_KC) + o) = a;
            *(unsigned long long*)((bf16*)(AWS + WS_KCB) + o) = (unsigned long long)pk2(a.x, a.y) | ((unsigned long long)pk2(a.z, a.w) << 32);
        }
    }
    __syncthreads();
}
#ifndef MK_N_LAUNCHES
#define MK_N_LAUNCHES 1
#endif
constexpr int NPH = 18;
constexpr int N_LAUNCHES = MK_N_LAUNCHES;
#define GRID_BAR() do { if (N_LAUNCHES == 1) { XcdBarrier bar_; bar_.bar = (unsigned*)((gu32*)(AWS + WS_CTL) + CW_BAR); bar_.x = xb_xcc_id(); bar_.st = (volatile LAS unsigned*)(C.lds + MISC_OFF) + 8; xcd_barrier(bar_); } } while (0)
#define lo (kargs()->ph_lo)
#define hi (kargs()->ph_hi)
#ifndef REP_PHASE
#define REP_PHASE -1
#endif
#ifndef PH_EN
#define PH_EN 0xFFFFFFFFu
#endif
#define IN(k) (((PH_EN >> ((k) > 8 ? ((k) - 8 > 8 ? 17 : (k) - 8) : (k))) & 1u) && lo <= (k) && (k) < hi)
#define BOTH(k) (IN(k) && IN((k) + 1))
#define RING (C.lds + POOL_OFF)
#define XG_ ((bf16*)(AWS + WS_R1))
#define OB_ ((bf16*)AOUT)
#define P_ ((bf16*)(AWS + WS_P))
#define H_ ((bf16*)(AWS + WS_P))
#define RSS_ ((float*)(AWS + WS_RSS))
#define RCOS_ ((const float*)(AWS + WS_ROPE))

template <int l> __device__ __forceinline__ void layer_phases(Ctx& C) {
        const int pb = 1 + 8 * l;
        if (IN(pb)) {
            pg8::Gemm g{XG_, (const bf16*)(AWS + WS_WIN + l * SZ_WIN), MTOK, PW, DM, DM, DM, nullptr, nullptr}; pg8::StaticOrder S; S.init(MTOK, PW, C.G, (int)blockIdx.x);
            pg8::EpiProj E{P_, RSS_, RCOS_};
            pg8::gemm_phase<pg8::EpiProj, pg8::StaticOrder, true, true>(RING, g, S, E, C.wave);
            if (REP_PHASE == 1) pg8::gemm_phase<pg8::EpiProj, pg8::StaticOrder, true, true>(RING, g, S, E, C.wave);
            if (REP_PHASE == 11) { pg8::EpiNull EN; pg8::gemm_phase<pg8::EpiNull, pg8::StaticOrder, true, true>(RING, g, S, EN, C.wave); }
            if (BOTH(pb)) GRID_BAR();
        }
        if (IN(pb + 1)) { compress_mfma(C, l); if (REP_PHASE == 2) compress_mfma(C, l); idx_mfma<0>(C); if (REP_PHASE == 3) idx_mfma<0>(C); if (REP_PHASE == 31) idx_mfma<1>(C); if (BOTH(pb + 1)) GRID_BAR(); }
        if (IN(pb + 2)) { nsa_mfma<0>(C); if (REP_PHASE == 4) nsa_mfma<0>(C); if (REP_PHASE == 41) nsa_mfma<1>(C); if (REP_PHASE == 42) nsa_mfma<2>(C); dsa_mfma(C); if (REP_PHASE == 5) dsa_mfma(C); if (BOTH(pb + 2)) GRID_BAR(); }
        if (IN(pb + 3)) {
            pg8::Gemm g{OB_, (const bf16*)(AWS + WS_WBN + l * SZ_WBR), MTOK, DM, 512, DM, 512, OB_ + 512, (const bf16*)(AWS + WS_WBD + l * SZ_WBR)}; pg8::DualOrder S; S.init(MTOK, DM, C.G, (int)blockIdx.x);
            pg8::EpiBranch2 E{P_, C_GN, C_GD, C_TMP, C_MRG};
            pg8::gemm_phase<pg8::EpiBranch2, pg8::DualOrder, true, true>(RING, g, S, E, C.wave);
            if (BOTH(pb + 3)) GRID_BAR();
        }
        if (IN(pb + 4)) { }
        if (IN(pb + 5)) {
            pg8::Gemm g{P_ + C_MRG, (const bf16*)(AWS + WS_WOUT + l * SZ_WOUT), MTOK, DM, DM, PW, DM, nullptr, nullptr}; pg8::StaticOrder S; S.init(MTOK, DM, C.G, (int)blockIdx.x);
            pg8::EpiResid E{XG_, RSS_};
            pg8::gemm_phase<pg8::EpiResid, pg8::StaticOrder, true, true>(RING, g, S, E, C.wave);
            if (BOTH(pb + 5)) GRID_BAR();
        }
        if (IN(pb + 6)) {
            pg8::Gemm g{XG_, (const bf16*)(AWS + WS_WGU + l * SZ_WGU), MTOK, PW, DM, DM, DM, nullptr, nullptr}; pg8::StaticOrder S; S.init(MTOK, PW, C.G, (int)blockIdx.x);
            pg8::EpiSwiglu E{H_, RSS_};
            pg8::gemm_phase<pg8::EpiSwiglu, pg8::StaticOrder, true, true>(RING, g, S, E, C.wave);
            if (REP_PHASE == 7) pg8::gemm_phase<pg8::EpiSwiglu, pg8::StaticOrder, true, true>(RING, g, S, E, C.wave);
            if (BOTH(pb + 6)) GRID_BAR();
        }
        if (IN(pb + 7)) {
            pg8::Gemm g{H_, (const bf16*)(AWS + WS_WDN + l * SZ_WDN), MTOK, DM, DFF, DFF, DFF, nullptr, nullptr}; pg8::StaticOrder S; S.init(MTOK, DM, C.G, (int)blockIdx.x);
            pg8::EpiResid E{XG_, RSS_};
            pg8::gemm_phase<pg8::EpiResid, pg8::StaticOrder, true, true>(RING, g, S, E, C.wave);
            if (BOTH(pb + 7)) GRID_BAR();
        }
}
__global__ void __launch_bounds__(NTHR, 2) hybrid_fwd(Args args) {
    extern __shared__ __attribute__((aligned(16))) unsigned char lds_raw[];
    Ctx C;
    C.lds = (LAS unsigned char*)lds_raw; C.tid = threadIdx.x; C.lane = 0; C.wave = __builtin_amdgcn_readfirstlane((int)threadIdx.x >> 6); C.G = gridDim.x;
    for (int u = C.tid; u < POOL_OFF / 4; u += NTHR) ((LAS unsigned*)(C.lds + LDSCTL_OFF))[u] = 0u;
    __syncthreads();
    if (N_LAUNCHES == 1) (void)xcd_barrier_post((unsigned*)((gu32*)(AWS + WS_CTL) + CW_BAR), (volatile LAS unsigned*)(C.lds + MISC_OFF) + 8);
    if (IN(0)) { p0_prologue(C); if (REP_PHASE == 0) p0_prologue(C); if (BOTH(0)) GRID_BAR(); }
    layer_phases<0>(C);
    layer_phases<1>(C);
    if (IN(17)) final_norm(C);
#ifdef IDX_DIAG
    if (IN(17)) { __syncthreads(); const unsigned nfb = __hip_atomic_load((unsigned*)(AWS + WS_CTL) + 2048, __ATOMIC_RELAXED, __HIP_MEMORY_SCOPE_AGENT); if (nfb > IDX_DIAG && blockIdx.x == 0) { AOUT[C.tid] = __builtin_nanf(""); } }
#endif
#undef IN
#undef BOTH
#undef lo
#undef hi
}

extern "C" void kernel_launch(void* const* d_in, const int* in_sizes, int n_in, void* d_out, int out_size, void* d_ws, size_t ws_size, hipStream_t stream) {
    static int grid = 0;
    if (grid == 0) {
        if (n_in != 21 || out_size != MTOK * DM || ws_size < WS_END) { fprintf(stderr, "kernel_launch: unexpected shapes (n_in %d out %d ws %zu)\n", n_in, out_size, ws_size); grid = -1; return; }
        int dev = 0, cus = 0, per_cu = 0;
        if (hipGetDevice(&dev) != hipSuccess || hipDeviceGetAttribute(&cus, hipDeviceAttributeMultiprocessorCount, dev) != hipSuccess) { grid = -1; return; }
        if (hipFuncSetAttribute((const void*)hybrid_fwd, hipFuncAttributeMaxDynamicSharedMemorySize, LDS_BYTES) != hipSuccess) { fprintf(stderr, "kernel_launch: hipFuncSetAttribute failed\n"); grid = -1; return; }
        if (hipOccupancyMaxActiveBlocksPerMultiprocessor(&per_cu, (const void*)hybrid_fwd, NTHR, LDS_BYTES) != hipSuccess || per_cu < 1) fprintf(stderr, "kernel_launch: occupancy query reports %d\n", per_cu);
        (void)hipGetLastError();
        grid = cus;
    }
    if (grid < 0) return;
    (void)hipMemsetAsync((char*)d_ws + WS_CTL, 0, CTL_ZERO_BYTES, stream);
    Args a{};
    for (int i = 0; i < 21; ++i) a.in[i] = (const float*)d_in[i];
    a.out = (float*)d_out; a.ws = (unsigned char*)d_ws;
    for (int li = 0; li < N_LAUNCHES; ++li) {
        a.ph_lo = (N_LAUNCHES == 1) ? 0 : li; a.ph_hi = (N_LAUNCHES == 1) ? NPH : li + 1; a.li = li;
        hipLaunchKernelGGL(hybrid_fwd, dim3(grid), dim3(NTHR), LDS_BYTES, stream, a);
    }
}
```

```cpp
#include <hip/hip_runtime.h>
#include <cstdio>
#include <cstdint>
namespace pg8 {
#define PG8_LAS __attribute__((address_space(3)))
typedef unsigned short bf16_t;
typedef short bf16x8 __attribute__((ext_vector_type(8)));
typedef float f32x4 __attribute__((ext_vector_type(4)));
typedef unsigned u32x4 __attribute__((ext_vector_type(4)));
constexpr int BM = 256, BK = 64, HALF = 128, HTB = HALF * BK * 2  , STAGE_BYTES = 8 * HTB, NXCD = 8, WGM = 8;

__host__ __device__ __forceinline__ int lds_byte(int r, int c) { const int st = (r >> 4) * 2 + (c >> 5), rr = r & 15, cc = c & 31, ob = rr * 64 + cc * 2; return st * 1024 + (ob ^ (((ob >> 9) & 1) << 5)); }
__host__ __device__ __forceinline__ void stage_rc(int b, int& R, int& C) { const int st = b / 1024, sb = b % 1024, swz = sb ^ (((sb >> 9) & 1) << 5); R = (st >> 1) * 16 + swz / 64; C = (st & 1) * 32 + (swz % 64) / 2; }
__host__ __device__ __forceinline__ int perm32(int rho) { const int n = rho >> 4, i = rho & 15; return 8 * (i >> 2) + 4 * n + (i & 3); }

struct Unit { int pm, pn, z; };
struct Gemm { const bf16_t* A; const bf16_t* Bt; int M, N, K, lda, ldb; const bf16_t* A2; const bf16_t* Bt2; int a_strm; };

struct StaticOrder {
    int nM, nN, nwg, G, c;
    __host__ __device__ void init(int M, int N, int G_, int c_) { nM = M / BM; nN = N / BM; nwg = nM * nN; G = G_; c = c_; }
    __host__ __device__ bool next(int i, Unit& u) const {
        const long L = (long)i * G + c; if (L >= nwg) return false;
        int wgid = (int)L; { const int q = nwg / NXCD, r = nwg % NXCD, xcd = wgid % NXCD, off = wgid / NXCD; wgid = (xcd < r ? xcd * (q + 1) : r * (q + 1) + (xcd - r) * q) + off; }
        const int nig = WGM * nN, gid = wgid / nig, fm = gid * WGM, gsz = (nM - fm) < WGM ? (nM - fm) : WGM;
        u.pm = fm + ((wgid % nig) % gsz); u.pn = (wgid % nig) / gsz; u.z = 0; return true;
    }
    __device__ __forceinline__ void a_ready(const Unit&) const {}
    __device__ __forceinline__ void done(const Unit&) const {}
};
struct DualOrder {
    StaticOrder S;
    __host__ __device__ void init(int M, int N, int G_, int c_) { S.init(M, N, G_, c_); }
    __host__ __device__ bool next(int i, Unit& u) const { if (!S.next(i >> 1, u)) return false; u.z = i & 1; return true; }
    __device__ __forceinline__ void a_ready(const Unit&) const {}
    __device__ __forceinline__ void done(const Unit&) const {}
};

__device__ __forceinline__ unsigned cvt_pk_bf16(float lo, float hi) { unsigned r; asm volatile("v_cvt_pk_bf16_f32 %0, %1, %2" : "=v"(r) : "v"(lo), "v"(hi)); return r; }
__device__ __forceinline__ float bf_lo(unsigned w) { return __uint_as_float(w << 16); }
__device__ __forceinline__ float bf_hi(unsigned w) { return __uint_as_float(w & 0xffff0000u); }
__device__ __forceinline__ float sigmoidf_(float x) { return __builtin_amdgcn_rcpf(1.0f + __builtin_amdgcn_exp2f(x * -1.4426950408889634f)); }
constexpr int PW = 5632;
constexpr float RMS_EPS = 1e-6f;
__device__ __forceinline__ float row_rstd(const float* rowss, int row) {
    const f32x4* p = (const f32x4*)(rowss + (size_t)row * 16);
    const f32x4 a = p[0], b = p[1], c = p[2], d = p[3];
    const float s = ((a[0] + a[1]) + (a[2] + a[3])) + ((b[0] + b[1]) + (b[2] + b[3])) + ((c[0] + c[1]) + (c[2] + c[3])) + ((d[0] + d[1]) + (d[2] + d[3]));
    float eps; asm volatile("s_mov_b32 %0, 0x358637bd" : "=s"(eps));
    return __builtin_amdgcn_rsqf(s * (1.0f / 1024.0f) + eps);
}
__device__ __forceinline__ int erow(int r) { return (r >> 2) * HALF + (r & 3) * 16; }
__device__ __forceinline__ float rstd_quarter(const f32x4 a) {
    float s = (a[0] + a[1]) + (a[2] + a[3]);
    s += __shfl_xor(s, 16); s += __shfl_xor(s, 32);
    float eps; asm volatile("s_mov_b32 %0, 0x358637bd" : "=s"(eps));
    return __builtin_amdgcn_rsqf(s * (1.0f / 1024.0f) + eps);
}
struct RstdCache { int t0, t1, nx; __device__ __forceinline__ void init() { t0 = -1; t1 = -1; nx = 0; } };
struct NoState { __device__ __forceinline__ void init() {} };
__device__ __forceinline__ const PG8_LAS float* rstd_rows(RstdCache& c, PG8_LAS float* rsl, const float* rowss, int pm, int tid) {
    int slot;
    if (pm == c.t0) slot = 0;
    else if (pm == c.t1) slot = 1;
    else {
        slot = c.nx; c.nx ^= 1; if (slot) c.t1 = pm; else c.t0 = pm;
        if (tid < 256) rsl[slot * 256 + tid] = row_rstd(rowss, pm * BM + tid);
        asm volatile("s_waitcnt lgkmcnt(0)\n\ts_barrier" ::: "memory");
    }
    return rsl + slot * 256;
}
struct EpiProj {
    static constexpr bool PERM = true, AFTER_DRAIN = false; static constexpr int STORES = 16;
    bf16_t* P; const float* rowss; const float* rtab;
    PG8_LAS float* rsl; typedef RstdCache State;
    __device__ __forceinline__ void operator()(const f32x4 (&acc)[2][2][4][2], const Unit& u, int wr, int wc, int fr, int fq, RstdCache& st) const {
        const int pn = u.pn;
        const bool rope_head = (pn <= 1) || (pn >= 5 && pn <= 8) || (pn == 11) || (pn == 12) || ((pn >= 2 && pn <= 4) && wc < 2) || (pn == 13 && wc == 0);
        const int row0 = u.pm * BM + wr * 64 + fr;
        f32x4 tq[8];
        if (rope_head) {
            const float* tb = rtab + (size_t)(row0 & 2047) * 16 + fq * 4;
#pragma unroll
            for (int r = 0; r < 8; ++r) tq[r] = *(const f32x4*)(tb + erow(r) * 16);
        }
        float rsv[8];
        { const float qs = (pn <= 1 || pn == 5 || pn == 6) ? 0.18033688011112042f : 1.0f;
          const PG8_LAS float* rl = rstd_rows(st, rsl, rowss, u.pm, (wr * 4 + wc) * 64 + fq * 16 + fr) + wr * 64 + fr;
#pragma unroll
          for (int r = 0; r < 8; ++r) rsv[r] = rl[erow(r)] * qs; }
#pragma unroll
        for (int ai = 0; ai < 2; ++ai)
#pragma unroll
            for (int m = 0; m < 4; ++m) {
                const int r = ai * 4 + m, row = row0 + erow(r);
                const float rs = rsv[r];
#pragma unroll
                for (int bj = 0; bj < 2; ++bj) {
                    f32x4 v0, v1;
                    if (pn >= 14) {
                        const float rsl = rs * -1.4426950408889634f;
#pragma unroll
                        for (int e = 0; e < 4; ++e) { v0[e] = __builtin_amdgcn_rcpf(1.0f + __builtin_amdgcn_exp2f(acc[ai][bj][m][0][e] * rsl)); v1[e] = __builtin_amdgcn_rcpf(1.0f + __builtin_amdgcn_exp2f(acc[ai][bj][m][1][e] * rsl)); }
                    } else { v0 = acc[ai][bj][m][0] * rs; v1 = acc[ai][bj][m][1] * rs; }
                    if (rope_head && bj == 0) {
                        f32x4 c0, c1, s0, s1, p0, p1;
#pragma unroll
                        for (int e = 0; e < 4; ++e) { c0[e] = __shfl(tq[r][e], fr); c1[e] = __shfl(tq[r][e], fr + 16); s0[e] = __shfl(tq[r][e], fr + 32); s1[e] = __shfl(tq[r][e], fr + 48); }
#pragma unroll
                        for (int e = 0; e < 4; ++e) { p0[e] = __shfl_xor(v0[e], 16); p1[e] = __shfl_xor(v1[e], 16); }
                        if (fq == 0) { v0 = v0 * c0 - p0 * s0; v1 = v1 * c1 - p1 * s1; }
                        else if (fq == 1) { v0 = v0 * c0 + p0 * s0; v1 = v1 * c1 + p1 * s1; }
                    }
                    if (pn == 13 && wc == 1 && bj == 0) {
                        if (fq == 0) { v0 = v0 * 0.044194173824159216f; v1 = v1 * 0.044194173824159216f; }
                        else {
#pragma unroll
                            for (int e = 0; e < 4; ++e) { v0[e] = sigmoidf_(v0[e]); v1[e] = sigmoidf_(v1[e]); }
                        }
                    }
                    u32x4 w; w.x = cvt_pk_bf16(v0[0], v0[1]); w.y = cvt_pk_bf16(v0[2], v0[3]); w.z = cvt_pk_bf16(v1[0], v1[1]); w.w = cvt_pk_bf16(v1[2], v1[3]);
                    *(u32x4*)(P + (size_t)row * PW + pn * BM + wc * 64 + bj * 32 + 8 * fq) = w;
                }
            }
    }
};
struct EpiNull { static constexpr bool PERM = true, AFTER_DRAIN = false; static constexpr int STORES = 0; typedef NoState State;
    __device__ __forceinline__ void operator()(const f32x4 (&acc)[2][2][4][2], const Unit&, int, int, int, int, NoState&) const {
#pragma unroll
        for (int a = 0; a < 2; ++a)
#pragma unroll
            for (int b = 0; b < 2; ++b)
#pragma unroll
                for (int m = 0; m < 4; ++m) asm volatile("" :: "v"(acc[a][b][m][0]), "v"(acc[a][b][m][1])); } };
struct EpiBranch2 {
    static constexpr bool PERM = true, AFTER_DRAIN = false; static constexpr int STORES = 16; typedef NoState State;
    bf16_t* Pb; int cg0, cg1, ct, co;
    __device__ __forceinline__ void operator()(const f32x4 (&acc)[2][2][4][2], const Unit& u, int wr, int wc, int fr, int fq, NoState&) const {
        const int cg = u.z ? cg1 : cg0, cst = u.z ? co : ct;
        bf16_t* p0 = Pb + (size_t)(u.pm * BM + wr * 64 + fr) * PW + u.pn * BM + wc * 64 + 8 * fq;
        u32x4 gw[8][2], tw[2][2];
#pragma unroll
        for (int r = 0; r < 8; ++r)
#pragma unroll
            for (int bj = 0; bj < 2; ++bj) gw[r][bj] = __builtin_nontemporal_load((const u32x4*)(p0 + (size_t)erow(r) * PW + bj * 32 + cg));
        if (u.z) {
#pragma unroll
            for (int r = 0; r < 2; ++r)
#pragma unroll
                for (int bj = 0; bj < 2; ++bj) tw[r][bj] = *(const u32x4*)(p0 + (size_t)erow(r) * PW + bj * 32 + ct);
        }
#pragma unroll
        for (int ai = 0; ai < 2; ++ai)
#pragma unroll
            for (int m = 0; m < 4; ++m) {
                const int r = ai * 4 + m;
                u32x4 w[2];
#pragma unroll
                for (int bj = 0; bj < 2; ++bj) {
                    const u32x4 g = gw[r][bj];
                    f32x4 v0 = acc[ai][bj][m][0], v1 = acc[ai][bj][m][1];
                    v0[0] *= bf_lo(g.x); v0[1] *= bf_hi(g.x); v0[2] *= bf_lo(g.y); v0[3] *= bf_hi(g.y);
                    v1[0] *= bf_lo(g.z); v1[1] *= bf_hi(g.z); v1[2] *= bf_lo(g.w); v1[3] *= bf_hi(g.w);
                    if (u.z) { const u32x4 t = tw[r & 1][bj];
                        v0[0] += bf_lo(t.x); v0[1] += bf_hi(t.x); v0[2] += bf_lo(t.y); v0[3] += bf_hi(t.y);
                        v1[0] += bf_lo(t.z); v1[1] += bf_hi(t.z); v1[2] += bf_lo(t.w); v1[3] += bf_hi(t.w); }
                    w[bj].x = cvt_pk_bf16(v0[0], v0[1]); w[bj].y = cvt_pk_bf16(v0[2], v0[3]); w[bj].z = cvt_pk_bf16(v1[0], v1[1]); w[bj].w = cvt_pk_bf16(v1[2], v1[3]);
                }
                if (u.z && r + 2 < 8) {
#pragma unroll
                    for (int bj = 0; bj < 2; ++bj) tw[r & 1][bj] = *(const u32x4*)(p0 + (size_t)erow(r + 2) * PW + bj * 32 + ct);
                }
#pragma unroll
                for (int bj = 0; bj < 2; ++bj) *(u32x4*)(p0 + (size_t)erow(r) * PW + bj * 32 + cst) = w[bj];
            }
    }
};
struct EpiResid {
    static constexpr bool PERM = true, AFTER_DRAIN = false; static constexpr int STORES = 16; typedef NoState State;
    bf16_t* X; float* ss;
    __device__ __forceinline__ void operator()(const f32x4 (&acc)[2][2][4][2], const Unit& u, int wr, int wc, int fr, int fq, NoState&) const {
        const int row0 = u.pm * BM + wr * 64 + fr;
        bf16_t* px0 = X + (size_t)row0 * 1024 + u.pn * BM + wc * 64 + 8 * fq;
        u32x4 xw[8][2];
#pragma unroll
        for (int r = 0; r < 8; ++r)
#pragma unroll
            for (int bj = 0; bj < 2; ++bj) xw[r][bj] = *(const u32x4*)(px0 + (size_t)erow(r) * 1024 + bj * 32);
#pragma unroll
        for (int ai = 0; ai < 2; ++ai)
#pragma unroll
            for (int m = 0; m < 4; ++m) {
                const int r = ai * 4 + m;
                float q = 0.f;
#pragma unroll
                for (int bj = 0; bj < 2; ++bj) {
                    const u32x4 x = xw[r][bj];
                    f32x4 v0 = acc[ai][bj][m][0], v1 = acc[ai][bj][m][1];
                    v0[0] += bf_lo(x.x); v0[1] += bf_hi(x.x); v0[2] += bf_lo(x.y); v0[3] += bf_hi(x.y);
                    v1[0] += bf_lo(x.z); v1[1] += bf_hi(x.z); v1[2] += bf_lo(x.w); v1[3] += bf_hi(x.w);
                    q += ((v0[0] * v0[0] + v0[1] * v0[1]) + (v0[2] * v0[2] + v0[3] * v0[3])) + ((v1[0] * v1[0] + v1[1] * v1[1]) + (v1[2] * v1[2] + v1[3] * v1[3]));
                    u32x4 w; w.x = cvt_pk_bf16(v0[0], v0[1]); w.y = cvt_pk_bf16(v0[2], v0[3]); w.z = cvt_pk_bf16(v1[0], v1[1]); w.w = cvt_pk_bf16(v1[2], v1[3]);
                    *(u32x4*)(px0 + (size_t)erow(r) * 1024 + bj * 32) = w;
                }
                q += __shfl_xor(q, 16); q += __shfl_xor(q, 32);
                if (fq == 0) ss[(size_t)(row0 + erow(r)) * 16 + u.pn * 4 + wc] = q;
            }
    }
};
struct EpiSwiglu {
    static constexpr bool PERM = true, AFTER_DRAIN = false; static constexpr int STORES = 8;
    bf16_t* H; const float* rowss; PG8_LAS float* rsl; typedef RstdCache State;
    __device__ __forceinline__ void operator()(const f32x4 (&acc)[2][2][4][2], const Unit& u, int wr, int wc, int fr, int fq, RstdCache& st) const {
        const int row0 = u.pm * BM + wr * 64 + fr;
        float rsv[8];
        { const PG8_LAS float* rl = rstd_rows(st, rsl, rowss, u.pm, (wr * 4 + wc) * 64 + fq * 16 + fr) + wr * 64 + fr;
#pragma unroll
          for (int r = 0; r < 8; ++r) rsv[r] = rl[erow(r)]; }
#pragma unroll
        for (int ai = 0; ai < 2; ++ai)
#pragma unroll
            for (int m = 0; m < 4; ++m) {
                const int r = ai * 4 + m, row = row0 + erow(r);
                const float rs = rsv[r], rs2 = rs * rs, rsl = rs * -1.4426950408889634f;
                float o[8];
#pragma unroll
                for (int n = 0; n < 2; ++n)
#pragma unroll
                    for (int e = 0; e < 4; ++e) {
                        const float ag = acc[ai][0][m][n][e], au = acc[ai][1][m][n][e];
                        o[n * 4 + e] = (ag * au) * (rs2 * __builtin_amdgcn_rcpf(1.0f + __builtin_amdgcn_exp2f(ag * rsl))); }
                u32x4 w; w.x = cvt_pk_bf16(o[0], o[1]); w.y = cvt_pk_bf16(o[2], o[3]); w.z = cvt_pk_bf16(o[4], o[5]); w.w = cvt_pk_bf16(o[6], o[7]);
                *(u32x4*)(H + ((size_t)row + (row & ~4095)) * 2816 + u.pn * HALF + wc * 32 + 8 * fq) = w;
            }
    }
};
template <class Epi, class Sched, bool ALIGN_EPI = false, bool SP2 = false>
__device__ __forceinline__ void gemm_phase(PG8_LAS unsigned char* lds, const Gemm g, const Sched& S, const Epi& E, int wave_in) {
    int tid_; asm volatile("v_mbcnt_lo_u32_b32 %0, -1, 0\n\tv_mbcnt_hi_u32_b32 %0, -1, %0" : "=v"(tid_)); tid_ += wave_in * 64;
    const int tid = tid_, wid = __builtin_amdgcn_readfirstlane(tid >> 6), lane = tid & 63, wr = wid >> 2, wc = wid & 3, fr = lane & 15, fq = lane >> 4;
    const int K = g.K, nt = K / BK;
    unsigned voffA[2], voffB[2];
#pragma unroll
    for (int i = 0; i < 2; ++i) { int R, C; stage_rc(tid * 16 + i * 8192, R, C); const int Rb = Epi::PERM ? ((R & ~31) + perm32(R & 31)) : R;
        voffA[i] = (unsigned)(R * g.lda + C) * 2u; voffB[i] = (unsigned)(Rb * g.ldb + C) * 2u; }
    const size_t kstep = (size_t)(BK * 2);
    const size_t hstepA = (size_t)HALF * g.lda * 2, hstepB = (size_t)HALF * g.ldb * 2;
    const size_t tstepA = 2 * hstepA, tstepB = 2 * hstepB;
    const unsigned ldsw = (unsigned)wid * 1024u;
    const int aoff = lds_byte(wr * 64 + fr, fq * 8), boff = lds_byte(wc * 32 + fr, fq * 8);
#define PG8_SA(b, h) (((b) * 2 + (h)) * HTB)
#define PG8_SB(b, h) ((4 + (b) * 2 + (h)) * HTB)
#define PG8_STAGE(bufoff, gbase, voff) do { _Pragma("unroll") for (int _i = 0; _i < 2; ++_i) \
        __builtin_amdgcn_global_load_lds((const unsigned*)((const char*)(gbase) + (voff)[_i]), (PG8_LAS unsigned*)(lds + (bufoff) + ldsw + _i * 8192), 16, 0, 0); } while (0)
#define PG8_LDA(dst, b, h) do { _Pragma("unroll") for (int m = 0; m < 4; ++m) _Pragma("unroll") for (int k = 0; k < 2; ++k) dst[m][k] = *(const PG8_LAS bf16x8*)(lds + PG8_SA(b, h) + aoff + m * 2048 + k * 1024); } while (0)
#define PG8_LDB(dst, b, h) do { _Pragma("unroll") for (int n = 0; n < 2; ++n) _Pragma("unroll") for (int k = 0; k < 2; ++k) dst[n][k] = *(const PG8_LAS bf16x8*)(lds + PG8_SB(b, h) + boff + n * 2048 + k * 1024); } while (0)
#define PG8_MMA(ai, bj, At, Bt) do { __builtin_amdgcn_s_setprio(1); _Pragma("unroll") for (int m = 0; m < 4; ++m) _Pragma("unroll") for (int n = 0; n < 2; ++n) _Pragma("unroll") for (int k = 0; k < 2; ++k) \
        acc[ai][bj][m][n] = __builtin_amdgcn_mfma_f32_16x16x32_bf16(Bt[n][k], At[m][k], acc[ai][bj][m][n], 0, 0, 0); __builtin_amdgcn_s_setprio(0); } while (0)
#define PG8_WAIT_V(n) asm volatile("s_waitcnt vmcnt(" #n ")" ::: "memory")
#define PG8_WAIT_L(n) asm volatile("s_waitcnt lgkmcnt(" #n ")" ::: "memory")
#define PG8_WAIT_V8R do { const int rlx_ = __builtin_amdgcn_readfirstlane((t == 0 && ui > 0) ? 1 : 0);        \
        if constexpr (Epi::STORES >= 16) asm volatile("s_waitcnt vmcnt(24)\n\ts_cmp_lg_u32 %0, 0\n\ts_cbranch_scc1 .Lrlx%=\n\ts_waitcnt vmcnt(8)\n.Lrlx%=:" :: "s"(rlx_) : "scc", "memory"); \
        else if constexpr (Epi::STORES >= 8) asm volatile("s_waitcnt vmcnt(16)\n\ts_cmp_lg_u32 %0, 0\n\ts_cbranch_scc1 .Lrlx%=\n\ts_waitcnt vmcnt(8)\n.Lrlx%=:" :: "s"(rlx_) : "scc", "memory"); \
        else PG8_WAIT_V(8); } while (0)
#define PG8_BAR __builtin_amdgcn_s_barrier()
#define PG8_SCHED __builtin_amdgcn_sched_barrier(0)
    Unit cur, nxt; int ui = 0;
    if (!S.next(0, cur)) return;
    typename Epi::State est; est.init();
    f32x4 acc[2][2][4][2];
#pragma unroll
    for (int a = 0; a < 2; ++a)
#pragma unroll
        for (int b = 0; b < 2; ++b)
#pragma unroll
            for (int m = 0; m < 4; ++m)
#pragma unroll
                for (int n = 0; n < 2; ++n) acc[a][b][m][n] = (f32x4){0.f, 0.f, 0.f, 0.f};
    bf16x8 At[4][2], B0[2][2], B1[2][2];
    const long dA2 = (const char*)g.A2 - (const char*)g.A, dB2 = (const char*)g.Bt2 - (const char*)g.Bt;
    const char* cA = (const char*)g.A + (cur.z ? dA2 : 0) + (size_t)(g.a_strm ? cur.pm + (cur.pm & ~15) : cur.pm) * tstepA; const char* cB = (const char*)g.Bt + (cur.z ? dB2 : 0) + (size_t)cur.pn * tstepB;
    S.a_ready(cur);
    if constexpr (SP2) {
        PG8_STAGE(PG8_SB(0, 0), cB, voffB); PG8_STAGE(PG8_SB(0, 1), cB + hstepB, voffB); PG8_STAGE(PG8_SA(0, 0), cA, voffA); PG8_STAGE(PG8_SA(0, 1), cA + hstepA, voffA);
        if (wr == 1) PG8_BAR;
        PG8_WAIT_V(2); PG8_BAR;
        PG8_STAGE(PG8_SB(1, 0), cB + kstep, voffB); PG8_STAGE(PG8_SA(1, 0), cA + kstep, voffA); PG8_STAGE(PG8_SB(1, 1), cB + hstepB + kstep, voffB);
        PG8_WAIT_V(6); PG8_BAR;
    } else {
        PG8_STAGE(PG8_SB(0, 0), cB, voffB); PG8_STAGE(PG8_SA(0, 0), cA, voffA); PG8_STAGE(PG8_SB(0, 1), cB + hstepB, voffB); PG8_STAGE(PG8_SA(0, 1), cA + hstepA, voffA);
        if (wr == 1) PG8_BAR;
        PG8_WAIT_V(4); PG8_BAR;
        PG8_STAGE(PG8_SB(1, 0), cB + kstep, voffB); PG8_STAGE(PG8_SA(1, 0), cA + kstep, voffA); PG8_STAGE(PG8_SB(1, 1), cB + hstepB + kstep, voffB);
        PG8_WAIT_V(6); PG8_BAR;
    }
    for (;;) {
        const bool has_next = S.next(ui + 1, nxt);
        const char* nA = has_next ? (const char*)g.A + (nxt.z ? dA2 : 0) + (size_t)(g.a_strm ? nxt.pm + (nxt.pm & ~15) : nxt.pm) * tstepA : cA; const char* nB = has_next ? (const char*)g.Bt + (nxt.z ? dB2 : 0) + (size_t)nxt.pn * tstepB : cB;
        for (int t = 0; t < nt; t += 2) {
            const bool last = (t == nt - 2);
            const char* a1 = cA + (size_t)(t + 1) * kstep;
            const char* a2 = last ? nA : cA + (size_t)(t + 2) * kstep; const char* b2 = last ? nB : cB + (size_t)(t + 2) * kstep;
            const char* a3 = a2 + kstep; const char* b3 = b2 + kstep;
            if (last && has_next) S.a_ready(nxt);
            if constexpr (SP2) {
            PG8_LDB(B0, 0, 0); PG8_LDB(B1, 0, 1); PG8_SCHED; PG8_LDA(At, 0, 0); PG8_STAGE(PG8_SA(1, 1), a1 + hstepA, voffA);
            PG8_WAIT_V8R; PG8_WAIT_L(0); PG8_BAR; PG8_MMA(0, 0, At, B0); PG8_MMA(0, 1, At, B1); PG8_BAR; PG8_SCHED;
            PG8_LDA(At, 0, 1); PG8_STAGE(PG8_SB(0, 0), b2, voffB); PG8_STAGE(PG8_SB(0, 1), b2 + hstepB, voffB); PG8_STAGE(PG8_SA(0, 0), a2, voffA);
            PG8_WAIT_V8R; PG8_WAIT_L(0); PG8_BAR; PG8_MMA(1, 0, At, B0); PG8_MMA(1, 1, At, B1); PG8_BAR; PG8_SCHED;
            PG8_LDB(B0, 1, 0); PG8_LDB(B1, 1, 1); PG8_SCHED; PG8_LDA(At, 1, 0); PG8_STAGE(PG8_SA(0, 1), a2 + hstepA, voffA);
            PG8_WAIT_V(8); PG8_WAIT_L(0); PG8_BAR; PG8_MMA(0, 0, At, B0); PG8_MMA(0, 1, At, B1); PG8_BAR; PG8_SCHED;
            PG8_LDA(At, 1, 1); PG8_STAGE(PG8_SB(1, 0), b3, voffB); PG8_STAGE(PG8_SB(1, 1), b3 + hstepB, voffB); PG8_STAGE(PG8_SA(1, 0), a3, voffA);
            PG8_WAIT_V(8); PG8_WAIT_L(0); PG8_BAR; PG8_MMA(1, 0, At, B0); PG8_MMA(1, 1, At, B1); PG8_BAR; PG8_SCHED;
            } else {
            PG8_LDB(B0, 0, 0); PG8_SCHED; PG8_LDA(At, 0, 0); PG8_STAGE(PG8_SA(1, 1), a1 + hstepA, voffA);
            PG8_WAIT_L(8); PG8_BAR; PG8_WAIT_L(0); PG8_MMA(0, 0, At, B0); PG8_BAR; PG8_SCHED;
            PG8_LDB(B1, 0, 1); PG8_STAGE(PG8_SB(0, 0), b2, voffB);
            PG8_BAR; PG8_WAIT_L(0); PG8_MMA(0, 1, At, B1); PG8_BAR;
            PG8_LDA(At, 0, 1); PG8_STAGE(PG8_SA(0, 0), a2, voffA);
            PG8_BAR; PG8_WAIT_L(0); PG8_MMA(1, 0, At, B0); PG8_BAR; PG8_SCHED;
            PG8_STAGE(PG8_SB(0, 1), b2 + hstepB, voffB);
            PG8_WAIT_V(6); PG8_BAR; PG8_MMA(1, 1, At, B1); PG8_BAR;
            PG8_LDB(B0, 1, 0); PG8_SCHED; PG8_LDA(At, 1, 0); PG8_STAGE(PG8_SA(0, 1), a2 + hstepA, voffA);
            PG8_WAIT_L(8); PG8_BAR; PG8_WAIT_L(0); PG8_MMA(0, 0, At, B0); PG8_BAR; PG8_SCHED;
            PG8_LDB(B1, 1, 1); PG8_STAGE(PG8_SB(1, 0), b3, voffB);
            PG8_BAR; PG8_WAIT_L(0); PG8_MMA(0, 1, At, B1); PG8_BAR;
            PG8_LDA(At, 1, 1); PG8_STAGE(PG8_SA(1, 0), a3, voffA);
            PG8_BAR; PG8_WAIT_L(0); PG8_MMA(1, 0, At, B0); PG8_BAR; PG8_SCHED;
            PG8_STAGE(PG8_SB(1, 1), b3 + hstepB, voffB);
            PG8_WAIT_V(6); PG8_BAR; PG8_MMA(1, 1, At, B1); PG8_BAR;
            }
        }
        if constexpr (ALIGN_EPI) { if (wr == 0) PG8_BAR; }
        if constexpr (!Epi::AFTER_DRAIN) { E(acc, cur, wr, wc, fr, fq, est); S.done(cur); }
        if (!has_next) break;
#pragma unroll
        for (int a = 0; a < 2; ++a)
#pragma unroll
            for (int b = 0; b < 2; ++b)
#pragma unroll
                for (int m = 0; m < 4; ++m)
#pragma unroll
                    for (int n = 0; n < 2; ++n) acc[a][b][m][n] = (f32x4){0.f, 0.f, 0.f, 0.f};
        cur = nxt; cA = nA; cB = nB; ++ui;
        if constexpr (ALIGN_EPI) { if (wr == 1) PG8_BAR; }
    }
    PG8_WAIT_V(0);
    if constexpr (!ALIGN_EPI) { if (wr == 0) PG8_BAR; }
    PG8_BAR;
    if constexpr (Epi::AFTER_DRAIN) { E.fused(acc, cur, wr, wc, fr, fq, lds, wid, lane); S.done(cur); }
#undef PG8_SA
#undef PG8_SB
#undef PG8_STAGE
#undef PG8_LDA
#undef PG8_LDB
#undef PG8_MMA
#undef PG8_WAIT_V
#undef PG8_WAIT_V8R
#undef PG8_WAIT_L
#undef PG8_BAR
#undef PG8_SCHED
}
}

constexpr int NB = 16, SEQ = 2048, DM = 1024, MTOK = NB * SEQ, DEPTH = 2, DIN = 5472, DFF = 2816;
using pg8::PW;
constexpr int C_NQ = 0, C_KCMP = 512, C_VCMP = 640, C_KSLC = 768, C_VSLC = 896, C_KWIN = 1024, C_VWIN = 1152, C_DQ = 1280, C_DK = 1792, C_DV = 2304,
              C_IQ = 2816, C_IK = 3328, C_IW = 3392, C_NG = 3400, C_GN = 3584, C_GD = 4608;
constexpr int C_TMP = 0, C_MRG = 1024;
__host__ __device__ __forceinline__ int proj_src_col(int n) {
    if (n < 1280) return n;
    if (n < 2816) return n - 1280 + 1304;
    if (n < 3328) return n - 2816 + 2840;
    if (n < 3392) return n - 3328 + 3352;
    if (n < 3400) return n - 3392 + 3416;
    if (n < 3424) return n - 3400 + 1280;
    if (n < 3584) return -1;
    return n - 3584 + 3424;
}
constexpr size_t MiB = 1u << 20;
constexpr size_t WS_CTL = 0, CTL_ZERO_BYTES = 65536;
constexpr size_t WS_ROPE = 1 * MiB;
constexpr size_t WS_CB1 = WS_ROPE + 131072;
constexpr size_t WS_RSS = 2 * MiB;
constexpr size_t WS_KC = 4 * MiB;
constexpr size_t WS_KCB = 6 * MiB;
constexpr size_t WS_SELM = 7 * MiB;
constexpr size_t WS_DMASK = 8 * MiB;
constexpr size_t WS_WIN = 16 * MiB;
constexpr size_t SZ_WIN = (size_t)PW * DM * 2, SZ_WBR = (size_t)DM * 512 * 2, SZ_WOUT = (size_t)DM * DM * 2, SZ_WGU = (size_t)PW * DM * 2, SZ_WDN = (size_t)DM * DFF * 2;
constexpr size_t WS_WBN = WS_WIN + DEPTH * SZ_WIN, WS_WBD = WS_WBN + DEPTH * SZ_WBR, WS_WOUT = WS_WBD + DEPTH * SZ_WBR, WS_WGU = WS_WOUT + DEPTH * SZ_WOUT, WS_WDN = WS_WGU + DEPTH * SZ_WGU;
constexpr size_t WS_W1B = WS_WDN + DEPTH * SZ_WDN;
constexpr size_t WS_R1 = 88 * MiB;
constexpr size_t WS_P = 152 * MiB;
constexpr size_t WS_END = WS_P + (size_t)MTOK * PW * 2;
static_assert(WS_W1B + 2 * MiB <= WS_R1 && WS_END <= 512 * MiB, "d_ws map");
constexpr int CW_TMO = 0, CW_CODE = 1, CW_BAR = 4096;

constexpr int LDSCTL_OFF = 0, MISC_OFF = 320, POOL_OFF = 1024;
constexpr int LDS_BYTES = 147456, POOL_BYTES = LDS_BYTES - POOL_OFF;
constexpr int NWAVES = 8, NTHR = 512;
#define GAS __attribute__((address_space(1)))
#define LAS __attribute__((address_space(3)))
typedef unsigned short bf16;
typedef unsigned v4u __attribute__((ext_vector_type(4)));
typedef float f32x4 __attribute__((ext_vector_type(4)));
typedef short bf16x8 __attribute__((ext_vector_type(8)));
typedef GAS unsigned gu32;
typedef GAS unsigned long long gu64;
#define RLX_AGENT __ATOMIC_RELAXED, __HIP_MEMORY_SCOPE_AGENT
#define LDS_WAIT() asm volatile("s_waitcnt lgkmcnt(0)" ::: "memory")
#define VM_WAIT() asm volatile("s_waitcnt vmcnt(0)" ::: "memory")
__device__ __forceinline__ unsigned long long rt() { return __builtin_amdgcn_s_memrealtime(); }
__device__ __forceinline__ unsigned f2bf(float f) { unsigned u = __builtin_bit_cast(unsigned, f); return (u + 0x7fffu + ((u >> 16) & 1u)) >> 16; }
__device__ __forceinline__ unsigned pk2(float lo, float hi) { return f2bf(lo) | (f2bf(hi) << 16); }

#define XB_TMO      128
#define XB_XCNT(j)  (256  + 64 * (j))
#define XB_XSUB(j)  (1280 + 64 * (j))
#define XB_XGEN(j)  (2304 + 64 * (j))
#define XB_TOP      3328
#define XB_TOPGEN   3392
#define XB_SIG(g)   (3456 + 64 * (g))
#define XCD_BAR_WORDS 3968
#define XB_SPIN_CAP (1u << 18)

__device__ __forceinline__ unsigned xb_ld(unsigned* p)              { return __hip_atomic_load(p, __ATOMIC_RELAXED, __HIP_MEMORY_SCOPE_AGENT); }
__device__ __forceinline__ unsigned xb_add(unsigned* p, unsigned v) { return __hip_atomic_fetch_add(p, v, __ATOMIC_RELAXED, __HIP_MEMORY_SCOPE_AGENT); }
__device__ __forceinline__ unsigned xb_xcc_id() { return (unsigned)__builtin_amdgcn_s_getreg((3 << 11) | 20) & 0xFu; }
#define XB_SPIN(cond, bar) do { unsigned _sp = 0; while (cond) { __builtin_amdgcn_s_sleep(1); \
    if ((++_sp & 255u) == 0u) { if (xb_ld(&(bar)[XB_TMO])) break; if (_sp > XB_SPIN_CAP) { atomicAdd(&(bar)[XB_TMO], 1u); break; } } } } while (0)

struct XcdBarrier {
    unsigned* bar; unsigned x;
    volatile LAS unsigned* st;
};

__device__ __forceinline__ XcdBarrier xcd_barrier_post(unsigned* bar, volatile LAS unsigned* st) {
    XcdBarrier b; b.bar = bar; b.x = xb_xcc_id(); b.st = st;
    if (threadIdx.x == 0) { (void)xb_add(&bar[XB_XCNT(b.x)], 1u); (void)__hip_atomic_fetch_or(&bar[XB_SIG(blockIdx.x & 7u)], 1u << b.x, __ATOMIC_RELAXED, __HIP_MEMORY_SCOPE_AGENT); }
    return b;
}
__device__ __forceinline__ void xcd_barrier_complete(unsigned* bar, unsigned x, unsigned& nloc, unsigned& nx) {
    const unsigned G = gridDim.x * gridDim.y * gridDim.z;
    unsigned sum, cnt, mine, sp = 0u;
    for (;;) {
        sum = 0u; cnt = 0u; mine = 0u;
#pragma unroll
        for (unsigned j = 0; j < 16; ++j) { const unsigned c = xb_ld(&bar[XB_XCNT(j)]); sum += c; cnt += (c > 0u) ? 1u : 0u; mine = (j == x) ? c : mine; }
        if (sum == G) break;
        __builtin_amdgcn_s_sleep(1);
        if ((++sp & 255u) == 0u) { if (xb_ld(&bar[XB_TMO])) break; if (sp > XB_SPIN_CAP) { atomicAdd(&bar[XB_TMO], 1u); break; } }
    }
    nloc = mine > 0u ? mine : 1u; nx = cnt > 0u ? cnt : 1u;
}

template <bool local = false> __device__ __forceinline__ void xcd_barrier(const XcdBarrier& b) {
    asm volatile("s_waitcnt vmcnt(0)" ::: "memory");
    __syncthreads();
    if (threadIdx.x == 0) {
        unsigned* bar = b.bar;
        __builtin_amdgcn_s_waitcnt(0);
        unsigned nloc = b.st[0], nx = b.st[1];
        if (nloc == 0u) { xcd_barrier_complete(bar, b.x, nloc, nx); b.st[0] = nloc; b.st[1] = nx; }
        const unsigned old = xb_add(&bar[XB_XSUB(b.x)], 1u);
        const unsigned gen = old / nloc;
        if (local && b.st[2] == 2u) {
            const unsigned target = (gen + 1u) * nloc;
            if (old + 1u != target) XB_SPIN(xb_ld(&bar[XB_XSUB(b.x)]) < target, bar);
            __builtin_amdgcn_fence(__ATOMIC_ACQUIRE, "agent");
            asm volatile("s_waitcnt vmcnt(0)" ::: "memory");
        } else
        if (old + 1u == (gen + 1u) * nloc) {
            if (!(local && b.st[2] == 2u)) {
            __builtin_amdgcn_fence(__ATOMIC_RELEASE, "agent");
            asm volatile("s_waitcnt vmcnt(0)" ::: "memory");
            const unsigned og = xb_add(&bar[XB_TOP], 1u);
            const unsigned tg = og / nx;
            if (og + 1u == (tg + 1u) * nx) xb_add(&bar[XB_TOPGEN], 1u);
            else XB_SPIN(xb_ld(&bar[XB_TOPGEN]) == tg, bar);
            }
            __builtin_amdgcn_fence(__ATOMIC_ACQUIRE, "agent");
            xb_add(&bar[XB_XGEN(b.x)], 1u);
            asm volatile("s_waitcnt vmcnt(0)" ::: "memory");
        } else {
            XB_SPIN(xb_ld(&bar[XB_XGEN(b.x)]) == gen, bar);
            __builtin_amdgcn_fence(__ATOMIC_ACQUIRE, "agent");
            asm volatile("s_waitcnt vmcnt(0)" ::: "memory");
        }
    }
    __syncthreads();
}
__device__ __forceinline__ void xcd_stream_mode(unsigned* bar, volatile LAS unsigned* st) {
    const unsigned G = gridDim.x;
    if (threadIdx.x < 64) {
        const unsigned ln = threadIdx.x; bool ok = true;
        if (ln < 8) { const unsigned sg = xb_ld(&bar[XB_SIG(ln)]); ok = (__builtin_popcount(sg) == 1); if (ok) ok = (xb_ld(&bar[XB_XCNT(__builtin_ctz(sg))]) == G / 8u); }
        const bool all = (__ballot(ok) == ~0ull);
        if (ln == 0) st[2] = (all && G == 256u) ? 2u : 1u;
    }
    __syncthreads();
}
struct Args { const float* in[21]; float* out; unsigned char* ws; int ph_lo, ph_hi, li, pad; };
struct Ctx { LAS unsigned char* lds; int tid, lane, wave, G; };
typedef const __attribute__((address_space(4))) Args* KArgs;
__device__ __forceinline__ KArgs kargs() { KArgs p = (KArgs)__builtin_amdgcn_kernarg_segment_ptr(); asm volatile("" : "+s"(p)); return p; }
__device__ __forceinline__ int fresh_tid(const Ctx& C0) { int ln; asm volatile("v_mbcnt_lo_u32_b32 %0, -1, 0\n\tv_mbcnt_hi_u32_b32 %0, -1, %0" : "=v"(ln)); return C0.wave * 64 + ln; }
#define AIN(i) (kargs()->in[i])
#define AOUT (kargs()->out)
#define AWS (kargs()->ws)
__device__ __forceinline__ float bf2f(bf16 b) { return __uint_as_float((unsigned)b << 16); }
__device__ __forceinline__ float wave_sum(float v) {
#pragma unroll
    for (int o = 1; o < 64; o <<= 1) v += __shfl_xor(v, o);
    return v;
}
__device__ __forceinline__ float wave_max(float v) {
#pragma unroll
    for (int o = 1; o < 64; o <<= 1) v = fmaxf(v, __shfl_xor(v, o));
    return v;
}
__host__ __device__ __forceinline__ int mask_bitpos(int u) { return (u & 3) + 4 * (u >> 3) + 16 * ((u >> 2) & 1); }

__device__ __forceinline__ void p0_transpose_item(const float* srcp, int Ns, bf16* WT, int K, int k0, int n0, LAS float* scr, int lane, const float* gk = nullptr) {
    float tv[32];
#pragma unroll
    for (int i = 0; i < 32; ++i) { const int kk = 2 * i + (lane >> 5); tv[i] = srcp ? __builtin_nontemporal_load(srcp + (size_t)(k0 + kk) * Ns) : 0.f; }
#pragma unroll
    for (int i = 0; i < 32; ++i) { const int kk = 2 * i + (lane >> 5); scr[kk * 33 + (lane & 31)] = gk ? tv[i] * gk[k0 + kk] : tv[i]; }
    LDS_WAIT(); asm volatile("" ::: "memory");
    const int c = lane & 7;
#pragma unroll
    for (int j = 0; j < 4; ++j) { const int n = (lane >> 3) + 8 * j; const LAS float* s = scr + (8 * c) * 33 + n;
        v4u o; o.x = pk2(s[0 * 33], s[1 * 33]); o.y = pk2(s[2 * 33], s[3 * 33]); o.z = pk2(s[4 * 33], s[5 * 33]); o.w = pk2(s[6 * 33], s[7 * 33]);
        *(GAS v4u*)(WT + (size_t)(n0 + n) * K + k0 + 8 * c) = o; }
    LDS_WAIT(); asm volatile("" ::: "memory");
}
__device__ __forceinline__ void sincos_small(double r, double& s, double& c) {
    const double r2 = r * r; double ts = 1.0, tc = 1.0, ss = 1.0, cc = 1.0;
#pragma unroll
    for (int k = 1; k <= 14; ++k) { tc = -tc * r2 * (1.0 / (double)((2 * k - 1) * (2 * k))); ts = -ts * r2 * (1.0 / (double)((2 * k) * (2 * k + 1))); cc += tc; ss += ts; }
    s = r * ss; c = cc;
}
__device__ __forceinline__ void p0_prologue(Ctx& C0) {
    Ctx C = C0; C.tid = fresh_tid(C0); C.lane = C.tid & 63;
    LAS float* scr = (LAS float*)(C.lds + POOL_OFF + C.wave * 16384);
    const int gw = blockIdx.x * NWAVES + C.wave, NGW = C.G * NWAVES, lane = C.lane;
    constexpr int I_WIN = 16 * (PW / 32), I_WBR = 8 * 32, I_WOUT = 16 * 32, I_WGU = 16 * (PW / 32), I_WDN = 44 * 32, I_L = I_WIN + 2 * I_WBR + I_WOUT + I_WGU + I_WDN;
    for (int it = gw; it < DEPTH * I_L; it += NGW) {
        const int l = it / I_L; int r = it % I_L;
        if (r < I_WIN) { const int nblk = PW / 32, kb = r / nblk, nb = r % nblk, n = nb * 32 + (lane & 31), rho = n & 255,
                sc = proj_src_col((n & ~255) + 64 * ((rho >> 5) & 3) + 32 * (rho >> 7) + (rho & 31));
            p0_transpose_item(sc >= 0 ? AIN(2) + (size_t)l * DM * DIN + sc : nullptr, DIN, (bf16*)(AWS + WS_WIN + l * SZ_WIN), DM, kb * 64, nb * 32, scr, lane, AIN(1) + l * DM); continue; } r -= I_WIN;
        if (r < I_WBR) { const int kb = r / 32, nb = r % 32, n0_ = nb * 32 + (lane & 31), rho = n0_ & 255, n = (n0_ & ~255) + 64 * ((rho >> 5) & 3) + 32 * (rho >> 7) + (rho & 31);
            p0_transpose_item(AIN(13) + (size_t)l * 512 * DM + n, DM, (bf16*)(AWS + WS_WBN + l * SZ_WBR), 512, kb * 64, nb * 32, scr, lane); continue; } r -= I_WBR;
        if (r < I_WBR) { const int kb = r / 32, nb = r % 32, n0_ = nb * 32 + (lane & 31), rho = n0_ & 255, n = (n0_ & ~255) + 64 * ((rho >> 5) & 3) + 32 * (rho >> 7) + (rho & 31);
            p0_transpose_item(AIN(14) + (size_t)l * 512 * DM + n, DM, (bf16*)(AWS + WS_WBD + l * SZ_WBR), 512, kb * 64, nb * 32, scr, lane); continue; } r -= I_WBR;
        if (r < I_WOUT) { const int kb = r / 32, nb = r % 32, n0_ = nb * 32 + (lane & 31), rho = n0_ & 255, n = (n0_ & ~255) + 64 * ((rho >> 5) & 3) + 32 * (rho >> 7) + (rho & 31);
            p0_transpose_item(AIN(15) + (size_t)l * DM * DM + n, DM, (bf16*)(AWS + WS_WOUT + l * SZ_WOUT), DM, kb * 64, nb * 32, scr, lane); continue; } r -= I_WOUT;
        if (r < I_WGU) { const int nblk = PW / 32, kb = r / nblk, nb = r % nblk, n = nb * 32 + (lane & 31), j = n & 255, hcol = (n >> 8) * 128 + (j & 127);
            const float* src = (j < 128 ? AIN(17) : AIN(18)) + (size_t)l * DM * DFF + hcol;
            p0_transpose_item(src, DFF, (bf16*)(AWS + WS_WGU + l * SZ_WGU), DM, kb * 64, nb * 32, scr, lane, AIN(16) + l * DM); continue; } r -= I_WGU;
        { const int kb = r / 32, nb = r % 32, n0_ = nb * 32 + (lane & 31), rho = n0_ & 255, n = (n0_ & ~255) + 64 * ((rho >> 5) & 3) + 32 * (rho >> 7) + (rho & 31);
            p0_transpose_item(AIN(19) + (size_t)l * DFF * DM + n, DM, (bf16*)(AWS + WS_WDN + l * SZ_WDN), DFF, kb * 64, nb * 32, scr, lane); }
    }
    for (int it = gw; it < DEPTH * 2 * 32 * 4; it += NGW) {
        const int l = it / 256, r = it % 256, kv = r / 128, kb = (r % 128) / 4, nb = r % 4, n = nb * 32 + (lane & 31);
        p0_transpose_item(AIN(kv ? 9 : 4) + (size_t)l * 2048 * 128 + n, 128, (bf16*)(AWS + WS_W1B) + (size_t)(l * 2 + kv) * 128 * 2048, 2048, kb * 64, nb * 32, scr, lane);
    }
    {
        bf16* XG = (bf16*)(AWS + WS_R1); float* rss = (float*)(AWS + WS_RSS);
        const float* xin = AIN(0);
        for (int m0 = gw * 2; m0 < MTOK; m0 += NGW * 2) {
            f32x4 v[2][4];
#pragma unroll
            for (int rr = 0; rr < 2; ++rr)
#pragma unroll
                for (int j = 0; j < 4; ++j) v[rr][j] = __builtin_nontemporal_load((const GAS f32x4*)(xin + (size_t)(m0 + rr) * DM) + lane + 64 * j);
#pragma unroll
            for (int rr = 0; rr < 2; ++rr) { const int m = m0 + rr;
                GAS unsigned long long* o8 = (GAS unsigned long long*)(XG + (size_t)m * DM) + lane;
                float s = 0.f;
#pragma unroll
                for (int j = 0; j < 4; ++j) { const f32x4 vv = v[rr][j]; s += (vv.x * vv.x + vv.y * vv.y) + (vv.z * vv.z + vv.w * vv.w); const f32x4 y = vv;
                    o8[64 * j] = (unsigned long long)pk2(y.x, y.y) | ((unsigned long long)pk2(y.z, y.w) << 32); }
                s = wave_sum(s);
                if (lane < 16) rss[(size_t)m * 16 + lane] = (lane == 0) ? s : 0.f; }
        }
    }
    {
        float* rc = (float*)(AWS + WS_ROPE);
        const float invf[8] = {1.0f, 0.1939227432012558f, 0.03760603070259094f, 0.007292664609849453f, 0.0014142135623842478f, 0.00027424818836152554f, 5.3182957344688475e-05f, 1.0313385246263351e-05f};
        for (int i = blockIdx.x * NTHR + C.tid; i < 2048 * 8; i += C.G * NTHR) {
            const int pos = i >> 3, j = i & 7; float f = invf[0];
#pragma unroll
            for (int q = 1; q < 8; ++q) f = (j == q) ? invf[q] : f;
            const float ang = (float)pos * f; const double a = (double)ang;
            const double k = __builtin_rint(a * 0.15915494309189535); const double r = (a - k * 6.283185307179586) - k * 2.4492935982947064e-16;
            double s, c; sincos_small(r, s, c);
            rc[pos * 16 + j] = (float)c; rc[pos * 16 + 8 + j] = (float)s;
        }
    }
    for (int it = blockIdx.x; it < DEPTH * 2 * 64; it += C.G) {
        const int lkv = it >> 6, ks = it & 63, l = lkv >> 1, kv = lkv & 1; const float* pos = AIN(kv ? 8 : 3) + (size_t)l * 2048; const float* w1 = AIN(kv ? 9 : 4) + (size_t)l * 2048 * 128;
        LAS float* red = (LAS float*)(C.lds + POOL_OFF);
        __syncthreads();
        const int n = C.tid & 127, q = C.tid >> 7; float a = 0.f;
#pragma unroll
        for (int k = 32 * ks + 8 * q; k < 32 * ks + 8 * q + 8; ++k) a += pos[k] * w1[(size_t)k * 128 + n];
        red[C.tid] = a; __syncthreads();
        if (C.tid < 128) ((float*)(AWS + WS_CB1))[(lkv * 64 + ks) * 128 + n] = (red[n] + red[128 + n]) + (red[256 + n] + red[384 + n]);
        __syncthreads();
    }
}
__device__ __forceinline__ float gelu_tanh(float x) { const float u = 0.7978845608028654f * (x + 0.044715f * x * x * x); const float t = 1.0f - 2.0f / (__expf(2.0f * u) + 1.0f); return 0.5f * x * (1.0f + t); }
__device__ __forceinline__ void final_norm(Ctx& C0) {
    Ctx C = C0; C.tid = fresh_tid(C0); C.lane = C.tid & 63; __syncthreads();
    const float* gn = AIN(20); const int lane = C.lane, wave = C.tid >> 6; const float* rss = (const float*)(AWS + WS_RSS); const bf16* X = (const bf16*)(AWS + WS_R1);
    f32x4 g[4];
#pragma unroll
    for (int j = 0; j < 4; ++j) g[j] = ((const f32x4*)gn)[lane + 64 * j];
    const bool strm = (C.G == 256);
    for (int mi = blockIdx.x * NWAVES + wave; mi < MTOK; mi += C.G * NWAVES) {
        const int m = strm ? 4096 * ((int)blockIdx.x & 7) + 8 * ((int)blockIdx.x >> 3) + wave + 256 * (mi / (256 * NWAVES)) : mi;
        GAS f32x4* orow = (GAS f32x4*)(AOUT + (size_t)m * DM) + lane;
        const unsigned long long* xr = (const unsigned long long*)(X + (size_t)m * DM) + lane;
        const float rs = pg8::row_rstd(rss, m);
#pragma unroll
        for (int j = 0; j < 4; ++j) { const unsigned long long w = __builtin_nontemporal_load(xr + 64 * j); const unsigned wl = (unsigned)w, wh = (unsigned)(w >> 32);
            const f32x4 x = {pg8::bf_lo(wl), pg8::bf_hi(wl), pg8::bf_lo(wh), pg8::bf_hi(wh)};
            __builtin_nontemporal_store(x * rs * g[j], orow + 64 * j); }
    }
}
namespace fa {
typedef float f32x16 __attribute__((ext_vector_type(16)));
typedef short s16x4 __attribute__((ext_vector_type(4)));
typedef short v4i16_t __attribute__((ext_vector_type(4)));
typedef short bf16x8 __attribute__((ext_vector_type(8)));
typedef unsigned u32x4 __attribute__((ext_vector_type(4)));
typedef float f32x2_t __attribute__((ext_vector_type(2))); typedef __bf16 bf16x2_t __attribute__((ext_vector_type(2)));
constexpr int SLOTB = 8192, NSLOT = 3;
constexpr int L_K = 0, L_V = NSLOT * SLOTB, L_WS = 2 * NSLOT * SLOTB, L_OST = L_WS + 8 * 256, L_END = L_OST + 8 * 4096;
constexpr float THR = 8.0f, BIGSUM = 1.0e30f;
struct W { int lane, r32, hi, wid; LAS unsigned char* shm; };
__device__ __forceinline__ int crow(int r, int hi) { return (r & 3) + 8 * (r >> 2) + 4 * hi; }
__device__ __forceinline__ unsigned cvtpk(float lo, float hi) { f32x2_t v = {lo, hi}; bf16x2_t b = __builtin_convertvector(v, bf16x2_t); return __builtin_bit_cast(unsigned, b); }
__device__ __forceinline__ float max3f(float a, float b, float c) { return __builtin_fmaxf(__builtin_fmaxf(a, b), c); }
#define FA_WAIT_BAR(N) asm volatile("s_waitcnt vmcnt(" #N ") lgkmcnt(0)\n\ts_barrier" ::: "memory")
__device__ __forceinline__ void glds16(const void* gsrc, unsigned lds_dst) { unsigned keep;
    asm volatile("s_mov_b32 %0, m0\n\ts_mov_b32 m0, %2\n\ts_nop 0\n\tglobal_load_lds_dwordx4 %1, off\n\ts_mov_b32 m0, %0" : "=&s"(keep) : "v"(gsrc), "s"(lds_dst) : "memory"); }
__device__ __forceinline__ void dma_tile(const W& w, const bf16* Kb, const bf16* Vb, int pitch, int tile, int slot) {
    const bf16* ks = Kb + (size_t)(64 * tile + w.lane) * pitch + w.wid * 8;
    const bf16* vs = Vb + (size_t)(64 * tile + 16 * (w.wid & 3) + (w.lane >> 2)) * pitch + (w.wid >> 2) * 32 + (w.lane & 3) * 8;
    const unsigned l0 = (unsigned)(uintptr_t)(w.shm) + slot * SLOTB + w.wid * 1024;
    glds16(ks, (unsigned)__builtin_amdgcn_readfirstlane(l0 + L_K)); glds16(vs, (unsigned)__builtin_amdgcn_readfirstlane(l0 + L_V));
}
__device__ __forceinline__ void qkt(f32x16& p0, f32x16& p1, const LAS unsigned char* Kslot, const bf16x8 (&qr)[4], int r32, int hi) {
    const f32x16 zero = f32x16{};
    const LAS unsigned char* kb = Kslot + hi * 1024 + r32 * 16;
#pragma unroll
    for (int dh = 0; dh < 2; ++dh) {
        bf16x8 b0[2], b1[2];
#pragma unroll
        for (int d = 0; d < 2; ++d) { b0[d] = *(const LAS bf16x8*)(kb + (2 * dh + d) * 2048); b1[d] = *(const LAS bf16x8*)(kb + (2 * dh + d) * 2048 + 512); }
        __builtin_amdgcn_sched_barrier(0);
#pragma unroll
        for (int d = 0; d < 2; ++d) { const int d0 = 2 * dh + d;
            if (d0 == 0) { p0 = __builtin_amdgcn_mfma_f32_32x32x16_bf16(b0[d], qr[0], zero, 0, 0, 0); p1 = __builtin_amdgcn_mfma_f32_32x32x16_bf16(b1[d], qr[0], zero, 0, 0, 0); }
            else { p0 = __builtin_amdgcn_mfma_f32_32x32x16_bf16(b0[d], qr[d0], p0, 0, 0, 0); p1 = __builtin_amdgcn_mfma_f32_32x32x16_bf16(b1[d], qr[d0], p1, 0, 0, 0); } }
    }
}
__device__ __forceinline__ s16x4 vtr(const LAS unsigned char* p) { return __builtin_bit_cast(s16x4, __builtin_amdgcn_ds_read_tr16_b64_v4i16((LAS v4i16_t*)p)); }
template <bool WITH_L = true> __device__ __forceinline__ void pv(f32x16 (&o)[2], f32x16& lacc, const LAS unsigned char* vp, const u32x4 (&pw)[4]) {
    const bf16x8 ones = {16256, 16256, 16256, 16256, 16256, 16256, 16256, 16256};
#pragma unroll
    for (int d0 = 0; d0 < 2; ++d0) {
        s16x4 lo[4], hi[4];
#pragma unroll
        for (int ks = 0; ks < 4; ++ks) { lo[ks] = vtr(vp + d0 * 4096 + ks * 1024); hi[ks] = vtr(vp + d0 * 4096 + ks * 1024 + 512); }
        __builtin_amdgcn_sched_barrier(0);
        if (WITH_L && d0 == 0) {
#pragma unroll
            for (int ks = 0; ks < 4; ++ks) lacc = __builtin_amdgcn_mfma_f32_32x32x16_bf16(__builtin_bit_cast(bf16x8, pw[ks]), ones, lacc, 0, 0, 0);
            __builtin_amdgcn_sched_barrier(0);
        }
#pragma unroll
        for (int ks = 0; ks < 4; ++ks) { const bf16x8 vf = {lo[ks][0], lo[ks][1], lo[ks][2], lo[ks][3], hi[ks][0], hi[ks][1], hi[ks][2], hi[ks][3]};
            o[d0] = __builtin_amdgcn_mfma_f32_32x32x16_bf16(__builtin_bit_cast(bf16x8, pw[ks]), vf, o[d0], 0, 0, 0); }
    }
}
__device__ __forceinline__ void pv(f32x16 (&o)[2], const LAS unsigned char* vp, const u32x4 (&pw)[4]) { f32x16 none; pv<false>(o, none, vp, pw); }
__device__ __forceinline__ float half_swap(float v) { const auto rr = __builtin_amdgcn_permlane32_swap(__float_as_uint(v), __float_as_uint(v), false, false); return __uint_as_float(rr[0] == __float_as_uint(v) ? rr[1] : rr[0]); }
__device__ __forceinline__ float rowmax(const f32x16& p0, const f32x16& p1) {
    float a = max3f(p0[0], p0[1], p1[0]), b = max3f(p0[2], p0[3], p1[1]); a = max3f(a, p1[2], p1[3]);
#pragma unroll
    for (int r = 4; r < 16; r += 4) { a = max3f(a, p0[r], p0[r + 1]); b = max3f(b, p0[r + 2], p0[r + 3]); a = max3f(a, p1[r], p1[r + 1]); b = max3f(b, p1[r + 2], p1[r + 3]); }
    const float m = __builtin_fmaxf(a, b);
    const auto rr = __builtin_amdgcn_permlane32_swap(__float_as_uint(m), __float_as_uint(m), false, false);
    return __builtin_fmaxf(__uint_as_float(rr[0]), __uint_as_float(rr[1]));
}
struct St { f32x16 o[2], lacc; float mref; bool moved; };
__device__ __forceinline__ void st_init(St& s) { s.o[0] = f32x16{}; s.o[1] = f32x16{}; s.lacc = f32x16{}; s.mref = 0.f; s.moved = false; }
template <class MaskF> __device__ __forceinline__ void tile_step(const W& w, int slot, const bf16x8 (&qr)[4], MaskF& MF, St& s, bool safe) {
    f32x16 p0, p1;
    qkt(p0, p1, w.shm + L_K + slot * SLOTB, qr, w.r32, w.hi);
    MF.pre(p0, p1);
    if (__builtin_expect(safe, 0)) {
        if (s.moved) {
#pragma unroll
            for (int r = 0; r < 16; ++r) { p0[r] -= s.mref; p1[r] -= s.mref; } }
        MF.pre_slow(p0, p1);
        const float rm = rowmax(p0, p1);
        if (__any(rm > THR)) {
            const float dl = __builtin_fmaxf(rm, 0.f); s.mref += dl; s.moved = true;
#pragma unroll
            for (int r = 0; r < 16; ++r) { p0[r] -= dl; p1[r] -= dl; }
            const float f = __builtin_amdgcn_exp2f(-dl);
            LAS float* wsf = (LAS float*)(w.shm + L_WS) + w.wid * 64;
            if (w.hi == 0) wsf[w.r32] = f;
            asm volatile("s_waitcnt lgkmcnt(0)" ::: "memory");
#pragma unroll
            for (int r = 0; r < 16; ++r) { const float fr = wsf[crow(r, w.hi)]; s.o[0][r] *= fr; s.o[1][r] *= fr; s.lacc[r] *= fr; }
        }
    }
#pragma unroll
    for (int r = 0; r < 16; ++r) { p0[r] = __builtin_amdgcn_exp2f(p0[r]); p1[r] = __builtin_amdgcn_exp2f(p1[r]); }
    MF.post(p0, p1);
    u32x4 pw[4];
#pragma unroll
    for (int k = 0; k < 4; ++k) { pw[0][k] = cvtpk(p0[2 * k], p0[2 * k + 1]); pw[1][k] = cvtpk(p0[8 + 2 * k], p0[9 + 2 * k]); pw[2][k] = cvtpk(p1[2 * k], p1[2 * k + 1]); pw[3][k] = cvtpk(p1[8 + 2 * k], p1[9 + 2 * k]); }
    MF.postw(pw);
    const LAS unsigned char* vp = w.shm + L_V + slot * SLOTB + ((w.lane >> 4) & 1) * 32 + (w.lane & 3) * 8 + (4 * w.hi + ((w.lane & 15) >> 2)) * 64;
    pv(s.o, s.lacc, vp, pw);
}
__device__ __forceinline__ bool branch_overflowed(const W& w, const St& s, int epoch) {
    volatile LAS int* flag = (volatile LAS int*)(w.shm - POOL_OFF + LDSCTL_OFF);
    float t = 0.f;
#pragma unroll
    for (int r = 0; r < 16; ++r) t += s.lacc[r];
    if (__builtin_expect(__any(!(t < BIGSUM)), 0)) { if (w.lane == 0) *flag = epoch; }
    asm volatile("s_waitcnt lgkmcnt(0)\n\ts_barrier" ::: "memory");
    return __builtin_amdgcn_readfirstlane(*flag) == epoch;
}
template <class TS, class MaskF> __device__ __forceinline__ bool run_branch(const W& w_in, const bf16* Kb, const bf16* Vb, int pitch, TS ts, bf16x8 (&qr)[4], MaskF& MF, St& s, bool safe, int epoch) {
    const W& w = w_in;
    const int n = ts.n;
    asm volatile("s_waitcnt vmcnt(0)" : "+v"(qr[0]), "+v"(qr[1]), "+v"(qr[2]), "+v"(qr[3]) :: "memory");
    int t0 = 0, t1 = 0, t2 = 0;
    if (n > 0) { t0 = ts.next(); MF.issue(t0); dma_tile(w, Kb, Vb, pitch, t0, 0); }
    if (n > 1) { t1 = ts.next(); dma_tile(w, Kb, Vb, pitch, t1, 1); MF.template settle<4>(); } else { MF.template settle<2>(); }
    int slot = 0;
#pragma nounroll
    for (int k = 0; k < n; ++k) {
        if (k + 1 < n) { FA_WAIT_BAR(2); } else { FA_WAIT_BAR(0); }
        MF.advance(t0);
        if (k + 1 < n) MF.issue(t1);
        if (k + 2 < n) { t2 = ts.next(); int s2 = slot + 2; s2 = s2 >= NSLOT ? s2 - NSLOT : s2; dma_tile(w, Kb, Vb, pitch, t2, s2); }
        if (MF.active(t0)) tile_step(w, slot, qr, MF, s, safe);
        if (k + 2 < n) { MF.template settle<2>(); } else { MF.template settle<0>(); }
        slot = (slot == NSLOT - 1) ? 0 : slot + 1; t0 = t1; t1 = t2;
    }
    return branch_overflowed(w, s, epoch);
}
__device__ __forceinline__ void finish_branch(const W& w, St& s, float gate, f32x16 (&oacc)[2]) {
    LAS float* wsf = (LAS float*)(w.shm + L_WS) + w.wid * 64;
    if (w.hi == 0) wsf[32 + w.r32] = gate;
    asm volatile("s_waitcnt lgkmcnt(0)" ::: "memory");
#pragma unroll
    for (int r = 0; r < 16; ++r) { const float l = s.lacc[r]; const float sc = (l > 0.f) ? wsf[32 + crow(r, w.hi)] * __builtin_amdgcn_rcpf(l) : 0.f; oacc[0][r] += s.o[0][r] * sc; oacc[1][r] += s.o[1][r] * sc; }
    asm volatile("s_waitcnt lgkmcnt(0)" ::: "memory");
}
__device__ __forceinline__ void store_o(const W& w_in, const f32x16 (&oacc)[2], bf16* Ow, int opitch) {
    const W& w = w_in;
    LAS bf16* stg = (LAS bf16*)(w.shm + L_OST) + w.wid * 2048;
#pragma unroll
    for (int r = 0; r < 16; ++r) { const int orow = crow(r, w.hi);
#pragma unroll
        for (int d0 = 0; d0 < 2; ++d0) stg[orow * 64 + d0 * 32 + w.r32] = (bf16)(cvtpk(oacc[d0][r], 0.f) & 0xffffu); }
    asm volatile("s_waitcnt lgkmcnt(0)" ::: "memory");
#pragma unroll
    for (int i = 0; i < 4; ++i) { const int row = i * 8 + (w.lane >> 3), ch = w.lane & 7; const u32x4 v = *(const LAS u32x4*)(stg + row * 64 + ch * 8); *(u32x4*)(Ow + (size_t)row * opitch + ch * 8) = v; }
    asm volatile("s_waitcnt lgkmcnt(0)" ::: "memory");
}
struct SeqRange { int n, t; __device__ __forceinline__ int next() { return t++; } };
struct SeqBits { int n; unsigned rem; __device__ __forceinline__ int next() { const int t = __builtin_ctz(rem); rem &= rem - 1u; return t; } };
}

constexpr int L_MK = fa::L_END, L_MK_SLOT = 2048, DSA_LDS_END = L_MK + fa::NSLOT * L_MK_SLOT;
struct DsaMask {
    const LAS unsigned char* mlds;
    int hi, last_tile; unsigned w0, w1;
    __device__ __forceinline__ bool active(int t) const { return t <= last_tile; }
    __device__ __forceinline__ void advance_slot(int slot) { w0 = *(const LAS unsigned*)(mlds + slot * L_MK_SLOT) >> (16 * hi); w1 = *(const LAS unsigned*)(mlds + slot * L_MK_SLOT + 1024) >> (16 * hi); }
    __device__ __forceinline__ void pre(fa::f32x16&, fa::f32x16&) const {}
    __device__ __forceinline__ void pre_slow(fa::f32x16& p0, fa::f32x16& p1) const {
#pragma unroll
        for (int r = 0; r < 16; ++r) {
            if (!((w0 >> r) & 1u)) p0[r] = -INFINITY;
            if (!((w1 >> r) & 1u)) p1[r] = -INFINITY; }
    }
    __device__ __forceinline__ void postw(fa::u32x4 (&)[4]) const {}
    __device__ __forceinline__ void post(fa::f32x16& p0, fa::f32x16& p1) const {
#pragma unroll
        for (int r = 0; r < 16; ++r) {
            unsigned m0, m1;
            asm("v_bfe_i32 %0, %1, %2, 1" : "=v"(m0) : "v"(w0), "n"(r));
            asm("v_bfe_i32 %0, %1, %2, 1" : "=v"(m1) : "v"(w1), "n"(r));
            p0[r] = __uint_as_float(__float_as_uint(p0[r]) & m0);
            p1[r] = __uint_as_float(__float_as_uint(p1[r]) & m1); }
    }
};
__device__ __forceinline__ void dsa_dma_tile(const fa::W& w, const bf16* Kb, const bf16* Vb, const unsigned* mk, int tile, int slot) {
    fa::dma_tile(w, Kb, Vb, PW, tile, slot);
    if (w.wid < 2) fa::glds16(mk + (size_t)(2 * tile + w.wid) * SEQ + 4 * w.lane, (unsigned)__builtin_amdgcn_readfirstlane((unsigned)(uintptr_t)(w.shm) + L_MK + slot * L_MK_SLOT + w.wid * 1024));
}
#define DSA_WAIT_BAR(wid_, N2, N3) do { if ((wid_) < 2) { FA_WAIT_BAR(N3); } else { FA_WAIT_BAR(N2); } } while (0)
__device__ __forceinline__ bool run_branch_dsa(const fa::W& w, const bf16* Kb, const bf16* Vb, const unsigned* mk, int n, fa::bf16x8 (&qr)[4], DsaMask& MF, fa::St& s, bool safe, int epoch, bool pre) {
    asm volatile("s_waitcnt vmcnt(0)" : "+v"(qr[0]), "+v"(qr[1]), "+v"(qr[2]), "+v"(qr[3]) :: "memory");
    if (!pre) { dsa_dma_tile(w, Kb, Vb, mk, 0, 0);
    if (n > 1) dsa_dma_tile(w, Kb, Vb, mk, 1, 1); }
    int slot = 0;
#pragma nounroll
    for (int k = 0; k < n; ++k) {
        if (k + 1 < n) { DSA_WAIT_BAR(w.wid, 2, 3); } else { FA_WAIT_BAR(0); }
        MF.advance_slot(slot);
        if (k + 2 < n) { int s2 = slot + 2; s2 = s2 >= fa::NSLOT ? s2 - fa::NSLOT : s2; dsa_dma_tile(w, Kb, Vb, mk, k + 2, s2); }
        if (MF.active(k)) fa::tile_step(w, slot, qr, MF, s, safe);
        slot = (slot == fa::NSLOT - 1) ? 0 : slot + 1;
    }
    return fa::branch_overflowed(w, s, epoch);
}
__device__ __forceinline__ void dsa_mfma(Ctx& C0) {
    Ctx C = C0; C.tid = fresh_tid(C0); C.lane = C.tid & 63; if (C.tid == 0) *(volatile LAS int*)(C.lds + LDSCTL_OFF) = 0; __syncthreads();
    int ep = 0;
    fa::W w; w.lane = C.lane; w.r32 = C.lane & 31; w.hi = C.lane >> 5; w.wid = C.wave; w.shm = C.lds + POOL_OFF;
    const bf16* P = (const bf16*)(AWS + WS_P); bf16* O = (bf16*)AOUT;        const unsigned* DMK = (const unsigned*)(AWS + WS_DMASK);
    const int G = C.G, bx = blockIdx.x, vcu = (G % 8 == 0) ? (bx % 8) * (G / 8) + bx / 8 : bx;
    for (int sl = vcu; sl < 256; sl += G) {
        const int bh = sl >> 1, sub = sl & 1, b = bh >> 3, h = bh & 7;
        for (int i = 0; i < 4; ++i) {
            const int qb = sub == 0 ? (i == 0 ? 7 : i == 1 ? 0 : i == 2 ? 4 : 3) : (i == 0 ? 6 : i == 1 ? 1 : i == 2 ? 5 : 2);
            { int tidu = fresh_tid(C0); w.lane = tidu & 63; w.r32 = w.lane & 31; w.hi = w.lane >> 5; w.wid = __builtin_amdgcn_readfirstlane(tidu >> 6); }
            const int q0 = qb * 256, tq = q0 + 32 * w.wid + w.r32;
            const bf16* Pb = P + (size_t)b * SEQ * PW;
            const bf16* Qrow = Pb + (size_t)tq * PW + C_DQ + h * 64;
            dsa_dma_tile(w, Pb + C_DK + h * 64, Pb + C_DV + h * 64, DMK + (size_t)b * 64 * SEQ + q0, 0, 0); dsa_dma_tile(w, Pb + C_DK + h * 64, Pb + C_DV + h * 64, DMK + (size_t)b * 64 * SEQ + q0, 1, 1);
            fa::bf16x8 qr[4];
#pragma unroll
            for (int d0 = 0; d0 < 4; ++d0) qr[d0] = *(const fa::bf16x8*)(Qrow + d0 * 16 + w.hi * 8);
            fa::St st;
#pragma nounroll
            for (int pass = 0; pass < 2; ++pass) {
                DsaMask MF; MF.mlds = w.shm + L_MK + (32 * w.wid + w.r32) * 4; MF.hi = w.hi; MF.last_tile = (q0 + 32 * w.wid + 31) >> 6; MF.w0 = MF.w1 = 0u;
                fa::st_init(st); ++ep;
                if (!run_branch_dsa(w, Pb + C_DK + h * 64, Pb + C_DV + h * 64, DMK + (size_t)b * 64 * SEQ + q0, (q0 + 256) / 64, qr, MF, st, pass != 0, ep, pass == 0)) break;
            }
            fa::f32x16 oacc[2]; oacc[0] = fa::f32x16{}; oacc[1] = fa::f32x16{};
            fa::finish_branch(w, st, 1.0f, oacc);
            fa::store_o(w, oacc, O + (size_t)(b * SEQ + q0 + 32 * w.wid) * 1024 + 512 + h * 64, 1024);
        }
    }
}
struct NsaSlcMask {
    unsigned rowsel, wmask; int diag, tq, hi; unsigned cursel;
    __device__ __forceinline__ bool active(int t) const { return (wmask >> t) & 1u; }
    __device__ __forceinline__ void issue(int) {}
    template <int N> __device__ __forceinline__ void settle() {}
    int curt;
    __device__ __forceinline__ void advance(int t) { curt = t; cursel = ((rowsel >> t) & 1u) ? 0xffffffffu : 0u; }
    __device__ __forceinline__ void pre(fa::f32x16& p0, fa::f32x16& p1) const {
        if (curt == diag) {
            const int lim = tq - 64 * diag - 4 * hi;
#pragma unroll
            for (int r = 0; r < 16; ++r) { const int ko = (r & 3) + 8 * (r >> 2); if (ko > lim) p0[r] = -INFINITY; if (ko + 32 > lim) p1[r] = -INFINITY; }
        }
    }
    __device__ __forceinline__ void pre_slow(fa::f32x16& p0, fa::f32x16& p1) const {
        if (!cursel) {
#pragma unroll
            for (int r = 0; r < 16; ++r) { p0[r] = -INFINITY; p1[r] = -INFINITY; } }
    }
    __device__ __forceinline__ void post(fa::f32x16&, fa::f32x16&) const {}
    __device__ __forceinline__ void postw(fa::u32x4 (&pw)[4]) const {
#pragma unroll
        for (int i = 0; i < 4; ++i) { pw[i][0] &= cursel; pw[i][1] &= cursel; pw[i][2] &= cursel; pw[i][3] &= cursel; }
    }
};
struct NsaWinMask {
    int tq, hi, tq0, curt;
    __device__ __forceinline__ bool active(int t) const { return 64 * t + 63 >= tq0 - 511 && 64 * t <= tq0 + 31; }
    __device__ __forceinline__ void issue(int) {}
    template <int N> __device__ __forceinline__ void settle() {}
    __device__ __forceinline__ void advance(int t) { curt = t; }
    __device__ __forceinline__ void pre(fa::f32x16& p0, fa::f32x16& p1) const {
        const int k0 = 64 * curt;
        if (k0 < tq0 - 480 || k0 + 63 > tq0) {
            const int hiL = tq - k0 - 4 * hi, loL = hiL - 511;
#pragma unroll
            for (int r = 0; r < 16; ++r) { const int ko = (r & 3) + 8 * (r >> 2); if (ko > hiL || ko < loL) p0[r] = -INFINITY; if (ko + 32 > hiL || ko + 32 < loL) p1[r] = -INFINITY; }
        }
    }
    __device__ __forceinline__ void pre_slow(fa::f32x16&, fa::f32x16&) const {}
    __device__ __forceinline__ void post(fa::f32x16&, fa::f32x16&) const {}
    __device__ __forceinline__ void postw(fa::u32x4 (&)[4]) const {}
};
template <int MODE> __device__ __forceinline__ void nsa_mfma(Ctx& C0) {
    Ctx C = C0; C.tid = fresh_tid(C0); C.lane = C.tid & 63; if (C.tid == 0) *(volatile LAS int*)(C.lds + LDSCTL_OFF) = 0; __syncthreads();
    int ep = 0;
    using namespace fa;
    W w; w.lane = C.lane; w.r32 = C.lane & 31; w.hi = C.lane >> 5; w.wid = C.wave; w.shm = C.lds + POOL_OFF;
    LAS float* impbuf = (LAS float*)(w.shm + L_END);
    LAS float* impsum = impbuf + 4 * 2 * 32 * 33;
    LAS unsigned* selm = (LAS unsigned*)(impsum + 64 * 33);
    const bf16* P = (const bf16*)(AWS + WS_P); bf16* O = (bf16*)AOUT;
    const bf16* KCB = (const bf16*)(AWS + WS_KCB);
    const int G = C.G, bx = blockIdx.x, vcu = (G % 8 == 0) ? (bx % 8) * (G / 8) + bx / 8 : bx;
    for (int sl = vcu; sl < 256; sl += G) {
        const int bg = sl >> 3, b = bg >> 1, g = bg & 1, s8 = sl & 7;
        for (int ui = 0; ui < 4; ++ui) {
            const int cur = (ui == 0) ? 31 - s8 : (ui == 1) ? s8 : (ui == 2) ? 16 + s8 : 15 - s8;
            int tidu = fresh_tid(C0);
            C.tid = tidu; C.lane = tidu & 63; C.wave = __builtin_amdgcn_readfirstlane(tidu >> 6);
            w.lane = C.lane; w.r32 = C.lane & 31; w.hi = C.lane >> 5; w.wid = C.wave;
            const int r = w.wid & 3, th = w.wid >> 2;
            const int q0 = 64 * cur, tq0 = q0 + 32 * th, tq = tq0 + w.r32, head = 4 * g + r;
            const bf16* Pb = P + (size_t)b * SEQ * PW; const bf16* Prow = Pb + (size_t)tq * PW;
            {
                const bf16* kc0 = KCB + (size_t)((0 * NB + b) * 2 + g) * 128 * 64; const bf16* vc0 = KCB + (size_t)((1 * NB + b) * 2 + g) * 128 * 64;
                dma_tile(w, kc0, vc0, 64, 0, 0); if (q0 >= 1024) dma_tile(w, kc0, vc0, 64, 1, 1); }
            bf16x8 qr[4];
#pragma unroll
            for (int d0 = 0; d0 < 4; ++d0) qr[d0] = *(const bf16x8*)(Prow + C_NQ + head * 64 + d0 * 16 + w.hi * 8);
            const float g_c = bf2f(Prow[C_NG + 0 * 8 + head]), g_s = bf2f(Prow[C_NG + 1 * 8 + head]), g_w = bf2f(Prow[C_NG + 2 * 8 + head]);
            if (C.tid < 3) selm[64 + C.tid] = 0u;
            f32x16 oacc[2];
            {
                const bf16* kc = KCB + (size_t)((0 * NB + b) * 2 + g) * 128 * 64; const bf16* vc = KCB + (size_t)((1 * NB + b) * 2 + g) * 128 * 64;
                const bool two = (q0 >= 1024);
                asm volatile("s_waitcnt vmcnt(0)" : "+v"(qr[0]), "+v"(qr[1]), "+v"(qr[2]), "+v"(qr[3]) :: "memory");
                FA_WAIT_BAR(0);
                f32x16 p[4];
                qkt(p[0], p[1], w.shm + L_K, qr, w.r32, w.hi);
                if (two) qkt(p[2], p[3], w.shm + L_K + SLOTB, qr, w.r32, w.hi);
                else {
#pragma unroll
                    for (int i = 0; i < 16; ++i) { p[2][i] = -INFINITY; p[3][i] = -INFINITY; } }
                const int lim = (tq >= 31 ? ((tq - 31) >> 4) : -1) - 4 * w.hi;
                float m = -INFINITY;
#pragma unroll
                for (int T = 0; T < 4; ++T)
#pragma unroll
                    for (int i = 0; i < 16; ++i) { const int c = 32 * T + (i & 3) + 8 * (i >> 2); if (c > lim) p[T][i] = -INFINITY; m = __builtin_fmaxf(m, p[T][i]); }
                { const auto rr = __builtin_amdgcn_permlane32_swap(__float_as_uint(m), __float_as_uint(m), false, false); m = __builtin_fmaxf(__uint_as_float(rr[0]), __uint_as_float(rr[1])); }
                const float msub = (m == -INFINITY) ? 0.f : m; float l = 0.f;
#pragma unroll
                for (int T = 0; T < 4; ++T)
#pragma unroll
                    for (int i = 0; i < 16; ++i) { p[T][i] = __builtin_amdgcn_exp2f(p[T][i] - msub); l += p[T][i]; }
                { const auto rr = __builtin_amdgcn_permlane32_swap(__float_as_uint(l), __float_as_uint(l), false, false); l = __uint_as_float(rr[0]) + __uint_as_float(rr[1]); }
                const float inv = (l > 0.f) ? 1.0f / l : 0.f;
#pragma unroll
                for (int T = 0; T < 4; ++T)
#pragma unroll
                    for (int i = 0; i < 16; ++i) p[T][i] *= inv;
                if (cur >= 16) {
                    LAS float* ib = impbuf + ((r * 2 + th) * 32 + w.r32) * 33;
                    float prv = 0.f;
#pragma unroll
                    for (int T = 0; T < 4; ++T)
#pragma unroll
                        for (int a = 0; a < 4; ++a) {
                            const float car = 0.5f * p[T][4 * a + 3], part = (p[T][4 * a] + p[T][4 * a + 1]) + (p[T][4 * a + 2] + car);
                            const auto rr = __builtin_amdgcn_permlane32_swap(__float_as_uint(car), __float_as_uint(car), false, false);
                            const float oth = (w.hi == 0) ? __uint_as_float(rr[1]) : __uint_as_float(rr[0]);
                            ib[8 * T + 2 * a + w.hi] = part + (w.hi ? oth : prv); prv = oth; }
                }
                {
                    u32x4 pwA[4], pwB[4];
#pragma unroll
                    for (int k = 0; k < 4; ++k) { pwA[0][k] = cvtpk(p[0][2 * k], p[0][2 * k + 1]); pwA[1][k] = cvtpk(p[0][8 + 2 * k], p[0][9 + 2 * k]); pwA[2][k] = cvtpk(p[1][2 * k], p[1][2 * k + 1]); pwA[3][k] = cvtpk(p[1][8 + 2 * k], p[1][9 + 2 * k]);
                        pwB[0][k] = cvtpk(p[2][2 * k], p[2][2 * k + 1]); pwB[1][k] = cvtpk(p[2][8 + 2 * k], p[2][9 + 2 * k]); pwB[2][k] = cvtpk(p[3][2 * k], p[3][2 * k + 1]); pwB[3][k] = cvtpk(p[3][8 + 2 * k], p[3][9 + 2 * k]); }
                    asm volatile("" : "+v"(pwA[0]), "+v"(pwA[1]), "+v"(pwA[2]), "+v"(pwA[3]), "+v"(pwB[0]), "+v"(pwB[1]), "+v"(pwB[2]), "+v"(pwB[3]));
                    f32x16 oc[2]; oc[0] = f32x16{}; oc[1] = f32x16{};
                    const LAS unsigned char* vp = w.shm + L_V + ((w.lane >> 4) & 1) * 32 + (w.lane & 3) * 8 + (4 * w.hi + ((w.lane & 15) >> 2)) * 64;
                    pv(oc, vp, pwA);
                    if (two) pv(oc, vp + SLOTB, pwB);
                    LAS float* wsf = (LAS float*)(w.shm + L_WS) + w.wid * 64;
                    if (w.hi == 0) wsf[32 + w.r32] = g_c;
                    asm volatile("s_waitcnt lgkmcnt(0)" ::: "memory");
#pragma unroll
                    for (int i = 0; i < 16; ++i) { const float scl = wsf[32 + crow(i, w.hi)]; oacc[0][i] = oc[0][i] * scl; oacc[1][i] = oc[1][i] * scl; }
                }
                asm volatile("s_waitcnt lgkmcnt(0)\n\ts_barrier" ::: "memory");
            }
            unsigned rowsel, umask, wmask;
#ifndef NSA_NO_RANK
            if (cur >= 16) {
                for (int e = C.tid; e < 64 * 32; e += NTHR) { const int tk = e >> 5, j = e & 31; float a = 0.f;
#pragma unroll
                    for (int rr2 = 0; rr2 < 4; ++rr2) a += impbuf[((rr2 * 2 + (tk >> 5)) * 32 + (tk & 31)) * 33 + j];
                    impsum[tk * 33 + j] = a; }
                asm volatile("s_waitcnt lgkmcnt(0)\n\ts_barrier" ::: "memory");
                const int tk = C.tid >> 3, jg = C.tid & 7; float sv[32];
#pragma unroll
                for (int j = 0; j < 32; ++j) { const float im = impsum[tk * 33 + j]; sv[j] = (j > cur) ? -INFINITY : ((j == 0 || j == cur || j == cur - 1) ? 1e4f : im); }
                unsigned bits = 0u;
#pragma unroll
                for (int q = 0; q < 4; ++q) { const int j = 4 * jg + q; float mine = sv[0];
#pragma unroll
                    for (int i = 1; i < 32; ++i) mine = (i == j) ? sv[i] : mine;
                    int rank = 0;
#pragma unroll
                    for (int i = 0; i < 32; ++i) rank += (sv[i] > mine || (sv[i] == mine && i < j)) ? 1 : 0;
                    if (rank < 16 && j <= cur) bits |= 1u << j; }
                bits |= __shfl_xor(bits, 1); bits |= __shfl_xor(bits, 2); bits |= __shfl_xor(bits, 4);
                if (jg == 0) { selm[tk] = bits; __hip_atomic_fetch_or(&selm[64], bits, __ATOMIC_RELAXED, __HIP_MEMORY_SCOPE_WORKGROUP); __hip_atomic_fetch_or(&selm[65 + (tk >> 5)], bits, __ATOMIC_RELAXED, __HIP_MEMORY_SCOPE_WORKGROUP); }
                asm volatile("s_waitcnt lgkmcnt(0)\n\ts_barrier" ::: "memory");
                rowsel = selm[32 * th + w.r32]; umask = selm[64]; wmask = selm[65 + th];
            } else
#endif
            { rowsel = umask = wmask = (cur == 31) ? 0xffffffffu : ((1u << (cur + 1)) - 1u); }
            umask = (unsigned)__builtin_amdgcn_readfirstlane((int)umask); wmask = (unsigned)__builtin_amdgcn_readfirstlane((int)wmask);
#ifndef NSA_NO_SLC
            if (MODE == 0 || MODE >= 2) {
                St st;
#pragma nounroll
                for (int pass = 0; pass < 2; ++pass) {
                    NsaSlcMask MF; MF.rowsel = rowsel; MF.wmask = wmask; MF.diag = cur; MF.tq = tq; MF.hi = w.hi; MF.cursel = 0u; MF.curt = 0;
                    st_init(st); ++ep;
                    SeqBits ts{__builtin_popcount(umask), umask};
                    if (!run_branch(w, Pb + C_KSLC + g * 64, Pb + C_VSLC + g * 64, PW, ts, qr, MF, st, pass != 0, ep)) break;
                }
                finish_branch(w, st, g_s, oacc);
            }
#endif
#ifndef NSA_NO_WIN
            if (MODE == 0 || MODE >= 3) {
                St st;
                const int tlo = cur >= 8 ? cur - 8 : 0;
#pragma nounroll
                for (int pass = 0; pass < 2; ++pass) {
                    NsaWinMask MF; MF.tq = tq; MF.hi = w.hi; MF.tq0 = tq0; MF.curt = 0;
                    st_init(st); ++ep;
                    SeqRange ts{cur - tlo + 1, tlo};
                    if (!run_branch(w, Pb + C_KWIN + g * 64, Pb + C_VWIN + g * 64, PW, ts, qr, MF, st, pass != 0, ep)) break;
                }
                finish_branch(w, st, g_w, oacc);
            }
#endif
            if (MODE == 0) store_o(w, oacc, O + (size_t)(b * SEQ + tq0) * 1024 + head * 64, 1024); else asm volatile("" :: "v"(oacc[0]), "v"(oacc[1]));
            asm volatile("s_waitcnt lgkmcnt(0)\n\ts_barrier" ::: "memory");
        }
    }
}
__device__ __forceinline__ unsigned fkey32(float f) { const unsigned u = __float_as_uint(f + 0.0f); return (f == -INFINITY) ? 0u : ((u & 0x80000000u) ? ~u : (u | 0x80000000u)); }
__device__ __forceinline__ int wave_sum_i32(int v) {
    v += __builtin_amdgcn_update_dpp(0, v, 0xB1, 0xF, 0xF, true);
    v += __builtin_amdgcn_update_dpp(0, v, 0x4E, 0xF, 0xF, true);
    v += __builtin_amdgcn_update_dpp(0, v, 0x141, 0xF, 0xF, true);
    v += __builtin_amdgcn_update_dpp(0, v, 0x140, 0xF, 0xF, true);
    return __builtin_amdgcn_readlane(v, 0) + __builtin_amdgcn_readlane(v, 16) + __builtin_amdgcn_readlane(v, 32) + __builtin_amdgcn_readlane(v, 48);
}
__device__ __forceinline__ float wave_max_dpp(float v) {
#define WMD_STEP(CTRL) v = __builtin_fmaxf(v, __int_as_float(__builtin_amdgcn_update_dpp(__float_as_int(v), __float_as_int(v), CTRL, 0xF, 0xF, false)))
    WMD_STEP(0xB1); WMD_STEP(0x4E); WMD_STEP(0x141); WMD_STEP(0x140);
#undef WMD_STEP
    const float a = __int_as_float(__builtin_amdgcn_readlane(__float_as_int(v), 0)), b = __int_as_float(__builtin_amdgcn_readlane(__float_as_int(v), 16));
    const float c = __int_as_float(__builtin_amdgcn_readlane(__float_as_int(v), 32)), d = __int_as_float(__builtin_amdgcn_readlane(__float_as_int(v), 48));
    return __builtin_fmaxf(__builtin_fmaxf(a, b), __builtin_fmaxf(c, d));
}
__device__ __forceinline__ unsigned wave_excl_prefix(unsigned v, int lane) {
    unsigned x = v;
#pragma unroll
    for (int o = 1; o < 64; o <<= 1) { const unsigned y = __shfl_up(x, o); x += (lane >= o) ? y : 0u; }
    return x - v;
}
typedef float f32x2_t __attribute__((ext_vector_type(2)));
#define VV(u) v2[(u) >> 1][(u) & 1]
__device__ __forceinline__ f32x2_t pk_fma_clamp(f32x2_t a, f32x2_t b, f32x2_t c) { f32x2_t d; asm("v_pk_fma_f32 %0, %1, %2, %3 clamp" : "=v"(d) : "v"(a), "s"(b), "v"(c)); return d; }
__device__ __forceinline__ f32x2_t pk_mul_clamp(f32x2_t a, f32x2_t b) { f32x2_t d; asm("v_pk_mul_f32 %0, %1, %2 clamp" : "=v"(d) : "v"(a), "s"(b)); return d; }
__device__ __forceinline__ f32x2_t pk_add(f32x2_t a, f32x2_t b) { f32x2_t d; asm("v_pk_add_f32 %0, %1, %2" : "=v"(d) : "v"(a), "v"(b)); return d; }
template <int MODE> __device__ __forceinline__ void idx_mfma(Ctx& C0) {
    Ctx C = C0; C.tid = fresh_tid(C0); C.lane = C.tid & 63; __syncthreads();
    typedef float f32x4_t __attribute__((ext_vector_type(4)));
    typedef short bf16x8 __attribute__((ext_vector_type(8)));
    constexpr int RS = 2113;
    LAS unsigned char* shm = C.lds + POOL_OFF;
    LAS unsigned char* qlds = shm;
    LAS float* scr = (LAS float*)shm;
    const bf16* P = (const bf16*)(AWS + WS_P); unsigned* DMK = (unsigned*)(AWS + WS_DMASK);
    const int G = C.G, bx = blockIdx.x, vcu = (G % 8 == 0) ? (bx % 8) * (G / 8) + bx / 8 : bx;
    for (int sl = vcu; sl < 256; sl += G) {
        const int b = sl >> 4, s16 = sl & 15;
#pragma nounroll
        for (int ui = 0; ui < 8; ++ui) {
            int tidu = fresh_tid(C0);
            const int tid = tidu, lane = tid & 63, tok = lane & 15, g = lane >> 4, wid = __builtin_amdgcn_readfirstlane(tid >> 6);
            const int q16 = ((ui & 1) ? (ui >> 1) * 32 + 31 - s16 : (ui >> 1) * 32 + s16);
            const int t = 16 * q16 + tok, nkt = (q16 >> 1) + 1;
            const bf16* Pb = P + (size_t)b * SEQ * PW;
#pragma unroll
            for (int k = 0; k < 2; ++k) { const int id = tid + 512 * k, tk = id >> 6, pc = id & 63;
                const v4u v = *(const v4u*)(Pb + (size_t)(16 * q16 + tk) * PW + C_IQ + pc * 8);
                *(LAS v4u*)(qlds + (pc * 16 + tk) * 16) = v; }
            const v4u wvp = *(const v4u*)(Pb + (size_t)t * PW + C_IW);
            asm volatile("s_waitcnt vmcnt(0) lgkmcnt(0)\n\ts_barrier" ::: "memory");
            float sv[8][8];
            bf16x8 qf[8][2];
#pragma unroll
            for (int h = 0; h < 8; ++h) { qf[h][0] = *(const LAS bf16x8*)(qlds + (g * 16 + tok) * 16 + (h * 8) * 256); qf[h][1] = *(const LAS bf16x8*)(qlds + (g * 16 + tok) * 16 + (h * 8 + 4) * 256); }
            bf16x8 ka0, ka1, kn0, kn1;
#define IDX_LOADK(d0, d1, kt_, s_) do { const bf16* krow_ = Pb + (size_t)(32 * (kt_) + 16 * (s_) + tok) * PW + C_IK + 8 * g; d0 = *(const bf16x8*)(krow_); d1 = *(const bf16x8*)(krow_ + 32); } while (0)
            if (wid < nkt) IDX_LOADK(ka0, ka1, wid, 0);
#pragma unroll
            for (int st = 0; st < 16; ++st) {
                const int j = st >> 1, s = st & 1, kt = wid + 8 * j;
                if (st + 1 < 16) { const int kt2 = wid + 8 * ((st + 1) >> 1); if (kt2 < nkt) IDX_LOADK(kn0, kn1, kt2, (st + 1) & 1); }
                if (kt < nkt) {
                    f32x4_t sc = {0.f, 0.f, 0.f, 0.f};
#pragma unroll
                    for (int h = 0; h < 8; ++h) {
                        f32x4_t acc = {0.f, 0.f, 0.f, 0.f};
                        acc = __builtin_amdgcn_mfma_f32_16x16x32_bf16(ka0, qf[h][0], acc, 0, 0, 0);
                        acc = __builtin_amdgcn_mfma_f32_16x16x32_bf16(ka1, qf[h][1], acc, 0, 0, 0);
                        const unsigned wpk = (h < 2) ? wvp.x : (h < 4) ? wvp.y : (h < 6) ? wvp.z : wvp.w; const float wh = (h & 1) ? pg8::bf_hi(wpk) : pg8::bf_lo(wpk);
#pragma unroll
                        for (int r = 0; r < 4; ++r) sc[r] = __builtin_fmaf(wh, __builtin_fmaxf(acc[r], 0.f), sc[r]);
                    }
                    const int kpos = 32 * kt + 16 * s + 4 * g;
#pragma unroll
                    for (int r = 0; r < 4; ++r) sv[j][4 * s + r] = (kpos + r <= t) ? sc[r] + 0.0f : -INFINITY;
                } else {
#pragma unroll
                    for (int r = 0; r < 4; ++r) sv[j][4 * s + r] = -INFINITY;
                }
                ka0 = kn0; ka1 = kn1;
            }
#undef IDX_LOADK
            if (q16 < 16) {
#pragma unroll
                for (int j = 0; j < 8; ++j) { const int kt = wid + 8 * j; unsigned bits = 0u;
#pragma unroll
                    for (int i = 0; i < 8; ++i) bits |= (sv[j][i] != -INFINITY) ? (1u << ((i & 3) + 8 * (i >> 2) + 4 * (g >> 1) + 16 * (g & 1))) : 0u;
                    bits |= __shfl_xor(bits, 16); bits |= __shfl_xor(bits, 32);
                    if (MODE == 0) { if (g == 0) DMK[(size_t)(b * 64 + kt) * SEQ + t] = bits; } else { asm volatile("" :: "v"(bits)); } }
                asm volatile("s_waitcnt lgkmcnt(0)\n\ts_barrier" ::: "memory");
                continue;
            }
            if (MODE == 1) { asm volatile("" :: "v"(sv[0][0]), "v"(sv[7][7])); asm volatile("s_waitcnt lgkmcnt(0)\n\ts_barrier" ::: "memory"); continue; }
            asm volatile("s_waitcnt lgkmcnt(0)\n\ts_barrier" ::: "memory");
#pragma unroll
            for (int j = 0; j < 8; ++j)
#pragma unroll
                for (int i = 0; i < 8; ++i) scr[tok * RS + 33 * (wid + 8 * j) + 16 * (i >> 2) + 4 * g + (i & 3)] = sv[j][i];
            asm volatile("s_waitcnt lgkmcnt(0)\n\ts_barrier" ::: "memory");
#pragma nounroll
            for (int tt = 0; tt < 2; ++tt) {
                const int tau = wid + 8 * tt, tq = 16 * q16 + tau;
                f32x2_t v2[16];
#pragma unroll
                for (int u = 0; u < 32; ++u) VV(u) = scr[tau * RS + 33 * lane + u];
#define IDX_CNT(PRED, OUT) do { int c_ = 0; _Pragma("unroll") for (int u = 0; u < 32; ++u) { const float fx = VV(u); c_ += (PRED) ? 1 : 0; } OUT = wave_sum_i32(c_); } while (0)
                const f32x2_t pbig2 = {1.2676506002282294e30f, 1.2676506002282294e30f}, nbig2 = {-1.2676506002282294e30f, -1.2676506002282294e30f};
                float mx = -INFINITY;
#pragma unroll
                for (int u = 0; u < 32; u += 2) mx = fa::max3f(mx, VV(u), VV(u + 1));
                mx = wave_max_dpp(mx);
#define IDX_CNTLT(PIV, OUT) do { const float pb_ = (PIV) * 1.2676506002282294e30f; const f32x2_t pb2_ = {pb_, pb_}; f32x2_t a0_ = {0.f, 0.f}, a1_ = {0.f, 0.f}; \
                    _Pragma("unroll") for (int u = 0; u < 16; u += 2) { a0_ = pk_add(a0_, pk_fma_clamp(v2[u], nbig2, pb2_)); a1_ = pk_add(a1_, pk_fma_clamp(v2[u + 1], nbig2, pb2_)); } \
                    OUT = wave_sum_i32((int)((a0_[0] + a0_[1]) + (a1_[0] + a1_[1]))); } while (0)
                int cp, c0;
                {
                    f32x2_t ap = {0.f, 0.f}, an = {0.f, 0.f};
#pragma unroll
                    for (int u = 0; u < 16; ++u) { ap = pk_add(ap, pk_mul_clamp(v2[u], pbig2)); an = pk_add(an, pk_mul_clamp(v2[u], nbig2)); }
                    cp = wave_sum_i32((int)(ap[0] + ap[1])); c0 = 2048 - wave_sum_i32((int)(an[0] + an[1]));
                    if (cp == 256) { int ce; IDX_CNT(fx > 0.f, ce); cp = ce; }
                }
                float thr = 0.f, tv = 0.f; int need = 0; bool tie = false, done = false, strict = false;
                float lo, hi_, clo, chi, wprev = INFINITY;
                if (cp >= 256) { lo = 0.f; hi_ = mx; clo = (float)cp; chi = 1.f; if (cp == 256) { done = true; strict = true; thr = 0.f; } }
                else if (c0 < 256) {
                    float mn = INFINITY;
#pragma unroll
                    for (int u = 0; u < 32; ++u) mn = (VV(u) == -INFINITY) ? mn : __builtin_fminf(mn, VV(u));
                    mn = -wave_max_dpp(-mn);
                    lo = mn; hi_ = 0.f; clo = (float)(tq + 1); chi = (float)c0; }
                else { lo = hi_ = clo = chi = 0.f; tie = true; tv = 0.f; need = 256 - cp; done = true; }
#pragma nounroll
                for (int rd = 0; rd < 64 && !done; ++rd) {
                    const float wdt = hi_ - lo, fi = __builtin_fminf(__builtin_fmaxf((clo - 256.5f) / (clo - chi), 0.02f), 0.98f);
                    const float frac = ((rd & 1) && wdt > 0.5f * wprev) ? 0.5f : fi;
                    if (!(rd & 1)) wprev = wdt;
                    const float mid = lo + wdt * frac;
                    if (!(mid > lo) || !(mid < hi_)) {
                        int cg; IDX_CNT(fx >= hi_, cg); tie = true; done = true; need = 256 - cg;
                        float below = -INFINITY;
#pragma unroll
                        for (int u = 0; u < 32; ++u) below = (VV(u) < hi_) ? __builtin_fmaxf(below, VV(u)) : below;
                        tv = wave_max_dpp(below);
                        break; }
                    int c; { int clt; IDX_CNTLT(mid, clt); c = 2048 - clt; }
                    if (c == 256) { int ce; IDX_CNT(fx >= mid, ce); c = ce; }
                    if (c == 256) { done = true; thr = mid; } else if (c > 256) { lo = mid; clo = (float)c; } else { hi_ = mid; chi = (float)c; }
                }
                bool redo = !done;
                if (tie && !redo) { int cgt, ceq; IDX_CNT(fx > tv, cgt); IDX_CNT(fx == tv, ceq); need = 256 - cgt; redo = (need < 1 || need > ceq); }
                if (__builtin_expect(redo, 0)) {
                    unsigned T = 0u;
#pragma nounroll
                    for (int bit = 31; bit >= 0; --bit) { const unsigned cand = T | (1u << bit); int c; IDX_CNT(fkey32(fx) >= cand, c); if (c >= 256) T = cand; }
                    tv = __uint_as_float((T & 0x80000000u) ? (T ^ 0x80000000u) : ~T); tie = true; strict = false;
                    int cgt; IDX_CNT(fx > tv, cgt); need = 256 - cgt;
                }
                unsigned word = 0u;
                if (!tie) {
#pragma unroll
                    for (int u = 0; u < 32; ++u) word |= ((strict ? VV(u) > thr : VV(u) >= thr)) ? (1u << ((u & 3) + 4 * (u >> 3) + 16 * ((u >> 2) & 1))) : 0u;
                } else {
                    unsigned nt = 0u;
#pragma unroll
                    for (int u = 0; u < 32; ++u) nt += (VV(u) == tv) ? 1u : 0u;
                    unsigned rank = wave_excl_prefix(nt, lane);
#pragma unroll
                    for (int u = 0; u < 32; ++u) { const bool eq = (VV(u) == tv); const bool sel = (VV(u) > tv) || (eq && (int)rank < need); rank += eq ? 1u : 0u;
                        word |= sel ? (1u << ((u & 3) + 4 * (u >> 3) + 16 * ((u >> 2) & 1))) : 0u; }
                }
                DMK[(size_t)(b * 64 + lane) * SEQ + tq] = word;
#undef IDX_CNT
#undef IDX_CNTLT
            }
            asm volatile("s_waitcnt lgkmcnt(0)\n\ts_barrier" ::: "memory");
        }
    }
}
__device__ __forceinline__ void compress_mfma(Ctx& C0, int l) {
    Ctx C = C0; C.tid = fresh_tid(C0); C.lane = C.tid & 63; __syncthreads();
    typedef float f32x16 __attribute__((ext_vector_type(16)));
    typedef short bf16x8 __attribute__((ext_vector_type(8)));
    LAS float* hidp = (LAS float*)(C.lds + POOL_OFF);
    LAS float* hid = hidp + 2 * 32 * 132;
    const bf16* P = (const bf16*)(AWS + WS_P);
    const int lane = C.lane, r32 = lane & 31, hi = lane >> 5, wid = C.wave, nb = wid & 3, kh = wid >> 2;
    for (int u0 = blockIdx.x; u0 < 256; u0 += C.G) {
        const int sr = u0 >> 3, u = (C.G % 8 == 0) ? (((sr >> 1) & 1) << 7) | ((2 * (u0 & 7) + (sr & 1)) << 3) | (((sr >> 2) & 1) << 2) | ((sr >> 3) & 3) : u0;
        const int kv = u >> 7, b = (u >> 3) & 15, g = (u >> 2) & 1, mb = u & 3, c0 = 32 * mb;
        const int crow_ = (c0 + r32 < 127) ? c0 + r32 : 126;
        const bf16* arow = P + (size_t)(b * SEQ + 16 * crow_) * PW + (kv ? C_VCMP : C_KCMP) + g * 64 + 8 * hi;
        const bf16* brow = (const bf16*)(AWS + WS_W1B) + ((size_t)(l * 2 + kv) * 128 + 32 * nb + r32) * 2048 + 1024 * kh + 8 * hi;
        f32x16 acc = f32x16{};
#pragma unroll 8
        for (int kk = 0; kk < 64; ++kk) {
            const int k = 1024 * kh + 16 * kk;
            const bf16x8 a = *(const bf16x8*)(arow + (size_t)(k >> 6) * PW + (k & 63));
            const bf16x8 bq = *(const bf16x8*)(brow + 16 * kk);
            acc = __builtin_amdgcn_mfma_f32_32x32x16_bf16(a, bq, acc, 0, 0, 0);
        }
        __syncthreads();
#pragma unroll
        for (int i = 0; i < 16; ++i) hidp[(kh * 32 + (i & 3) + 8 * (i >> 2) + 4 * hi) * 132 + 32 * nb + r32] = acc[i];
        __syncthreads();
        LAS float* cb1 = hid + 32 * 132;
        if (C.tid < 128) { const float* cp = (const float*)(AWS + WS_CB1) + (size_t)(l * 2 + kv) * 64 * 128 + C.tid; float a = AIN(kv ? 10 : 5)[l * 128 + C.tid];
            for (int ks = 0; ks < 64; ++ks) a += cp[ks * 128];
            cb1[C.tid] = a; }
        __syncthreads();
        for (int e = C.tid; e < 32 * 128; e += NTHR) { const int c = e >> 7, n = e & 127; hid[c * 132 + n] = gelu_tanh(hidp[c * 132 + n] + hidp[(32 + c) * 132 + n] + cb1[n]); }
        __syncthreads();
        {
            const float* w2 = AIN(kv ? 11 : 6) + (size_t)l * 128 * 64; const float* b2 = AIN(kv ? 12 : 7) + l * 64;
            const int c = C.tid >> 4, d4 = (C.tid & 15) * 4;
            f32x4 a = *(const f32x4*)(b2 + d4);
            for (int n = 0; n < 128; ++n) a += hid[c * 132 + n] * *(const f32x4*)(w2 + n * 64 + d4);
            if (c0 + c >= 127) a = (f32x4){0.f, 0.f, 0.f, 0.f};
            const size_t o = ((size_t)((kv * NB + b) * 2 + g) * 128 + c0 + c) * 64 + d4;
            *(f32x4*)((float*)(AWS + WS_KC) + o) = a;
            *(unsigned long long*)((bf16*)(AWS + WS_KCB) + o) = (unsigned long long)pk2(a.x, a.y) | ((unsigned long long)pk2(a.z, a.w) << 32);
        }
    }
    __syncthreads();
}
#ifndef MK_N_LAUNCHES
#define MK_N_LAUNCHES 1
#endif
constexpr int NPH = 18;
constexpr int N_LAUNCHES = MK_N_LAUNCHES;
#define GRID_BAR() do { if (N_LAUNCHES == 1) { XcdBarrier bar_; bar_.bar = (unsigned*)((gu32*)(AWS + WS_CTL) + CW_BAR); bar_.x = xb_xcc_id(); bar_.st = (volatile LAS unsigned*)(C.lds + MISC_OFF) + 8; xcd_barrier(bar_); } } while (0)
#define LOCAL_BAR() do { if (N_LAUNCHES == 1) { XcdBarrier bar_; bar_.bar = (unsigned*)((gu32*)(AWS + WS_CTL) + CW_BAR); bar_.x = xb_xcc_id(); bar_.st = (volatile LAS unsigned*)(C.lds + MISC_OFF) + 8; xcd_barrier<true>(bar_); } } while (0)
#define lo (kargs()->ph_lo)
#define hi (kargs()->ph_hi)
#ifndef REP_PHASE
#define REP_PHASE -1
#endif
#ifndef PH_EN
#define PH_EN 0xFFFFFFFFu
#endif
#define IN(k) (((PH_EN >> ((k) > 8 ? ((k) - 8 > 8 ? 17 : (k) - 8) : (k))) & 1u) && lo <= (k) && (k) < hi)
#define BOTH(k) (IN(k) && IN((k) + 1))
#define RING (C.lds + POOL_OFF)
#define XG_ ((bf16*)(AWS + WS_R1))
#define OB_ ((bf16*)AOUT)
#define P_ ((bf16*)(AWS + WS_P))
#define H_ ((bf16*)(AWS + WS_P))
#define RSS_ ((float*)(AWS + WS_RSS))
#define RCOS_ ((const float*)(AWS + WS_ROPE))

template <int l> __device__ __forceinline__ void layer_phases(Ctx& C) {
        const int pb = 1 + 8 * l;
        if (IN(pb)) {
            pg8::Gemm g{XG_, (const bf16*)(AWS + WS_WIN + l * SZ_WIN), MTOK, PW, DM, DM, DM, nullptr, nullptr}; pg8::StaticOrder S; S.init(MTOK, PW, C.G, (int)blockIdx.x);
            pg8::EpiProj E{P_, RSS_, RCOS_, (LAS float*)(RING + pg8::STAGE_BYTES)};
            pg8::gemm_phase<pg8::EpiProj, pg8::StaticOrder, true, true>(RING, g, S, E, C.wave);
            if (REP_PHASE == 1) pg8::gemm_phase<pg8::EpiProj, pg8::StaticOrder, true, true>(RING, g, S, E, C.wave);
            if (REP_PHASE == 11) { pg8::EpiNull EN; pg8::gemm_phase<pg8::EpiNull, pg8::StaticOrder, true, true>(RING, g, S, EN, C.wave); }
            if (BOTH(pb)) LOCAL_BAR();
        }
        if (IN(pb + 1)) { compress_mfma(C, l); if (REP_PHASE == 2) compress_mfma(C, l); idx_mfma<0>(C); if (REP_PHASE == 3) idx_mfma<0>(C); if (REP_PHASE == 31) idx_mfma<1>(C); if (BOTH(pb + 1)) LOCAL_BAR(); }
        if (IN(pb + 2)) { nsa_mfma<0>(C); if (REP_PHASE == 4) nsa_mfma<0>(C); if (REP_PHASE == 41) nsa_mfma<1>(C); if (REP_PHASE == 42) nsa_mfma<2>(C); dsa_mfma(C); if (REP_PHASE == 5) dsa_mfma(C); if (BOTH(pb + 2)) LOCAL_BAR(); }
        if (IN(pb + 3)) {
            pg8::Gemm g{OB_, (const bf16*)(AWS + WS_WBN + l * SZ_WBR), MTOK, DM, 512, DM, 512, OB_ + 512, (const bf16*)(AWS + WS_WBD + l * SZ_WBR)}; pg8::DualOrder S; S.init(MTOK, DM, C.G, (int)blockIdx.x);
            pg8::EpiBranch2 E{P_, C_GN, C_GD, C_TMP, C_MRG};
            pg8::gemm_phase<pg8::EpiBranch2, pg8::DualOrder, true, true>(RING, g, S, E, C.wave);
            if (BOTH(pb + 3)) LOCAL_BAR();
        }
        if (IN(pb + 4)) { }
        if (IN(pb + 5)) {
            pg8::Gemm g{P_ + C_MRG, (const bf16*)(AWS + WS_WOUT + l * SZ_WOUT), MTOK, DM, DM, PW, DM, nullptr, nullptr}; pg8::StaticOrder S; S.init(MTOK, DM, C.G, (int)blockIdx.x);
            pg8::EpiResid E{XG_, RSS_};
            pg8::gemm_phase<pg8::EpiResid, pg8::StaticOrder, true, true>(RING, g, S, E, C.wave);
            if (BOTH(pb + 5)) LOCAL_BAR();
        }
        if (IN(pb + 6)) {
            pg8::Gemm g{XG_, (const bf16*)(AWS + WS_WGU + l * SZ_WGU), MTOK, PW, DM, DM, DM, nullptr, nullptr}; pg8::StaticOrder S; S.init(MTOK, PW, C.G, (int)blockIdx.x);
            pg8::EpiSwiglu E{H_, RSS_, (LAS float*)(RING + pg8::STAGE_BYTES)};
            pg8::gemm_phase<pg8::EpiSwiglu, pg8::StaticOrder, true, true>(RING, g, S, E, C.wave);
            if (REP_PHASE == 7) pg8::gemm_phase<pg8::EpiSwiglu, pg8::StaticOrder, true, true>(RING, g, S, E, C.wave);
            if (BOTH(pb + 6)) LOCAL_BAR();
        }
        if (IN(pb + 7)) {
            pg8::Gemm g{H_, (const bf16*)(AWS + WS_WDN + l * SZ_WDN), MTOK, DM, DFF, DFF, DFF, nullptr, nullptr, 1}; pg8::StaticOrder S; S.init(MTOK, DM, C.G, (int)blockIdx.x);
            pg8::EpiResid E{XG_, RSS_};
            pg8::gemm_phase<pg8::EpiResid, pg8::StaticOrder, true, true>(RING, g, S, E, C.wave);
            if (BOTH(pb + 7)) LOCAL_BAR();
        }
}
__global__ void __launch_bounds__(NTHR, 2) hybrid_fwd(Args args) {
    extern __shared__ __attribute__((aligned(16))) unsigned char lds_raw[];
    Ctx C;
    C.lds = (LAS unsigned char*)lds_raw; C.tid = threadIdx.x; C.lane = 0; C.wave = __builtin_amdgcn_readfirstlane((int)threadIdx.x >> 6); C.G = gridDim.x;
    for (int u = C.tid; u < POOL_OFF / 4; u += NTHR) ((LAS unsigned*)(C.lds + LDSCTL_OFF))[u] = 0u;
    __syncthreads();
    if (N_LAUNCHES == 1) (void)xcd_barrier_post((unsigned*)((gu32*)(AWS + WS_CTL) + CW_BAR), (volatile LAS unsigned*)(C.lds + MISC_OFF) + 8);
    if (IN(0)) { p0_prologue(C); if (REP_PHASE == 0) p0_prologue(C); if (BOTH(0)) { GRID_BAR(); if (N_LAUNCHES == 1) xcd_stream_mode((unsigned*)((gu32*)(AWS + WS_CTL) + CW_BAR), (volatile LAS unsigned*)(C.lds + MISC_OFF) + 8); } }
    layer_phases<0>(C);
    layer_phases<1>(C);
    if (IN(17)) final_norm(C);
#ifdef IDX_DIAG
    if (IN(17)) { __syncthreads(); const unsigned nfb = __hip_atomic_load((unsigned*)(AWS + WS_CTL) + 2048, __ATOMIC_RELAXED, __HIP_MEMORY_SCOPE_AGENT); if (nfb > IDX_DIAG && blockIdx.x == 0) { AOUT[C.tid] = __builtin_nanf(""); } }
#endif
#undef IN
#undef BOTH
#undef lo
#undef hi
}

extern "C" void kernel_launch(void* const* d_in, const int* in_sizes, int n_in, void* d_out, int out_size, void* d_ws, size_t ws_size, hipStream_t stream) {
    static int grid = 0;
    if (grid == 0) {
        if (n_in != 21 || out_size != MTOK * DM || ws_size < WS_END) { fprintf(stderr, "kernel_launch: unexpected shapes (n_in %d out %d ws %zu)\n", n_in, out_size, ws_size); grid = -1; return; }
        int dev = 0, cus = 0, per_cu = 0;
        if (hipGetDevice(&dev) != hipSuccess || hipDeviceGetAttribute(&cus, hipDeviceAttributeMultiprocessorCount, dev) != hipSuccess) { grid = -1; return; }
        if (hipFuncSetAttribute((const void*)hybrid_fwd, hipFuncAttributeMaxDynamicSharedMemorySize, LDS_BYTES) != hipSuccess) { fprintf(stderr, "kernel_launch: hipFuncSetAttribute failed\n"); grid = -1; return; }
        if (hipOccupancyMaxActiveBlocksPerMultiprocessor(&per_cu, (const void*)hybrid_fwd, NTHR, LDS_BYTES) != hipSuccess || per_cu < 1) fprintf(stderr, "kernel_launch: occupancy query reports %d\n", per_cu);
        (void)hipGetLastError();
        grid = cus;
    }
    if (grid < 0) return;
    (void)hipMemsetAsync((char*)d_ws + WS_CTL, 0, CTL_ZERO_BYTES, stream);
    Args a{};
    for (int i = 0; i < 21; ++i) a.in[i] = (const float*)d_in[i];
    a.out = (float*)d_out; a.ws = (unsigned char*)d_ws;
    for (int li = 0; li < N_LAUNCHES; ++li) {
        a.ph_lo = (N_LAUNCHES == 1) ? 0 : li; a.ph_hi = (N_LAUNCHES == 1) ? NPH : li + 1; a.li = li;
        hipLaunchKernelGGL(hybrid_fwd, dim3(grid), dim3(NTHR), LDS_BYTES, stream, a);
    }
}
```
